# Optimizing an MI355X kernel written in HIP

```python
import math
import jax
import jax.numpy as jnp
from jax import lax
import numpy as np

D_MODEL = 1024
BATCH = 8
SEQ = 4096
DEPTH = 1

HYENA_WIDTH = D_MODEL // 2
ATTN_WIDTH = D_MODEL - HYENA_WIDTH
ATTN_HEAD_DIM = 64
ATTN_HEADS = ATTN_WIDTH // (2 * ATTN_HEAD_DIM)
IN_WIDTH = 3 * HYENA_WIDTH + 3 * ATTN_WIDTH
FILTER_EMB_DIM = 33
FILTER_ORDER = 64
FILTER_TARGET = 1e-2
FILTER_FAST_DECAY_PCT = 0.3
FILTER_SLOW_DECAY_PCT = 1.5
D_FF = 4 * D_MODEL
ROPE_THETA = 10000.0
Q_BLOCK = 128
NORM_EPS = 1e-6
SUBLN_EPS = 1e-5

kernel_name = 'hybrid_hyena_diffattn_encoder_block'

F32 = jnp.float32


def rms_norm(x, gain, eps=NORM_EPS):
    xf = x.astype(F32)
    y = xf * lax.rsqrt(jnp.mean(xf * xf, axis=-1, keepdims=True) + eps)
    return (y * gain.astype(F32)).astype(x.dtype)


def short_conv_centred(u, w, b):
    L = u.shape[1]
    up = jnp.pad(u, ((0, 0), (1, 1), (0, 0)))
    return up[:, 0:L] * w[0] + up[:, 1:L + 1] * w[1] + up[:, 2:L + 2] * w[2] + b


def hyena_positional_features(L):
    bands = (FILTER_EMB_DIM - 1) // 2
    t = jnp.linspace(0.0, 1.0, L, dtype=F32)[:, None]
    w = (2.0 * math.pi / L) * jnp.arange(L, dtype=F32)[:, None]
    f = jnp.linspace(1e-4, bands - 1, bands, dtype=F32)[None, :]
    fw = f * w
    return jnp.concatenate([t, jnp.cos(fw), -jnp.sin(fw)], axis=-1)


def hyena_decay_window(L):
    t = jnp.linspace(0.0, 1.0, L, dtype=F32)[:, None]
    max_decay = math.log(FILTER_TARGET) / FILTER_FAST_DECAY_PCT
    min_decay = math.log(FILTER_TARGET) / FILTER_SLOW_DECAY_PCT
    deltas = jnp.linspace(min_decay, max_decay, HYENA_WIDTH, dtype=F32)[None, :]
    return jnp.exp(-t * jnp.abs(deltas))


def implicit_filters(z, decay, w1, b1, w2, b2, w3, b3, w4, freq):
    freq = freq.astype(F32)
    h = jnp.sin(freq * (z @ w1.astype(F32) + b1.astype(F32)))
    h = jnp.sin(freq * (h @ w2.astype(F32) + b2.astype(F32)))
    h = jnp.sin(freq * (h @ w3.astype(F32) + b3.astype(F32)))
    h = (h @ w4.astype(F32)).reshape(z.shape[0], 2, HYENA_WIDTH)
    h = h * decay[:, None, :]
    return h[:, 0], h[:, 1]


def fft_conv(u, h):
    L = u.shape[1]
    n = 2 * L
    uf = jnp.fft.rfft(u, n=n, axis=1)
    hf = jnp.fft.rfft(h, n=n, axis=0)
    return jnp.fft.irfft(uf * hf[None], n=n, axis=1)[:, :L]


def bidirectional_long_conv(u, h_fwd, h_bwd, bias):
    u32 = u.astype(F32)
    y_fwd = fft_conv(u32, h_fwd)
    y_bwd = jnp.flip(fft_conv(jnp.flip(u32, axis=1), h_bwd), axis=1)
    return y_fwd + y_bwd + u32 * bias.astype(F32)


def hyena_mixer(u, conv_w, conv_b, h_fwd, h_bwd, filt_bias):
    u = short_conv_centred(u, conv_w, conv_b)
    x0, x1, v = jnp.split(u, 3, axis=-1)
    y = bidirectional_long_conv(v * x1, h_fwd, h_bwd, filt_bias)
    return (y * x0.astype(F32)).astype(u.dtype)


def rope_tables(L):
    inv = ROPE_THETA ** (-jnp.arange(0, ATTN_HEAD_DIM, 2, dtype=F32) / ATTN_HEAD_DIM)
    ang = jnp.arange(L, dtype=F32)[:, None] * inv[None, :]
    ang = jnp.concatenate([ang, ang], axis=-1)
    return jnp.cos(ang), jnp.sin(ang)


def apply_rope(x, cos, sin):
    x = x.astype(F32)
    x1, x2 = jnp.split(x, 2, axis=-1)
    rot = jnp.concatenate([-x2, x1], axis=-1)
    return x * cos[None, :, None, None, :] + rot * sin[None, :, None, None, :]


def differential_attention(q, k, v, lam):
    B, S = q.shape[0], q.shape[1]
    nb = S // Q_BLOCK
    qb = q.reshape(B, nb, Q_BLOCK, ATTN_HEADS, 2, ATTN_HEAD_DIM).transpose(1, 0, 3, 4, 2, 5)
    kt = k.transpose(0, 2, 3, 1, 4)
    vt = v.astype(F32).transpose(0, 2, 1, 3)

    def block(q_blk):
        s = jnp.einsum('bhcqd,bhcsd->bhcqs', q_blk, kt)
        p = jax.nn.softmax(s, axis=-1)
        w = p[:, :, 0] - lam * p[:, :, 1]
        return jnp.einsum('bhqs,bhse->bhqe', w, vt)

    o = lax.map(block, qb)
    return o.transpose(1, 0, 3, 2, 4).reshape(B, S, ATTN_HEADS, 2 * ATTN_HEAD_DIM)


def setup_inputs(seed: int = 0) -> dict:
    key = jax.random.key(seed)
    ks = jax.random.split(key, 32)

    def nrm(k, shape, std):
        return std * jax.random.normal(k, shape, F32)

    def gain(k, n):
        return 1.0 + nrm(k, (DEPTH, n), 0.01)

    return {
        'x': jax.random.normal(ks[0], (BATCH, SEQ, D_MODEL), F32),
        'attn_pre_gain': gain(ks[1], D_MODEL),
        'attn_post_gain': gain(ks[2], D_MODEL),
        'w_in': nrm(ks[3], (DEPTH, D_MODEL, IN_WIDTH), D_MODEL ** -0.5),
        'conv_w': nrm(ks[4], (DEPTH, 3, 3 * HYENA_WIDTH), 3 ** -0.5),
        'conv_b': nrm(ks[5], (DEPTH, 3 * HYENA_WIDTH), 0.02),
        'filt_w1': nrm(ks[6], (DEPTH, FILTER_EMB_DIM, FILTER_ORDER), FILTER_EMB_DIM ** -0.5),
        'filt_b1': nrm(ks[7], (DEPTH, FILTER_ORDER), 0.1),
        'filt_w2': nrm(ks[8], (DEPTH, FILTER_ORDER, FILTER_ORDER), FILTER_ORDER ** -0.5),
        'filt_b2': nrm(ks[9], (DEPTH, FILTER_ORDER), 0.1),
        'filt_w3': nrm(ks[10], (DEPTH, FILTER_ORDER, FILTER_ORDER), FILTER_ORDER ** -0.5),
        'filt_b3': nrm(ks[11], (DEPTH, FILTER_ORDER), 0.1),
        'filt_w4': nrm(ks[12], (DEPTH, FILTER_ORDER, 2 * HYENA_WIDTH), 0.02),
        'filt_freq': 1.0 + nrm(ks[13], (DEPTH, FILTER_ORDER), 0.01),
        'filt_bias': nrm(ks[14], (DEPTH, HYENA_WIDTH), 1.0),
        'lam_q1': nrm(ks[15], (DEPTH, ATTN_HEAD_DIM), 0.1),
        'lam_k1': nrm(ks[16], (DEPTH, ATTN_HEAD_DIM), 0.1),
        'lam_q2': nrm(ks[17], (DEPTH, ATTN_HEAD_DIM), 0.1),
        'lam_k2': nrm(ks[18], (DEPTH, ATTN_HEAD_DIM), 0.1),
        'subln_gain': gain(ks[19], 2 * ATTN_HEAD_DIM),
        'w_out': nrm(ks[20], (DEPTH, HYENA_WIDTH + ATTN_WIDTH, D_MODEL), (HYENA_WIDTH + ATTN_WIDTH) ** -0.5),
        'mlp_pre_gain': gain(ks[21], D_MODEL),
        'mlp_post_gain': gain(ks[22], D_MODEL),
        'w_up': nrm(ks[23], (DEPTH, D_MODEL, D_FF), D_MODEL ** -0.5),
        'w_down': nrm(ks[24], (DEPTH, D_FF, D_MODEL), D_FF ** -0.5),
    }


def reference(x, attn_pre_gain, attn_post_gain, w_in, conv_w, conv_b, filt_w1, filt_b1, filt_w2, filt_b2,
              filt_w3, filt_b3, filt_w4, filt_freq, filt_bias, lam_q1, lam_k1, lam_q2, lam_k2, subln_gain,
              w_out, mlp_pre_gain, mlp_post_gain, w_up, w_down):
    B, S, _ = x.shape
    z = hyena_positional_features(S)
    decay = hyena_decay_window(S)
    cos, sin = rope_tables(S)
    scale = ATTN_HEAD_DIM ** -0.5
    for l in range(DEPTH):
        h = rms_norm(x, attn_pre_gain[l])
        proj = h @ w_in[l]
        u_hy = proj[..., :3 * HYENA_WIDTH]
        q, k, v = jnp.split(proj[..., 3 * HYENA_WIDTH:], 3, axis=-1)

        h_fwd, h_bwd = implicit_filters(z, decay, filt_w1[l], filt_b1[l], filt_w2[l], filt_b2[l],
                                        filt_w3[l], filt_b3[l], filt_w4[l], filt_freq[l])
        y_hy = hyena_mixer(u_hy, conv_w[l], conv_b[l], h_fwd, h_bwd, filt_bias[l])

        q = apply_rope(q.reshape(B, S, ATTN_HEADS, 2, ATTN_HEAD_DIM), cos, sin) * scale
        k = apply_rope(k.reshape(B, S, ATTN_HEADS, 2, ATTN_HEAD_DIM), cos, sin)
        v = v.reshape(B, S, ATTN_HEADS, 2 * ATTN_HEAD_DIM)
        lam_init = 0.8 - 0.6 * math.exp(-0.3 * l)
        lam = (jnp.exp(jnp.sum(lam_q1[l].astype(F32) * lam_k1[l].astype(F32)))
               - jnp.exp(jnp.sum(lam_q2[l].astype(F32) * lam_k2[l].astype(F32))) + lam_init)
        o = differential_attention(q, k, v, lam)
        o = rms_norm(o, subln_gain[l], SUBLN_EPS) * (1.0 - lam_init)
        y_attn = o.reshape(B, S, ATTN_WIDTH).astype(x.dtype)

        mix = jnp.concatenate([y_hy, y_attn], axis=-1) @ w_out[l]
        x = x + rms_norm(mix, attn_post_gain[l])

        h = rms_norm(x, mlp_pre_gain[l])
        y = jnp.square(jax.nn.relu(h @ w_up[l])) @ w_down[l]
        x = x + rms_norm(y, mlp_post_gain[l])
    return x
```

```cpp
#include <hip/hip_runtime.h>
#include <hip/hip_cooperative_groups.h>
#include <cstdio>
#include <cstdint>
#include <cmath>
namespace cg = cooperative_groups;
#ifndef MK_COOP
#define MK_COOP 1
#endif
namespace pg8 {
#define PG8_LAS __attribute__((address_space(3)))
typedef unsigned short bf16_t;
typedef short bf16x8 __attribute__((ext_vector_type(8)));
typedef float f32x4 __attribute__((ext_vector_type(4)));
typedef unsigned u32x4 __attribute__((ext_vector_type(4)));
constexpr int BM = 256, BK = 64, HALF = 128, HTB = HALF * BK * 2  , STAGE_BYTES = 8 * HTB, NXCD = 8, WGM = 8;

__host__ __device__ __forceinline__ int lds_byte(int r, int c) { const int st = (r >> 4) * 2 + (c >> 5), rr = r & 15, cc = c & 31, ob = rr * 64 + cc * 2; return st * 1024 + (ob ^ (((ob >> 9) & 1) << 5)); }
__host__ __device__ __forceinline__ void stage_rc(int b, int& R, int& C) { const int st = b / 1024, sb = b % 1024, swz = sb ^ (((sb >> 9) & 1) << 5); R = (st >> 1) * 16 + swz / 64; C = (st & 1) * 32 + (swz % 64) / 2; }
__host__ __device__ __forceinline__ int perm32(int rho) { const int n = rho >> 4, i = rho & 15; return 8 * (i >> 2) + 4 * n + (i & 3); }

struct Unit { int pm, pn; };
struct Gemm { const bf16_t* A; const bf16_t* Bt; int M, N, K; };

struct StaticOrder {
    int nM, nN, nwg, G, c;
    __host__ __device__ void init(int M, int N, int G_, int c_) { nM = M / BM; nN = N / BM; nwg = nM * nN; G = G_; c = c_; }
    __host__ __device__ bool next(int i, Unit& u) const {
        const long L = (long)i * G + c; if (L >= nwg) return false;
        int wgid = (int)L; { const int q = nwg / NXCD, r = nwg % NXCD, xcd = wgid % NXCD, off = wgid / NXCD; wgid = (xcd < r ? xcd * (q + 1) : r * (q + 1) + (xcd - r) * q) + off; }
        const int nig = WGM * nN, gid = wgid / nig, fm = gid * WGM, gsz = (nM - fm) < WGM ? (nM - fm) : WGM;
        u.pm = fm + ((wgid % nig) % gsz); u.pn = (wgid % nig) / gsz; return true;
    }
    __device__ __forceinline__ void a_ready(const Unit&) const {}
    __device__ __forceinline__ void done(const Unit&) const {}
};

__device__ __forceinline__ unsigned cvt_pk_bf16(float lo, float hi) { unsigned r; asm volatile("v_cvt_pk_bf16_f32 %0, %1, %2" : "=v"(r) : "v"(lo), "v"(hi)); return r; }
typedef float f32x2 __attribute__((ext_vector_type(2)));
typedef float f32x2 __attribute__((ext_vector_type(2)));
template <int ACT> struct EpiBf16 {
    static constexpr bool PERM = true, AFTER_DRAIN = false;
    bf16_t* O; int ldc;
    __device__ __forceinline__ void operator()(const f32x4 (&acc)[2][2][4][2], const Unit& u, int wr, int wc, int fr, int fq) const {
        const int row0 = u.pm * BM + wr * 64 + fr; const int col0 = u.pn * BM + wc * 32 + 8 * fq;
#pragma unroll
        for (int ai = 0; ai < 2; ++ai)
#pragma unroll
            for (int m = 0; m < 4; ++m) { bf16_t* rowp = O + (size_t)(row0 + ai * HALF + m * 16) * ldc + col0;
#pragma unroll
                for (int bj = 0; bj < 2; ++bj) { f32x4 v0 = acc[ai][bj][m][0], v1 = acc[ai][bj][m][1];
                    if (ACT == 1) {
#pragma unroll
                        for (int j = 0; j < 4; ++j) { float a = v0[j] > 0.f ? v0[j] : 0.f; v0[j] = a * a; float b = v1[j] > 0.f ? v1[j] : 0.f; v1[j] = b * b; } }
                    u32x4 w; w.x = cvt_pk_bf16(v0[0], v0[1]); w.y = cvt_pk_bf16(v0[2], v0[3]); w.z = cvt_pk_bf16(v1[0], v1[1]); w.w = cvt_pk_bf16(v1[2], v1[3]);
                    *(u32x4*)(rowp + bj * HALF) = w; } }
    }
};
struct EpiRope {
    static constexpr bool PERM = true, AFTER_DRAIN = false;
    bf16_t* O; int ldc; const float* rope; float qscale;
    __device__ __forceinline__ void operator()(const f32x4 (&acc)[2][2][4][2], const Unit& u, int wr, int wc, int fr, int fq) const {
        const int row0 = u.pm * BM + wr * 64 + fr; const int col0 = u.pn * BM + wc * 32 + 8 * fq;
        const int g = (wc & 1) * 4 + fq;
        const float sc = (u.pn < 2) ? qscale : 1.0f;
#pragma unroll
        for (int ai = 0; ai < 2; ++ai)
#pragma unroll
            for (int m = 0; m < 4; ++m) { const int row = row0 + ai * HALF + m * 16; const int pos = row & 4095;
                const f32x4 cs0 = *(const f32x4*)(rope + (size_t)pos * 64 + 8 * g), cs1 = *(const f32x4*)(rope + (size_t)pos * 64 + 8 * g + 4);
                const float c[4] = {cs0[0], cs0[2], cs1[0], cs1[2]}, s[4] = {cs0[1], cs0[3], cs1[1], cs1[3]};
                bf16_t* rowp = O + (size_t)row * ldc + col0;
#pragma unroll
                for (int bj = 0; bj < 2; ++bj) { const f32x4 lo = acc[ai][bj][m][0], hi = acc[ai][bj][m][1]; float ol[4], oh[4];
#pragma unroll
                    for (int j = 0; j < 4; ++j) { ol[j] = (lo[j] * c[j] - hi[j] * s[j]) * sc; oh[j] = (hi[j] * c[j] + lo[j] * s[j]) * sc; }
                    u32x4 w; w.x = cvt_pk_bf16(ol[0], ol[1]); w.y = cvt_pk_bf16(ol[2], ol[3]); w.z = cvt_pk_bf16(oh[0], oh[1]); w.w = cvt_pk_bf16(oh[2], oh[3]);
                    *(u32x4*)(rowp + bj * HALF) = w; } }
    }
};
template <class Epi, class Sched, bool ALIGN_EPI = false, bool SP2 = false>
__device__ __forceinline__ void gemm_phase(PG8_LAS unsigned char* lds, const Gemm g, const Sched& S, const Epi& E) {
    const int tid = threadIdx.x, wid = __builtin_amdgcn_readfirstlane(tid >> 6), lane = tid & 63, wr = wid >> 2, wc = wid & 3, fr = lane & 15, fq = lane >> 4;
    const int K = g.K, nt = K / BK;
    unsigned voffA[2], voffB[2];
#pragma unroll
    for (int i = 0; i < 2; ++i) { int R, C; stage_rc(tid * 16 + i * 8192, R, C); const int Rb = Epi::PERM ? ((R & ~31) + perm32(R & 31)) : R;
        voffA[i] = (unsigned)(R * K + C) * 2u; voffB[i] = (unsigned)(Rb * K + C) * 2u; }
    const size_t kstep = (size_t)(BK * 2);
    const size_t hstep = (size_t)HALF * K * 2;
    const size_t tstep = 2 * hstep;
    const unsigned ldsw = (unsigned)wid * 1024u;
    const int aoff = lds_byte(wr * 64 + fr, fq * 8), boff = lds_byte(wc * 32 + fr, fq * 8);
#define PG8_SA(b, h) (((b) * 2 + (h)) * HTB)
#define PG8_SB(b, h) ((4 + (b) * 2 + (h)) * HTB)
#define PG8_STAGE(bufoff, gbase, voff) do { _Pragma("unroll") for (int _i = 0; _i < 2; ++_i) \
        __builtin_amdgcn_global_load_lds((const unsigned*)((const char*)(gbase) + (voff)[_i]), (PG8_LAS unsigned*)(lds + (bufoff) + ldsw + _i * 8192), 16, 0, 0); } while (0)
#define PG8_LDA(dst, b, h) do { _Pragma("unroll") for (int m = 0; m < 4; ++m) _Pragma("unroll") for (int k = 0; k < 2; ++k) dst[m][k] = *(const PG8_LAS bf16x8*)(lds + PG8_SA(b, h) + aoff + m * 2048 + k * 1024); } while (0)
#define PG8_LDB(dst, b, h) do { _Pragma("unroll") for (int n = 0; n < 2; ++n) _Pragma("unroll") for (int k = 0; k < 2; ++k) dst[n][k] = *(const PG8_LAS bf16x8*)(lds + PG8_SB(b, h) + boff + n * 2048 + k * 1024); } while (0)
#define PG8_MMA(ai, bj, At, Bt) do { __builtin_amdgcn_s_setprio(1); _Pragma("unroll") for (int m = 0; m < 4; ++m) _Pragma("unroll") for (int n = 0; n < 2; ++n) _Pragma("unroll") for (int k = 0; k < 2; ++k) \
        acc[ai][bj][m][n] = __builtin_amdgcn_mfma_f32_16x16x32_bf16(Bt[n][k], At[m][k], acc[ai][bj][m][n], 0, 0, 0); __builtin_amdgcn_s_setprio(0); } while (0)
#define PG8_WAIT_V(n) asm volatile("s_waitcnt vmcnt(" #n ")" ::: "memory")
#define PG8_WAIT_L(n) asm volatile("s_waitcnt lgkmcnt(" #n ")" ::: "memory")
#define PG8_BAR __builtin_amdgcn_s_barrier()
#define PG8_SCHED __builtin_amdgcn_sched_barrier(0)
    Unit cur, nxt; int ui = 0;
    if (!S.next(0, cur)) return;
    f32x4 acc[2][2][4][2];
#pragma unroll
    for (int a = 0; a < 2; ++a)
#pragma unroll
        for (int b = 0; b < 2; ++b)
#pragma unroll
            for (int m = 0; m < 4; ++m)
#pragma unroll
                for (int n = 0; n < 2; ++n) acc[a][b][m][n] = (f32x4){0.f, 0.f, 0.f, 0.f};
    bf16x8 At[4][2], B0[2][2], B1[2][2];
    const char* cA = (const char*)g.A + (size_t)cur.pm * tstep; const char* cB = (const char*)g.Bt + (size_t)cur.pn * tstep;
    S.a_ready(cur);
    if constexpr (SP2) {
        PG8_STAGE(PG8_SB(0, 0), cB, voffB); PG8_STAGE(PG8_SB(0, 1), cB + hstep, voffB); PG8_STAGE(PG8_SA(0, 0), cA, voffA); PG8_STAGE(PG8_SA(0, 1), cA + hstep, voffA);
        if (wr == 1) PG8_BAR;
        PG8_WAIT_V(2); PG8_BAR;
        PG8_STAGE(PG8_SB(1, 0), cB + kstep, voffB); PG8_STAGE(PG8_SA(1, 0), cA + kstep, voffA); PG8_STAGE(PG8_SB(1, 1), cB + hstep + kstep, voffB);
        PG8_WAIT_V(6); PG8_BAR;
    } else {
        PG8_STAGE(PG8_SB(0, 0), cB, voffB); PG8_STAGE(PG8_SA(0, 0), cA, voffA); PG8_STAGE(PG8_SB(0, 1), cB + hstep, voffB); PG8_STAGE(PG8_SA(0, 1), cA + hstep, voffA);
        if (wr == 1) PG8_BAR;
        PG8_WAIT_V(4); PG8_BAR;
        PG8_STAGE(PG8_SB(1, 0), cB + kstep, voffB); PG8_STAGE(PG8_SA(1, 0), cA + kstep, voffA); PG8_STAGE(PG8_SB(1, 1), cB + hstep + kstep, voffB);
        PG8_WAIT_V(6); PG8_BAR;
    }
    for (;;) {
        const bool has_next = S.next(ui + 1, nxt);
        const char* nA = has_next ? (const char*)g.A + (size_t)nxt.pm * tstep : cA; const char* nB = has_next ? (const char*)g.Bt + (size_t)nxt.pn * tstep : cB;
        for (int t = 0; t < nt; t += 2) {
            const bool last = (t == nt - 2);
            const char* a1 = cA + (size_t)(t + 1) * kstep;
            const char* a2 = last ? nA : cA + (size_t)(t + 2) * kstep; const char* b2 = last ? nB : cB + (size_t)(t + 2) * kstep;
            const char* a3 = a2 + kstep; const char* b3 = b2 + kstep;
            if (last && has_next) S.a_ready(nxt);
            if constexpr (SP2) {
            PG8_LDB(B0, 0, 0); PG8_LDB(B1, 0, 1); PG8_SCHED; PG8_LDA(At, 0, 0); PG8_STAGE(PG8_SA(1, 1), a1 + hstep, voffA);
            PG8_WAIT_V(8); PG8_WAIT_L(0); PG8_BAR; PG8_MMA(0, 0, At, B0); PG8_MMA(0, 1, At, B1); PG8_BAR; PG8_SCHED;
            PG8_LDA(At, 0, 1); PG8_STAGE(PG8_SB(0, 0), b2, voffB); PG8_STAGE(PG8_SB(0, 1), b2 + hstep, voffB); PG8_STAGE(PG8_SA(0, 0), a2, voffA);
            PG8_WAIT_V(8); PG8_WAIT_L(0); PG8_BAR; PG8_MMA(1, 0, At, B0); PG8_MMA(1, 1, At, B1); PG8_BAR; PG8_SCHED;
            PG8_LDB(B0, 1, 0); PG8_LDB(B1, 1, 1); PG8_SCHED; PG8_LDA(At, 1, 0); PG8_STAGE(PG8_SA(0, 1), a2 + hstep, voffA);
            PG8_WAIT_V(8); PG8_WAIT_L(0); PG8_BAR; PG8_MMA(0, 0, At, B0); PG8_MMA(0, 1, At, B1); PG8_BAR; PG8_SCHED;
            PG8_LDA(At, 1, 1); PG8_STAGE(PG8_SB(1, 0), b3, voffB); PG8_STAGE(PG8_SB(1, 1), b3 + hstep, voffB); PG8_STAGE(PG8_SA(1, 0), a3, voffA);
            PG8_WAIT_V(8); PG8_WAIT_L(0); PG8_BAR; PG8_MMA(1, 0, At, B0); PG8_MMA(1, 1, At, B1); PG8_BAR; PG8_SCHED;
            } else {
            PG8_LDB(B0, 0, 0); PG8_SCHED; PG8_LDA(At, 0, 0); PG8_STAGE(PG8_SA(1, 1), a1 + hstep, voffA);
            PG8_WAIT_L(8); PG8_BAR; PG8_WAIT_L(0); PG8_MMA(0, 0, At, B0); PG8_BAR; PG8_SCHED;
            PG8_LDB(B1, 0, 1); PG8_STAGE(PG8_SB(0, 0), b2, voffB);
            PG8_BAR; PG8_WAIT_L(0); PG8_MMA(0, 1, At, B1); PG8_BAR;
            PG8_LDA(At, 0, 1); PG8_STAGE(PG8_SA(0, 0), a2, voffA);
            PG8_BAR; PG8_WAIT_L(0); PG8_MMA(1, 0, At, B0); PG8_BAR; PG8_SCHED;
            PG8_STAGE(PG8_SB(0, 1), b2 + hstep, voffB);
            PG8_WAIT_V(6); PG8_BAR; PG8_MMA(1, 1, At, B1); PG8_BAR;
            PG8_LDB(B0, 1, 0); PG8_SCHED; PG8_LDA(At, 1, 0); PG8_STAGE(PG8_SA(0, 1), a2 + hstep, voffA);
            PG8_WAIT_L(8); PG8_BAR; PG8_WAIT_L(0); PG8_MMA(0, 0, At, B0); PG8_BAR; PG8_SCHED;
            PG8_LDB(B1, 1, 1); PG8_STAGE(PG8_SB(1, 0), b3, voffB);
            PG8_BAR; PG8_WAIT_L(0); PG8_MMA(0, 1, At, B1); PG8_BAR;
            PG8_LDA(At, 1, 1); PG8_STAGE(PG8_SA(1, 0), a3, voffA);
            PG8_BAR; PG8_WAIT_L(0); PG8_MMA(1, 0, At, B0); PG8_BAR; PG8_SCHED;
            PG8_STAGE(PG8_SB(1, 1), b3 + hstep, voffB);
            PG8_WAIT_V(6); PG8_BAR; PG8_MMA(1, 1, At, B1); PG8_BAR;
            }
        }
        if constexpr (ALIGN_EPI) { if (wr == 0) PG8_BAR; }
        if constexpr (!Epi::AFTER_DRAIN) { E(acc, cur, wr, wc, fr, fq); S.done(cur); }
        if (!has_next) break;
#pragma unroll
        for (int a = 0; a < 2; ++a)
#pragma unroll
            for (int b = 0; b < 2; ++b)
#pragma unroll
                for (int m = 0; m < 4; ++m)
#pragma unroll
                    for (int n = 0; n < 2; ++n) acc[a][b][m][n] = (f32x4){0.f, 0.f, 0.f, 0.f};
        cur = nxt; cA = nA; cB = nB; ++ui;
        if constexpr (ALIGN_EPI) { if (wr == 1) PG8_BAR; }
    }
    PG8_WAIT_V(0);
    if constexpr (!ALIGN_EPI) { if (wr == 0) PG8_BAR; }
    PG8_BAR;
    if constexpr (Epi::AFTER_DRAIN) { E.fused(acc, cur, wr, wc, fr, fq, lds, wid, lane); S.done(cur); }
#undef PG8_SA
#undef PG8_SB
#undef PG8_STAGE
#undef PG8_LDA
#undef PG8_LDB
#undef PG8_MMA
#undef PG8_WAIT_V
#undef PG8_WAIT_L
#undef PG8_BAR
#undef PG8_SCHED
}
}

constexpr int BATCH = 8, SEQ = 4096, DM = 1024, MTOK = BATCH * SEQ, HYW = 512, NIN = 3072, DFF = 4096;
constexpr int NWAVES = 8, NTHR = 512;
constexpr float NORM_EPS = 1e-6f, SUBLN_EPS = 1e-5f;
constexpr float QSCALE = 0.125f * 1.4426950408889634f;
constexpr int HRLEN = 8224;
constexpr size_t MiB = 1u << 20;
constexpr size_t WS_WIN = 0, WS_WOUT = 6 * MiB, WS_WUP = 8 * MiB, WS_WDOWN = 16 * MiB;
constexpr size_t WS_HR = 24 * MiB;
constexpr size_t WS_ROPE = 33 * MiB;
constexpr size_t WS_XN = 40 * MiB;
constexpr size_t WS_MO = 104 * MiB;
constexpr size_t WS_YT = 168 * MiB;
constexpr size_t WS_UVT = 200 * MiB;
constexpr size_t WS_QK = 328 * MiB;
constexpr size_t WS_MIX = 392 * MiB;
constexpr size_t WS_H = 200 * MiB;
constexpr size_t WS_END = 456 * MiB;
constexpr int LDS_BYTES = 135168;

#define LAS __attribute__((address_space(3)))
typedef unsigned short bf16;
typedef unsigned u32x4 __attribute__((ext_vector_type(4)));
typedef unsigned u32x2 __attribute__((ext_vector_type(2)));
typedef float f32x4 __attribute__((ext_vector_type(4)));
typedef float f32x16 __attribute__((ext_vector_type(16)));
typedef short bf16x8 __attribute__((ext_vector_type(8)));
typedef short s16x4 __attribute__((ext_vector_type(4)));

__device__ __forceinline__ unsigned f2bf(float f) { unsigned u = __builtin_bit_cast(unsigned, f); return (u + 0x7fffu + ((u >> 16) & 1u)) >> 16; }
__device__ __forceinline__ unsigned pk2(float lo, float hi) { return f2bf(lo) | (f2bf(hi) << 16); }
typedef float f32x2_t __attribute__((ext_vector_type(2))); typedef __bf16 bf16x2_t __attribute__((ext_vector_type(2)));
__device__ __forceinline__ unsigned cvtpk(float lo, float hi) { f32x2_t v = {lo, hi}; bf16x2_t b = __builtin_convertvector(v, bf16x2_t); return __builtin_bit_cast(unsigned, b); }
__device__ __forceinline__ float bf2f(unsigned short b) { return __builtin_bit_cast(float, (unsigned)b << 16); }
__device__ __forceinline__ float bflo(unsigned w) { return __builtin_bit_cast(float, w << 16); }
__device__ __forceinline__ float bfhi(unsigned w) { return __builtin_bit_cast(float, w & 0xffff0000u); }
__device__ __forceinline__ float wave_sum(float v) {
#pragma unroll
    for (int o = 1; o < 64; o <<= 1) v += __shfl_xor(v, o);
    return v;
}
__device__ __forceinline__ float swap_hi(float v) { return __shfl_xor(v, 32); }
#define LDS_WAIT() asm volatile("s_waitcnt lgkmcnt(0)" ::: "memory")

struct Args { const float* in[25]; float* out; unsigned char* ws; int ph_lo, ph_hi; };

__device__ __forceinline__ int win_src(int n) {
    if (n < 1536) return n;
    if (n < 2048) return n + 1024;
    const int pp = n - 2048, grp = pp >> 6, p = pp & 63, g = p >> 3, e = p & 7;
    const int d = (e < 4) ? (4 * g + e) : (32 + 4 * g + (e - 4));
    return 1536 + grp * 64 + d;
}
template <bool PERMW>
__device__ __forceinline__ void p0_transpose_item(const float* W, int K, int N, bf16* WT, LAS float* scr, int item, int lane) {
    const int nblk = N / 32, kb = item / nblk, nb = item % nblk, k0 = 64 * kb, n0 = 32 * nb;
    const int sc = PERMW ? win_src(n0 + (lane & 31)) : (n0 + (lane & 31));
#pragma unroll 8
    for (int i = 0; i < 32; ++i) { const int kk = 2 * i + (lane >> 5); scr[kk * 33 + (lane & 31)] = W[(size_t)(k0 + kk) * N + sc]; }
    LDS_WAIT(); asm volatile("" ::: "memory");
    const int c = lane & 7;
#pragma unroll
    for (int j = 0; j < 4; ++j) { const int n = (lane >> 3) + 8 * j; const LAS float* s = scr + (8 * c) * 33 + n;
        u32x4 o; o.x = pk2(s[0 * 33], s[1 * 33]); o.y = pk2(s[2 * 33], s[3 * 33]); o.z = pk2(s[4 * 33], s[5 * 33]); o.w = pk2(s[6 * 33], s[7 * 33]);
        *(u32x4*)(WT + (size_t)(n0 + n) * K + k0 + 8 * c) = o; }
    LDS_WAIT(); asm volatile("" ::: "memory");
}
__device__ __forceinline__ void rms_row_to_bf16(const float* xrow, const float* gain, bf16* orow, int lane) {
    const f32x4* xr = (const f32x4*)xrow + lane; const f32x4* gr = (const f32x4*)gain + lane;
    f32x4 v[4]; float s = 0.f;
#pragma unroll
    for (int j = 0; j < 4; ++j) { v[j] = xr[64 * j]; s += (v[j].x * v[j].x + v[j].y * v[j].y) + (v[j].z * v[j].z + v[j].w * v[j].w); }
    const float r = 1.0f / sqrtf(wave_sum(s) * (1.f / DM) + NORM_EPS);
    unsigned long long* o8 = (unsigned long long*)orow + lane;
#pragma unroll
    for (int j = 0; j < 4; ++j) { const f32x4 g = gr[64 * j];
        o8[64 * j] = (unsigned long long)pk2(v[j].x * r * g.x, v[j].y * r * g.y) | ((unsigned long long)pk2(v[j].z * r * g.z, v[j].w * r * g.w) << 32); }
}

__device__ __forceinline__ void filter_item(LAS unsigned char* lds, const Args& a, bf16* HR, int pg, int tid) {
    LAS float* Z = (LAS float*)lds;
    LAS float* HA = Z + 16 * 33;
    LAS float* HB = HA + 16 * 64;
    const float* w1 = a.in[6]; const float* b1 = a.in[7]; const float* w2 = a.in[8]; const float* b2 = a.in[9];
    const float* w3 = a.in[10]; const float* b3 = a.in[11]; const float* w4 = a.in[12]; const float* freq = a.in[13]; const float* fbias = a.in[14];
    const int t0 = 16 * pg;
    for (int i = tid; i < 16 * 33; i += NTHR) { const int p = i / 33, f = i % 33; const int pos = t0 + p; float val;
        if (f == 0) val = (float)pos * (1.0f / (float)(SEQ - 1));
        else { const int j = (f - 1) & 15; const float fj = 1e-4f + (float)j * ((15.0f - 1e-4f) / 15.0f); const float w = (6.283185307179586f / (float)SEQ) * (float)pos; const float arg = fj * w;
            val = (f <= 16) ? cosf(arg) : -sinf(arg); }
        Z[i] = val; }
    __syncthreads();
    for (int o = tid; o < 1024; o += NTHR) { const int p = o >> 6, n = o & 63; float acc = b1[n];
#pragma unroll 3
        for (int f = 0; f < 33; ++f) acc += Z[p * 33 + f] * w1[f * 64 + n];
        HA[o] = sinf(freq[n] * acc); }
    __syncthreads();
    for (int o = tid; o < 1024; o += NTHR) { const int p = o >> 6, n = o & 63; float acc = b2[n];
#pragma unroll 4
        for (int f = 0; f < 64; ++f) acc += HA[p * 64 + f] * w2[f * 64 + n];
        HB[o] = sinf(freq[n] * acc); }
    __syncthreads();
    for (int o = tid; o < 1024; o += NTHR) { const int p = o >> 6, n = o & 63; float acc = b3[n];
#pragma unroll 4
        for (int f = 0; f < 64; ++f) acc += HB[p * 64 + f] * w3[f * 64 + n];
        HA[o] = sinf(freq[n] * acc); }
    __syncthreads();
    {   const int c = tid;
        float af[16], ab[16];
#pragma unroll
        for (int p = 0; p < 16; ++p) { af[p] = 0.f; ab[p] = 0.f; }
#pragma unroll 2
        for (int k = 0; k < 64; ++k) { const float wf = w4[k * 1024 + c], wb = w4[k * 1024 + 512 + c];
#pragma unroll
            for (int p = 0; p < 16; ++p) { const float hv = HA[p * 64 + k]; af[p] += hv * wf; ab[p] += hv * wb; } }
        const float min_decay = -4.605170185988091f / 1.5f, max_decay = -4.605170185988091f / 0.3f;
        const float adelta = fabsf(min_decay + (float)c * ((max_decay - min_decay) / 511.0f));
        bf16* hr = HR + (size_t)c * HRLEN;
#pragma unroll
        for (int p = 0; p < 16; ++p) { const int pos = t0 + p; const float tl = (float)pos * (1.0f / (float)(SEQ - 1)); const float dec = expf(-tl * adelta);
            const float vf = af[p] * dec, vb = ab[p] * dec;
            if (pos == 0) hr[4096] = (bf16)f2bf(vf + vb + fbias[c]);
            else { hr[4096 - pos] = (bf16)f2bf(vf); hr[4096 + pos] = (bf16)f2bf(vb); } }
        if (pg == 0) { hr[0] = 0; for (int i = 8192; i < HRLEN; ++i) hr[i] = 0; }
    }
    __syncthreads();
}

namespace att {
constexpr int KP = 272, VP = 136, KBUF = 64 * KP, VBUF = 128 * VP, STG = KBUF + VBUF;
constexpr int NT = SEQ / 64;
__device__ __forceinline__ void unit(LAS unsigned char* lds, const bf16* QK, const bf16* UVT, bf16* MIX, const float* sgain, float lam, int b, int h, int qb) {
    const int tid = threadIdx.x, lane = tid & 63, r32 = lane & 31, hi = lane >> 5; const int wid = __builtin_amdgcn_readfirstlane(tid >> 6);
    const int qsub = wid & 3, c = wid >> 2;
    const size_t rowbase = (size_t)b * SEQ; const int q0 = qb * 128 + qsub * 32;
    bf16x8 qr[4];
    { const bf16* qp = QK + (rowbase + q0 + r32) * 1024 + h * 128 + c * 64 + hi * 8;
#pragma unroll
      for (int ds = 0; ds < 4; ++ds) qr[ds] = *(const bf16x8*)(qp + ds * 16); }
    const bf16* gk[2]; const bf16* gv[2]; int lk[2], lv[2];
#pragma unroll
    for (int i = 0; i < 2; ++i) { const int id = tid + NTHR * i; const int kr = id >> 4, kc = id & 15; const int ve = id >> 3, vc = id & 7;
        gk[i] = QK + (rowbase + kr) * 1024 + 512 + h * 128 + kc * 8; lk[i] = kr * KP + kc * 16;
        gv[i] = UVT + (size_t)(1536 + h * 128 + ve) * MTOK + rowbase + vc * 8; lv[i] = KBUF + ve * VP + vc * 16; }
    u32x4 pk[2], pv[2];
#pragma unroll
    for (int i = 0; i < 2; ++i) { pk[i] = *(const u32x4*)gk[i]; pv[i] = *(const u32x4*)gv[i]; }
#pragma unroll
    for (int i = 0; i < 2; ++i) { *(LAS u32x4*)(lds + lk[i]) = pk[i]; *(LAS u32x2*)(lds + lv[i]) = (u32x2){pv[i].x, pv[i].y}; *(LAS u32x2*)(lds + lv[i] + 8) = (u32x2){pv[i].z, pv[i].w}; }
    __syncthreads();
    f32x16 o[4];
#pragma unroll
    for (int e = 0; e < 4; ++e) o[e] = (f32x16){};
    float mref = -1e30f, lsum = 0.f;
    for (int t = 0; t < NT; ++t) {
        LAS unsigned char* st = lds + (t & 1) * STG;
        LAS unsigned char* nx = lds + ((t + 1) & 1) * STG;
        const bool more = (t + 1 < NT);
        if (more) {
#pragma unroll
            for (int i = 0; i < 2; ++i) { pk[i] = *(const u32x4*)(gk[i] + (size_t)(t + 1) * 64 * 1024); pv[i] = *(const u32x4*)(gv[i] + (size_t)(t + 1) * 64); } }
        f32x16 s0 = (f32x16){}, s1 = (f32x16){};
        { const LAS unsigned char* kb = st + r32 * KP + c * 128 + hi * 16;
#pragma unroll
          for (int ds = 0; ds < 4; ++ds) { const bf16x8 a0 = *(const LAS bf16x8*)(kb + ds * 32), a1 = *(const LAS bf16x8*)(kb + 32 * KP + ds * 32);
              s0 = __builtin_amdgcn_mfma_f32_32x32x16_bf16(a0, qr[ds], s0, 0, 0, 0); s1 = __builtin_amdgcn_mfma_f32_32x32x16_bf16(a1, qr[ds], s1, 0, 0, 0); } }
        float mx = fmaxf(s0[0], s1[0]);
#pragma unroll
        for (int r = 1; r < 16; ++r) mx = fmaxf(mx, fmaxf(s0[r], s1[r]));
        mx = fmaxf(mx, swap_hi(mx));
        if (__any(mx > mref + 8.0f)) { const float mnew = fmaxf(mref, mx); const float al = __builtin_amdgcn_exp2f(mref - mnew);
#pragma unroll
            for (int e = 0; e < 4; ++e)
#pragma unroll
                for (int r = 0; r < 16; ++r) o[e][r] *= al;
            lsum *= al; mref = mnew; }
        float ps = 0.f;
#pragma unroll
        for (int r = 0; r < 16; ++r) { s0[r] = __builtin_amdgcn_exp2f(s0[r] - mref); s1[r] = __builtin_amdgcn_exp2f(s1[r] - mref); ps += s0[r] + s1[r]; }
        lsum += ps;
        { const LAS unsigned char* vb = st + KBUF + r32 * VP + hi * 8;
#pragma unroll
          for (int ks = 0; ks < 4; ++ks) { u32x4 pw;
              if (ks < 2) { const int bs = 8 * (ks & 1); pw.x = cvtpk(s0[bs], s0[bs + 1]); pw.y = cvtpk(s0[bs + 2], s0[bs + 3]); pw.z = cvtpk(s0[bs + 4], s0[bs + 5]); pw.w = cvtpk(s0[bs + 6], s0[bs + 7]); }
              else { const int bs = 8 * (ks & 1); pw.x = cvtpk(s1[bs], s1[bs + 1]); pw.y = cvtpk(s1[bs + 2], s1[bs + 3]); pw.z = cvtpk(s1[bs + 4], s1[bs + 5]); pw.w = cvtpk(s1[bs + 6], s1[bs + 7]); }
              const bf16x8 pb = __builtin_bit_cast(bf16x8, pw);
#pragma unroll
              for (int e = 0; e < 4; ++e) { const u32x2 v0 = *(const LAS u32x2*)(vb + e * 32 * VP + ks * 32), v1 = *(const LAS u32x2*)(vb + e * 32 * VP + ks * 32 + 16);
                  const bf16x8 va = __builtin_bit_cast(bf16x8, (u32x4){v0.x, v0.y, v1.x, v1.y});
                  o[e] = __builtin_amdgcn_mfma_f32_32x32x16_bf16(va, pb, o[e], 0, 0, 0); } } }
        if (more) {
#pragma unroll
            for (int i = 0; i < 2; ++i) { *(LAS u32x4*)(nx + lk[i]) = pk[i]; *(LAS u32x2*)(nx + lv[i]) = (u32x2){pv[i].x, pv[i].y}; *(LAS u32x2*)(nx + lv[i] + 8) = (u32x2){pv[i].z, pv[i].w}; } }
        __syncthreads();
    }
    lsum += swap_hi(lsum);
    const float sc = (c == 0) ? (1.0f / lsum) : (lam / lsum);
    LAS float* X = (LAS float*)lds + qsub * (128 * 32);
    if (c == 1) {
#pragma unroll
        for (int e = 0; e < 4; ++e)
#pragma unroll
            for (int r = 0; r < 16; ++r) { const int ee = 32 * e + (r & 3) + 8 * (r >> 2) + 4 * hi; X[ee * 32 + r32] = o[e][r] * sc; } }
    __syncthreads();
    if (c == 0) { float ss = 0.f;
#pragma unroll
        for (int e = 0; e < 4; ++e)
#pragma unroll
            for (int r = 0; r < 16; ++r) { const int ee = 32 * e + (r & 3) + 8 * (r >> 2) + 4 * hi; const float v = o[e][r] * sc - X[ee * 32 + r32]; o[e][r] = v; ss += v * v; }
        ss += swap_hi(ss);
        const float rs = (1.0f / sqrtf(ss * (1.0f / 128.0f) + SUBLN_EPS)) * 0.8f;
        bf16* op = MIX + (rowbase + q0 + r32) * 1024 + 512 + h * 128;
#pragma unroll
        for (int e = 0; e < 4; ++e)
#pragma unroll
            for (int q4 = 0; q4 < 4; ++q4) { const int ee = 32 * e + 8 * q4 + 4 * hi; const f32x4 g = *(const f32x4*)(sgain + ee);
                u32x2 w; w.x = cvtpk(o[e][4 * q4] * rs * g.x, o[e][4 * q4 + 1] * rs * g.y); w.y = cvtpk(o[e][4 * q4 + 2] * rs * g.z, o[e][4 * q4 + 3] * rs * g.w);
                *(u32x2*)(op + ee) = w; } }
    __syncthreads();
}
}

namespace hy {
constexpr int UP = 264, UBUF = 32 * UP * 2, HRB = HRLEN * 2;
constexpr int NCH = 17;
__device__ __forceinline__ float ldbf(const bf16* p) { return bf2f(*p); }
__device__ __forceinline__ void stage(LAS unsigned char* ub, const bf16* X1, const bf16* V, const float (&w1)[4], const float (&wv)[4], int j, int tid) {
    for (int it = tid; it < 520; it += NTHR) { const int b = it / 65, tt = it - b * 65; const int s0 = 256 * j - 4 + 4 * tt;
        float g[4] = {0.f, 0.f, 0.f, 0.f};
        if (s0 >= 0 && s0 < SEQ) { const bf16* x1p = X1 + (size_t)b * SEQ + s0; const bf16* vp = V + (size_t)b * SEQ + s0;
            const u32x2 xa = *(const u32x2*)x1p, va = *(const u32x2*)vp;
            float xs[6], vs[6];
            xs[0] = (s0 > 0) ? ldbf(x1p - 1) : 0.f; vs[0] = (s0 > 0) ? ldbf(vp - 1) : 0.f;
            xs[5] = (s0 + 4 < SEQ) ? ldbf(x1p + 4) : 0.f; vs[5] = (s0 + 4 < SEQ) ? ldbf(vp + 4) : 0.f;
            xs[1] = bflo(xa.x); xs[2] = bfhi(xa.x); xs[3] = bflo(xa.y); xs[4] = bfhi(xa.y);
            vs[1] = bflo(va.x); vs[2] = bfhi(va.x); vs[3] = bflo(va.y); vs[4] = bfhi(va.y);
#pragma unroll
            for (int i = 0; i < 4; ++i) { const float cx = w1[0] * xs[i] + w1[1] * xs[i + 1] + w1[2] * xs[i + 2] + w1[3]; const float cv = wv[0] * vs[i] + wv[1] * vs[i + 1] + wv[2] * vs[i + 2] + wv[3]; g[i] = cx * cv; } }
        LAS bf16* U = (LAS bf16*)ub;
#pragma unroll
        for (int r = 0; r < 4; ++r)
#pragma unroll
            for (int i = 0; i < 4; ++i) { const int kk = 4 * tt + i - r; if (kk >= 0 && kk < 256) U[(4 * b + r) * UP + kk] = (bf16)f2bf(g[i]); } }
}
__device__ __forceinline__ void channel(LAS unsigned char* lds, const bf16* UVT, const bf16* HR, const float* conv_w, const float* conv_b, bf16* YT, int c) {
    const int tid = threadIdx.x, lane = tid & 63, r32 = lane & 31, hi = lane >> 5; const int wid = __builtin_amdgcn_readfirstlane(tid >> 6);
    const bf16* X0 = UVT + (size_t)c * MTOK; const bf16* X1 = UVT + (size_t)(512 + c) * MTOK; const bf16* V = UVT + (size_t)(1024 + c) * MTOK;
    float w0[4], w1[4], wv[4];
#pragma unroll
    for (int k = 0; k < 3; ++k) { w0[k] = conv_w[k * 1536 + c]; w1[k] = conv_w[k * 1536 + 512 + c]; wv[k] = conv_w[k * 1536 + 1024 + c]; }
    w0[3] = conv_b[c]; w1[3] = conv_b[512 + c]; wv[3] = conv_b[1024 + c];
    for (int i = tid; i < HRB / 16; i += NTHR) ((LAS u32x4*)lds)[i] = ((const u32x4*)(HR + (size_t)c * HRLEN))[i];
    LAS unsigned char* ub0 = lds + HRB;
    stage(ub0, X1, V, w1, wv, 0, tid);
    __syncthreads();
    f32x16 acc[4];
#pragma unroll
    for (int n = 0; n < 4; ++n) acc[n] = (f32x16){};
    const int hb0 = (4096 - 4 * (128 * wid + r32) - 4 + 8 * hi) * 2;
    for (int j = 0; j < NCH; ++j) {
        LAS unsigned char* ucur = ub0 + (j & 1) * UBUF;
        if (j + 1 < NCH) stage(ub0 + ((j + 1) & 1) * UBUF, X1, V, w1, wv, j + 1, tid);
        const int nks = (j < NCH - 1) ? 16 : 1;
        const LAS unsigned char* ua = ucur + r32 * (UP * 2) + hi * 16;
        const LAS unsigned char* hp = lds + hb0 + j * 512;
#pragma unroll 4
        for (int ks = 0; ks < nks; ++ks) { const bf16x8 a = *(const LAS bf16x8*)(ua + ks * 32);
#pragma unroll
            for (int n = 0; n < 4; ++n) { const LAS unsigned char* p = hp + ks * 32 - n * 256; const u32x2 b0 = *(const LAS u32x2*)p, b1 = *(const LAS u32x2*)(p + 8);
                const bf16x8 bb = __builtin_bit_cast(bf16x8, (u32x4){b0.x, b0.y, b1.x, b1.y});
                acc[n] = __builtin_amdgcn_mfma_f32_32x32x16_bf16(a, bb, acc[n], 0, 0, 0); } }
        __syncthreads();
    }
#pragma unroll
    for (int n = 0; n < 4; ++n) { const int t = 4 * (128 * wid + 32 * n + r32);
#pragma unroll
        for (int q = 0; q < 4; ++q) { const int b = 2 * q + hi; const bf16* xp = X0 + (size_t)b * SEQ + t; const u32x2 xa = *(const u32x2*)xp; float xs[6];
            xs[0] = (t > 0) ? ldbf(xp - 1) : 0.f; xs[5] = (t + 4 < SEQ) ? ldbf(xp + 4) : 0.f;
            xs[1] = bflo(xa.x); xs[2] = bfhi(xa.x); xs[3] = bflo(xa.y); xs[4] = bfhi(xa.y);
            float y[4];
#pragma unroll
            for (int i = 0; i < 4; ++i) y[i] = acc[n][4 * q + i] * (w0[0] * xs[i] + w0[1] * xs[i + 1] + w0[2] * xs[i + 2] + w0[3]);
            u32x2 w; w.x = pk2(y[0], y[1]); w.y = pk2(y[2], y[3]);
            *(u32x2*)(YT + (size_t)c * MTOK + (size_t)b * SEQ + t) = w; } }
    __syncthreads();
}
}

__global__ void __launch_bounds__(NTHR, 2) fwd_kernel(Args a) {
    extern __shared__ __attribute__((aligned(16))) unsigned char lds_raw[];
    LAS unsigned char* lds = (LAS unsigned char*)lds_raw;
    const int tid = threadIdx.x, lane = tid & 63; const int wave = __builtin_amdgcn_readfirstlane(tid >> 6);
    const int G = gridDim.x, bx = blockIdx.x;
    const int gw = bx * NWAVES + wave, NGW = G * NWAVES;
    unsigned char* ws = a.ws;
    bf16* Win_t = (bf16*)(ws + WS_WIN); bf16* Wout_t = (bf16*)(ws + WS_WOUT); bf16* Wup_t = (bf16*)(ws + WS_WUP); bf16* Wdown_t = (bf16*)(ws + WS_WDOWN);
    bf16* HR = (bf16*)(ws + WS_HR); float* ROPE = (float*)(ws + WS_ROPE);
    bf16* XN = (bf16*)(ws + WS_XN); bf16* MO = (bf16*)(ws + WS_MO); bf16* YT = (bf16*)(ws + WS_YT); bf16* UVT = (bf16*)(ws + WS_UVT);
    bf16* QK = (bf16*)(ws + WS_QK); bf16* MIX = (bf16*)(ws + WS_MIX); bf16* HB = (bf16*)(ws + WS_H);
    const float* x = a.in[0];
    const int lo = a.ph_lo, hi_ph = a.ph_hi;
#if MK_COOP
    cg::grid_group grid = cg::this_grid();
#define SEAM(k) do { if (lo <= (k) && (k) + 1 < hi_ph) grid.sync(); } while (0)
#else
#define SEAM(k) do { } while (0)
#endif
#ifndef PHMASK
#define PHMASK 0x1ff
#endif
#define IN(k) (((PHMASK >> (k)) & 1) && lo <= (k) && (k) < hi_ph)

    if (IN(0)) {
        LAS float* scr = (LAS float*)(lds + wave * 16384);
        constexpr int I_IN = (DM / 64) * (NIN / 32), I_OUT = (DM / 64) * (DM / 32), I_UP = (DM / 64) * (DFF / 32), I_DN = (DFF / 64) * (DM / 32);
        for (int it = gw; it < I_IN + I_OUT + I_UP + I_DN; it += NGW) { int r = it;
            if (r < I_IN) { p0_transpose_item<true>(a.in[3], DM, NIN, Win_t, scr, r, lane); continue; } r -= I_IN;
            if (r < I_OUT) { p0_transpose_item<false>(a.in[20], DM, DM, Wout_t, scr, r, lane); continue; } r -= I_OUT;
            if (r < I_UP) { p0_transpose_item<false>(a.in[23], DM, DFF, Wup_t, scr, r, lane); continue; } r -= I_UP;
            p0_transpose_item<false>(a.in[24], DFF, DM, Wdown_t, scr, r, lane); }
        for (int m = gw; m < MTOK; m += NGW) rms_row_to_bf16(x + (size_t)m * DM, a.in[1], XN + (size_t)m * DM, lane);
        for (int i = bx * NTHR + tid; i < SEQ * 32; i += G * NTHR) { const int pos = i >> 5, k = i & 31;
            const float inv = exp2f(-(float)(2 * k) * (13.287712379549449f / 64.0f)); const float ang = (float)pos * inv;
            ROPE[2 * i] = cosf(ang); ROPE[2 * i + 1] = sinf(ang); }
        __syncthreads();
        for (int pg = bx; pg < SEQ / 16; pg += G) filter_item(lds, a, HR, pg, tid);
    }
    SEAM(0);
    if (IN(1)) {
        { pg8::Gemm g{Win_t, XN, 2048, MTOK, DM}; pg8::StaticOrder S; S.init(2048, MTOK, G, bx);
          pg8::EpiBf16<0> E{UVT, MTOK};
          pg8::gemm_phase<pg8::EpiBf16<0>, pg8::StaticOrder, true, true>(lds, g, S, E); }
        { pg8::Gemm g{XN, Win_t + (size_t)2048 * DM, MTOK, 1024, DM}; pg8::StaticOrder S; S.init(MTOK, 1024, G, bx);
          pg8::EpiRope E{QK, 1024, ROPE, QSCALE};
          pg8::gemm_phase<pg8::EpiRope, pg8::StaticOrder, true, true>(lds, g, S, E); }
    }
    SEAM(1);
    if (IN(2)) {
        float lam;
        { const float p1 = a.in[15][lane] * a.in[16][lane], p2 = a.in[17][lane] * a.in[18][lane];
          lam = expf(wave_sum(p1)) - expf(wave_sum(p2)) + 0.2f; }
        for (int u = bx; u < 1024; u += G) { const int bh = (u & 7) + 8 * (u >> 8), qb = (u >> 3) & 31;
            att::unit(lds, QK, UVT, MIX, a.in[19], lam, bh >> 2, bh & 3, qb); }
        for (int c = bx; c < HYW; c += G) hy::channel(lds, UVT, HR, a.in[4], a.in[5], YT, c);
    }
    SEAM(2);
    if (IN(3)) {
        LAS unsigned short* scr = (LAS unsigned short*)(lds + wave * 16384);
        for (int it = gw; it < 8 * (MTOK / 64); it += NGW) { const int ct = it & 7, mt = it >> 3; const int c0 = 64 * ct, m0 = 64 * mt;
#pragma unroll
            for (int i = 0; i < 8; ++i) { const int cc = 8 * i + (lane >> 3), mch = lane & 7; const u32x4 v = *(const u32x4*)(YT + (size_t)(c0 + cc) * MTOK + m0 + 8 * mch);
                LAS unsigned* d = (LAS unsigned*)(scr + cc * 66 + 8 * mch); d[0] = v.x; d[1] = v.y; d[2] = v.z; d[3] = v.w; }
            LDS_WAIT(); asm volatile("" ::: "memory");
#pragma unroll
            for (int i = 0; i < 8; ++i) { const int mm = 8 * i + (lane >> 3), cch = lane & 7; const LAS unsigned short* s = scr + (8 * cch) * 66 + mm;
                u32x4 o; o.x = (unsigned)s[0] | ((unsigned)s[66] << 16); o.y = (unsigned)s[2 * 66] | ((unsigned)s[3 * 66] << 16);
                o.z = (unsigned)s[4 * 66] | ((unsigned)s[5 * 66] << 16); o.w = (unsigned)s[6 * 66] | ((unsigned)s[7 * 66] << 16);
                *(u32x4*)(MIX + (size_t)(m0 + mm) * 1024 + c0 + 8 * cch) = o; }
            LDS_WAIT(); asm volatile("" ::: "memory"); }
        __syncthreads();
    }
    SEAM(3);
    if (IN(4)) {
        pg8::Gemm g{MIX, Wout_t, MTOK, DM, DM}; pg8::StaticOrder S; S.init(MTOK, DM, G, bx);
        pg8::EpiBf16<0> E{MO, DM};
        pg8::gemm_phase<pg8::EpiBf16<0>, pg8::StaticOrder, true, true>(lds, g, S, E);
    }
    SEAM(4);
    if (IN(5)) {
        const f32x4* gp = (const f32x4*)a.in[2] + lane; const f32x4* gm = (const f32x4*)a.in[21] + lane;
        for (int m = gw; m < MTOK; m += NGW) {
            const f32x4* xr = (const f32x4*)(x + (size_t)m * DM) + lane; const u32x2* mr = (const u32x2*)(MO + (size_t)m * DM) + lane;
            f32x4 v[4], y[4]; float s = 0.f;
#pragma unroll
            for (int j = 0; j < 4; ++j) { v[j] = xr[64 * j]; const u32x2 w = mr[64 * j]; y[j] = (f32x4){bflo(w.x), bfhi(w.x), bflo(w.y), bfhi(w.y)};
                s += (y[j].x * y[j].x + y[j].y * y[j].y) + (y[j].z * y[j].z + y[j].w * y[j].w); }
            const float r = 1.0f / sqrtf(wave_sum(s) * (1.f / DM) + NORM_EPS); float s2 = 0.f;
            f32x4* orow = (f32x4*)(a.out + (size_t)m * DM) + lane;
#pragma unroll
            for (int j = 0; j < 4; ++j) { const f32x4 g = gp[64 * j]; v[j] = v[j] + y[j] * r * g; orow[64 * j] = v[j];
                s2 += (v[j].x * v[j].x + v[j].y * v[j].y) + (v[j].z * v[j].z + v[j].w * v[j].w); }
            const float r2 = 1.0f / sqrtf(wave_sum(s2) * (1.f / DM) + NORM_EPS);
            unsigned long long* o8 = (unsigned long long*)(XN + (size_t)m * DM) + lane;
#pragma unroll
            for (int j = 0; j < 4; ++j) { const f32x4 g = gm[64 * j];
                o8[64 * j] = (unsigned long long)pk2(v[j].x * r2 * g.x, v[j].y * r2 * g.y) | ((unsigned long long)pk2(v[j].z * r2 * g.z, v[j].w * r2 * g.w) << 32); }
        }
    }
    SEAM(5);
    if (IN(6)) {
        pg8::Gemm g{XN, Wup_t, MTOK, DFF, DM}; pg8::StaticOrder S; S.init(MTOK, DFF, G, bx);
        pg8::EpiBf16<1> E{HB, DFF};
        pg8::gemm_phase<pg8::EpiBf16<1>, pg8::StaticOrder, true, true>(lds, g, S, E);
    }
    SEAM(6);
    if (IN(7)) {
        pg8::Gemm g{HB, Wdown_t, MTOK, DM, DFF}; pg8::StaticOrder S; S.init(MTOK, DM, G, bx);
        pg8::EpiBf16<0> E{MO, DM};
        pg8::gemm_phase<pg8::EpiBf16<0>, pg8::StaticOrder, true, true>(lds, g, S, E);
    }
    SEAM(7);
    if (IN(8)) {
        const f32x4* gp = (const f32x4*)a.in[22] + lane;
        for (int m = gw; m < MTOK; m += NGW) {
            f32x4* orow = (f32x4*)(a.out + (size_t)m * DM) + lane; const u32x2* mr = (const u32x2*)(MO + (size_t)m * DM) + lane;
            f32x4 v[4], y[4]; float s = 0.f;
#pragma unroll
            for (int j = 0; j < 4; ++j) { v[j] = orow[64 * j]; const u32x2 w = mr[64 * j]; y[j] = (f32x4){bflo(w.x), bfhi(w.x), bflo(w.y), bfhi(w.y)};
                s += (y[j].x * y[j].x + y[j].y * y[j].y) + (y[j].z * y[j].z + y[j].w * y[j].w); }
            const float r = 1.0f / sqrtf(wave_sum(s) * (1.f / DM) + NORM_EPS);
#pragma unroll
            for (int j = 0; j < 4; ++j) { const f32x4 g = gp[64 * j]; orow[64 * j] = v[j] + y[j] * r * g; }
        }
    }
#undef IN
#undef SEAM
}

constexpr int NPHASE = 9;
extern "C" void kernel_launch(void* const* d_in, const int* in_sizes, int n_in, void* d_out, int out_size, void* d_ws, size_t ws_size, hipStream_t stream) {
    static int grid = 0;
    if (grid == 0) {
        if (n_in != 25 || in_sizes[0] != MTOK * DM || out_size != MTOK * DM || ws_size < WS_END) {
            fprintf(stderr, "kernel_launch: unexpected shapes (n_in %d in0 %d out %d ws %zu)\n", n_in, n_in > 0 ? in_sizes[0] : -1, out_size, ws_size); grid = -1; return; }
        int dev = 0, cus = 0, per_cu = 0;
        hipGetDevice(&dev); hipDeviceGetAttribute(&cus, hipDeviceAttributeMultiprocessorCount, dev);
        hipFuncSetAttribute((const void*)fwd_kernel, hipFuncAttributeMaxDynamicSharedMemorySize, LDS_BYTES);
        hipOccupancyMaxActiveBlocksPerMultiprocessor(&per_cu, (const void*)fwd_kernel, NTHR, LDS_BYTES);
        if (per_cu < 1) { fprintf(stderr, "kernel_launch: occupancy query says %d blocks/CU\n", per_cu); per_cu = 1; }
        (void)hipGetLastError();
        grid = cus * 1;
    }
    if (grid < 0) return;
    Args a{};
    for (int i = 0; i < 25; ++i) a.in[i] = (const float*)d_in[i];
    a.out = (float*)d_out; a.ws = (unsigned char*)d_ws;
#if MK_COOP
    a.ph_lo = 0; a.ph_hi = NPHASE;
    void* args[] = {&a};
    hipError_t e = hipLaunchCooperativeKernel((const void*)fwd_kernel, dim3(grid), dim3(NTHR), args, LDS_BYTES, stream);
    if (e != hipSuccess) fprintf(stderr, "cooperative launch failed: %s (grid %d)\n", hipGetErrorString(e), grid);
#else
    for (int p = 0; p < NPHASE; ++p) { a.ph_lo = p; a.ph_hi = p + 1; hipLaunchKernelGGL(fwd_kernel, dim3(grid), dim3(NTHR), LDS_BYTES, stream, a); }
#endif
}
```

```cpp
#include <hip/hip_runtime.h>
#include <hip/hip_cooperative_groups.h>
#include <cstdio>
#include <cstdint>
#include <cmath>
namespace cg = cooperative_groups;
#ifndef MK_COOP
#define MK_COOP 1
#endif
namespace pg8 {
#define PG8_LAS __attribute__((address_space(3)))
typedef unsigned short bf16_t;
typedef short bf16x8 __attribute__((ext_vector_type(8)));
typedef float f32x4 __attribute__((ext_vector_type(4)));
typedef unsigned u32x4 __attribute__((ext_vector_type(4)));
constexpr int BM = 256, BK = 64, HALF = 128, HTB = HALF * BK * 2  , STAGE_BYTES = 8 * HTB, NXCD = 8, WGM = 8;

__host__ __device__ __forceinline__ int lds_byte(int r, int c) { const int st = (r >> 4) * 2 + (c >> 5), rr = r & 15, cc = c & 31, ob = rr * 64 + cc * 2; return st * 1024 + (ob ^ (((ob >> 9) & 1) << 5)); }
__host__ __device__ __forceinline__ void stage_rc(int b, int& R, int& C) { const int st = b / 1024, sb = b % 1024, swz = sb ^ (((sb >> 9) & 1) << 5); R = (st >> 1) * 16 + swz / 64; C = (st & 1) * 32 + (swz % 64) / 2; }
__host__ __device__ __forceinline__ int perm32(int rho) { const int n = rho >> 4, i = rho & 15; return 8 * (i >> 2) + 4 * n + (i & 3); }

struct Unit { int pm, pn; };
struct Gemm { const bf16_t* A; const bf16_t* Bt; int M, N, K; };

struct StaticOrder {
    int nM, nN, nwg, G, c;
    __host__ __device__ void init(int M, int N, int G_, int c_) { nM = M / BM; nN = N / BM; nwg = nM * nN; G = G_; c = c_; }
    __host__ __device__ bool next(int i, Unit& u) const {
        const long L = (long)i * G + c; if (L >= nwg) return false;
        int wgid = (int)L; { const int q = nwg / NXCD, r = nwg % NXCD, xcd = wgid % NXCD, off = wgid / NXCD; wgid = (xcd < r ? xcd * (q + 1) : r * (q + 1) + (xcd - r) * q) + off; }
        const int nig = WGM * nN, gid = wgid / nig, fm = gid * WGM, gsz = (nM - fm) < WGM ? (nM - fm) : WGM;
        u.pm = fm + ((wgid % nig) % gsz); u.pn = (wgid % nig) / gsz; return true;
    }
    __device__ __forceinline__ void a_ready(const Unit&) const {}
    __device__ __forceinline__ void done(const Unit&) const {}
};

__device__ __forceinline__ unsigned cvt_pk_bf16(float lo, float hi) { unsigned r; asm volatile("v_cvt_pk_bf16_f32 %0, %1, %2" : "=v"(r) : "v"(lo), "v"(hi)); return r; }
typedef float f32x2 __attribute__((ext_vector_type(2)));
typedef float f32x2 __attribute__((ext_vector_type(2)));
template <int ACT> struct EpiBf16 {
    static constexpr bool PERM = true, AFTER_DRAIN = false;
    bf16_t* O; int ldc;
    __device__ __forceinline__ void operator()(const f32x4 (&acc)[2][2][4][2], const Unit& u, int wr, int wc, int fr, int fq) const {
        const int row0 = u.pm * BM + wr * 64 + fr; const int col0 = u.pn * BM + wc * 32 + 8 * fq;
#pragma unroll
        for (int ai = 0; ai < 2; ++ai)
#pragma unroll
            for (int m = 0; m < 4; ++m) { bf16_t* rowp = O + (size_t)(row0 + ai * HALF + m * 16) * ldc + col0;
#pragma unroll
                for (int bj = 0; bj < 2; ++bj) { f32x4 v0 = acc[ai][bj][m][0], v1 = acc[ai][bj][m][1];
                    if (ACT == 1) {
#pragma unroll
                        for (int j = 0; j < 4; ++j) { float a = v0[j] > 0.f ? v0[j] : 0.f; v0[j] = a * a; float b = v1[j] > 0.f ? v1[j] : 0.f; v1[j] = b * b; } }
                    u32x4 w; w.x = cvt_pk_bf16(v0[0], v0[1]); w.y = cvt_pk_bf16(v0[2], v0[3]); w.z = cvt_pk_bf16(v1[0], v1[1]); w.w = cvt_pk_bf16(v1[2], v1[3]);
                    *(u32x4*)(rowp + bj * HALF) = w; } }
    }
};
struct EpiRope {
    static constexpr bool PERM = true, AFTER_DRAIN = false;
    bf16_t* O; int ldc; const float* rope; float qscale;
    __device__ __forceinline__ void operator()(const f32x4 (&acc)[2][2][4][2], const Unit& u, int wr, int wc, int fr, int fq) const {
        const int row0 = u.pm * BM + wr * 64 + fr; const int col0 = u.pn * BM + wc * 32 + 8 * fq;
        const int g = (wc & 1) * 4 + fq;
        const float sc = (u.pn < 2) ? qscale : 1.0f;
#pragma unroll
        for (int ai = 0; ai < 2; ++ai)
#pragma unroll
            for (int m = 0; m < 4; ++m) { const int row = row0 + ai * HALF + m * 16; const int pos = row & 4095;
                const f32x4 cs0 = *(const f32x4*)(rope + (size_t)pos * 64 + 8 * g), cs1 = *(const f32x4*)(rope + (size_t)pos * 64 + 8 * g + 4);
                const float c[4] = {cs0[0], cs0[2], cs1[0], cs1[2]}, s[4] = {cs0[1], cs0[3], cs1[1], cs1[3]};
                bf16_t* rowp = O + (size_t)row * ldc + col0;
#pragma unroll
                for (int bj = 0; bj < 2; ++bj) { const f32x4 lo = acc[ai][bj][m][0], hi = acc[ai][bj][m][1]; float ol[4], oh[4];
#pragma unroll
                    for (int j = 0; j < 4; ++j) { ol[j] = (lo[j] * c[j] - hi[j] * s[j]) * sc; oh[j] = (hi[j] * c[j] + lo[j] * s[j]) * sc; }
                    u32x4 w; w.x = cvt_pk_bf16(ol[0], ol[1]); w.y = cvt_pk_bf16(ol[2], ol[3]); w.z = cvt_pk_bf16(oh[0], oh[1]); w.w = cvt_pk_bf16(oh[2], oh[3]);
                    *(u32x4*)(rowp + bj * HALF) = w; } }
    }
};
template <class Epi, class Sched, bool ALIGN_EPI = false, bool SP2 = false>
__device__ __forceinline__ void gemm_phase(PG8_LAS unsigned char* lds, const Gemm g, const Sched& S, const Epi& E) {
    const int tid = threadIdx.x, wid = __builtin_amdgcn_readfirstlane(tid >> 6), lane = tid & 63, wr = wid >> 2, wc = wid & 3, fr = lane & 15, fq = lane >> 4;
    const int K = g.K, nt = K / BK;
    unsigned voffA[2], voffB[2];
#pragma unroll
    for (int i = 0; i < 2; ++i) { int R, C; stage_rc(tid * 16 + i * 8192, R, C); const int Rb = Epi::PERM ? ((R & ~31) + perm32(R & 31)) : R;
        voffA[i] = (unsigned)(R * K + C) * 2u; voffB[i] = (unsigned)(Rb * K + C) * 2u; }
    const size_t kstep = (size_t)(BK * 2);
    const size_t hstep = (size_t)HALF * K * 2;
    const size_t tstep = 2 * hstep;
    const unsigned ldsw = (unsigned)wid * 1024u;
    const int aoff = lds_byte(wr * 64 + fr, fq * 8), boff = lds_byte(wc * 32 + fr, fq * 8);
#define PG8_SA(b, h) (((b) * 2 + (h)) * HTB)
#define PG8_SB(b, h) ((4 + (b) * 2 + (h)) * HTB)
#define PG8_STAGE(bufoff, gbase, voff) do { _Pragma("unroll") for (int _i = 0; _i < 2; ++_i) \
        __builtin_amdgcn_global_load_lds((const unsigned*)((const char*)(gbase) + (voff)[_i]), (PG8_LAS unsigned*)(lds + (bufoff) + ldsw + _i * 8192), 16, 0, 0); } while (0)
#define PG8_LDA(dst, b, h) do { _Pragma("unroll") for (int m = 0; m < 4; ++m) _Pragma("unroll") for (int k = 0; k < 2; ++k) dst[m][k] = *(const PG8_LAS bf16x8*)(lds + PG8_SA(b, h) + aoff + m * 2048 + k * 1024); } while (0)
#define PG8_LDB(dst, b, h) do { _Pragma("unroll") for (int n = 0; n < 2; ++n) _Pragma("unroll") for (int k = 0; k < 2; ++k) dst[n][k] = *(const PG8_LAS bf16x8*)(lds + PG8_SB(b, h) + boff + n * 2048 + k * 1024); } while (0)
#define PG8_MMA(ai, bj, At, Bt) do { __builtin_amdgcn_s_setprio(1); _Pragma("unroll") for (int m = 0; m < 4; ++m) _Pragma("unroll") for (int n = 0; n < 2; ++n) _Pragma("unroll") for (int k = 0; k < 2; ++k) \
        acc[ai][bj][m][n] = __builtin_amdgcn_mfma_f32_16x16x32_bf16(Bt[n][k], At[m][k], acc[ai][bj][m][n], 0, 0, 0); __builtin_amdgcn_s_setprio(0); } while (0)
#define PG8_WAIT_V(n) asm volatile("s_waitcnt vmcnt(" #n ")" ::: "memory")
#define PG8_WAIT_L(n) asm volatile("s_waitcnt lgkmcnt(" #n ")" ::: "memory")
#define PG8_BAR __builtin_amdgcn_s_barrier()
#define PG8_SCHED __builtin_amdgcn_sched_barrier(0)
    Unit cur, nxt; int ui = 0;
    if (!S.next(0, cur)) return;
    f32x4 acc[2][2][4][2];
#pragma unroll
    for (int a = 0; a < 2; ++a)
#pragma unroll
        for (int b = 0; b < 2; ++b)
#pragma unroll
            for (int m = 0; m < 4; ++m)
#pragma unroll
                for (int n = 0; n < 2; ++n) acc[a][b][m][n] = (f32x4){0.f, 0.f, 0.f, 0.f};
    bf16x8 At[4][2], B0[2][2], B1[2][2];
    const char* cA = (const char*)g.A + (size_t)cur.pm * tstep; const char* cB = (const char*)g.Bt + (size_t)cur.pn * tstep;
    S.a_ready(cur);
    if constexpr (SP2) {
        PG8_STAGE(PG8_SB(0, 0), cB, voffB); PG8_STAGE(PG8_SB(0, 1), cB + hstep, voffB); PG8_STAGE(PG8_SA(0, 0), cA, voffA); PG8_STAGE(PG8_SA(0, 1), cA + hstep, voffA);
        if (wr == 1) PG8_BAR;
        PG8_WAIT_V(2); PG8_BAR;
        PG8_STAGE(PG8_SB(1, 0), cB + kstep, voffB); PG8_STAGE(PG8_SA(1, 0), cA + kstep, voffA); PG8_STAGE(PG8_SB(1, 1), cB + hstep + kstep, voffB);
        PG8_WAIT_V(6); PG8_BAR;
    } else {
        PG8_STAGE(PG8_SB(0, 0), cB, voffB); PG8_STAGE(PG8_SA(0, 0), cA, voffA); PG8_STAGE(PG8_SB(0, 1), cB + hstep, voffB); PG8_STAGE(PG8_SA(0, 1), cA + hstep, voffA);
        if (wr == 1) PG8_BAR;
        PG8_WAIT_V(4); PG8_BAR;
        PG8_STAGE(PG8_SB(1, 0), cB + kstep, voffB); PG8_STAGE(PG8_SA(1, 0), cA + kstep, voffA); PG8_STAGE(PG8_SB(1, 1), cB + hstep + kstep, voffB);
        PG8_WAIT_V(6); PG8_BAR;
    }
    for (;;) {
        const bool has_next = S.next(ui + 1, nxt);
        const char* nA = has_next ? (const char*)g.A + (size_t)nxt.pm * tstep : cA; const char* nB = has_next ? (const char*)g.Bt + (size_t)nxt.pn * tstep : cB;
        for (int t = 0; t < nt; t += 2) {
            const bool last = (t == nt - 2);
            const char* a1 = cA + (size_t)(t + 1) * kstep;
            const char* a2 = last ? nA : cA + (size_t)(t + 2) * kstep; const char* b2 = last ? nB : cB + (size_t)(t + 2) * kstep;
            const char* a3 = a2 + kstep; const char* b3 = b2 + kstep;
            if (last && has_next) S.a_ready(nxt);
            if constexpr (SP2) {
            PG8_LDB(B0, 0, 0); PG8_LDB(B1, 0, 1); PG8_SCHED; PG8_LDA(At, 0, 0); PG8_STAGE(PG8_SA(1, 1), a1 + hstep, voffA);
            PG8_WAIT_V(8); PG8_WAIT_L(0); PG8_BAR; PG8_MMA(0, 0, At, B0); PG8_MMA(0, 1, At, B1); PG8_BAR; PG8_SCHED;
            PG8_LDA(At, 0, 1); PG8_STAGE(PG8_SB(0, 0), b2, voffB); PG8_STAGE(PG8_SB(0, 1), b2 + hstep, voffB); PG8_STAGE(PG8_SA(0, 0), a2, voffA);
            PG8_WAIT_V(8); PG8_WAIT_L(0); PG8_BAR; PG8_MMA(1, 0, At, B0); PG8_MMA(1, 1, At, B1); PG8_BAR; PG8_SCHED;
            PG8_LDB(B0, 1, 0); PG8_LDB(B1, 1, 1); PG8_SCHED; PG8_LDA(At, 1, 0); PG8_STAGE(PG8_SA(0, 1), a2 + hstep, voffA);
            PG8_WAIT_V(8); PG8_WAIT_L(0); PG8_BAR; PG8_MMA(0, 0, At, B0); PG8_MMA(0, 1, At, B1); PG8_BAR; PG8_SCHED;
            PG8_LDA(At, 1, 1); PG8_STAGE(PG8_SB(1, 0), b3, voffB); PG8_STAGE(PG8_SB(1, 1), b3 + hstep, voffB); PG8_STAGE(PG8_SA(1, 0), a3, voffA);
            PG8_WAIT_V(8); PG8_WAIT_L(0); PG8_BAR; PG8_MMA(1, 0, At, B0); PG8_MMA(1, 1, At, B1); PG8_BAR; PG8_SCHED;
            } else {
            PG8_LDB(B0, 0, 0); PG8_SCHED; PG8_LDA(At, 0, 0); PG8_STAGE(PG8_SA(1, 1), a1 + hstep, voffA);
            PG8_WAIT_L(8); PG8_BAR; PG8_WAIT_L(0); PG8_MMA(0, 0, At, B0); PG8_BAR; PG8_SCHED;
            PG8_LDB(B1, 0, 1); PG8_STAGE(PG8_SB(0, 0), b2, voffB);
            PG8_BAR; PG8_WAIT_L(0); PG8_MMA(0, 1, At, B1); PG8_BAR;
            PG8_LDA(At, 0, 1); PG8_STAGE(PG8_SA(0, 0), a2, voffA);
            PG8_BAR; PG8_WAIT_L(0); PG8_MMA(1, 0, At, B0); PG8_BAR; PG8_SCHED;
            PG8_STAGE(PG8_SB(0, 1), b2 + hstep, voffB);
            PG8_WAIT_V(6); PG8_BAR; PG8_MMA(1, 1, At, B1); PG8_BAR;
            PG8_LDB(B0, 1, 0); PG8_SCHED; PG8_LDA(At, 1, 0); PG8_STAGE(PG8_SA(0, 1), a2 + hstep, voffA);
            PG8_WAIT_L(8); PG8_BAR; PG8_WAIT_L(0); PG8_MMA(0, 0, At, B0); PG8_BAR; PG8_SCHED;
            PG8_LDB(B1, 1, 1); PG8_STAGE(PG8_SB(1, 0), b3, voffB);
            PG8_BAR; PG8_WAIT_L(0); PG8_MMA(0, 1, At, B1); PG8_BAR;
            PG8_LDA(At, 1, 1); PG8_STAGE(PG8_SA(1, 0), a3, voffA);
            PG8_BAR; PG8_WAIT_L(0); PG8_MMA(1, 0, At, B0); PG8_BAR; PG8_SCHED;
            PG8_STAGE(PG8_SB(1, 1), b3 + hstep, voffB);
            PG8_WAIT_V(6); PG8_BAR; PG8_MMA(1, 1, At, B1); PG8_BAR;
            }
        }
        if constexpr (ALIGN_EPI) { if (wr == 0) PG8_BAR; }
        if constexpr (!Epi::AFTER_DRAIN) { E(acc, cur, wr, wc, fr, fq); S.done(cur); }
        if (!has_next) break;
#pragma unroll
        for (int a = 0; a < 2; ++a)
#pragma unroll
            for (int b = 0; b < 2; ++b)
#pragma unroll
                for (int m = 0; m < 4; ++m)
#pragma unroll
                    for (int n = 0; n < 2; ++n) acc[a][b][m][n] = (f32x4){0.f, 0.f, 0.f, 0.f};
        cur = nxt; cA = nA; cB = nB; ++ui;
        if constexpr (ALIGN_EPI) { if (wr == 1) PG8_BAR; }
    }
    PG8_WAIT_V(0);
    if constexpr (!ALIGN_EPI) { if (wr == 0) PG8_BAR; }
    PG8_BAR;
    if constexpr (Epi::AFTER_DRAIN) { E.fused(acc, cur, wr, wc, fr, fq, lds, wid, lane); S.done(cur); }
#undef PG8_SA
#undef PG8_SB
#undef PG8_STAGE
#undef PG8_LDA
#undef PG8_LDB
#undef PG8_MMA
#undef PG8_WAIT_V
#undef PG8_WAIT_L
#undef PG8_BAR
#undef PG8_SCHED
}
}

constexpr int BATCH = 8, SEQ = 4096, DM = 1024, MTOK = BATCH * SEQ, HYW = 512, NIN = 3072, DFF = 4096;
constexpr int NWAVES = 8, NTHR = 512;
constexpr float NORM_EPS = 1e-6f, SUBLN_EPS = 1e-5f;
constexpr float QSCALE = 0.125f * 1.4426950408889634f;
constexpr int HRLEN = 8224;
constexpr size_t MiB = 1u << 20;
constexpr size_t WS_WIN = 0, WS_WOUT = 6 * MiB, WS_WUP = 8 * MiB, WS_WDOWN = 16 * MiB;
constexpr size_t WS_HR = 24 * MiB;
constexpr size_t WS_ROPE = 33 * MiB;
constexpr size_t WS_CTL = 34 * MiB, CTL_BYTES = 16384;
constexpr size_t WS_XN = 40 * MiB;
constexpr size_t WS_MO = 104 * MiB;
constexpr size_t WS_YT = 168 * MiB;
constexpr size_t WS_UVT = 200 * MiB;
constexpr size_t WS_QK = 328 * MiB;
constexpr size_t WS_MIX = 392 * MiB;
constexpr size_t WS_H = 200 * MiB;
constexpr size_t WS_END = 456 * MiB;
constexpr int LDS_BYTES = 135168;

#define LAS __attribute__((address_space(3)))
typedef unsigned short bf16;
typedef unsigned u32x4 __attribute__((ext_vector_type(4)));
typedef unsigned u32x2 __attribute__((ext_vector_type(2)));
typedef float f32x4 __attribute__((ext_vector_type(4)));
typedef float f32x16 __attribute__((ext_vector_type(16)));
typedef short bf16x8 __attribute__((ext_vector_type(8)));
typedef short s16x4 __attribute__((ext_vector_type(4)));

__device__ __forceinline__ unsigned f2bf(float f) { unsigned u = __builtin_bit_cast(unsigned, f); return (u + 0x7fffu + ((u >> 16) & 1u)) >> 16; }
__device__ __forceinline__ unsigned pk2(float lo, float hi) { return f2bf(lo) | (f2bf(hi) << 16); }
typedef float f32x2_t __attribute__((ext_vector_type(2))); typedef __bf16 bf16x2_t __attribute__((ext_vector_type(2)));
__device__ __forceinline__ unsigned cvtpk(float lo, float hi) { f32x2_t v = {lo, hi}; bf16x2_t b = __builtin_convertvector(v, bf16x2_t); return __builtin_bit_cast(unsigned, b); }
__device__ __forceinline__ float bf2f(unsigned short b) { return __builtin_bit_cast(float, (unsigned)b << 16); }
__device__ __forceinline__ float bflo(unsigned w) { return __builtin_bit_cast(float, w << 16); }
__device__ __forceinline__ float bfhi(unsigned w) { return __builtin_bit_cast(float, w & 0xffff0000u); }
__device__ __forceinline__ float wave_sum(float v) {
#pragma unroll
    for (int o = 1; o < 64; o <<= 1) v += __shfl_xor(v, o);
    return v;
}
__device__ __forceinline__ float swap_hi(float v) { return __shfl_xor(v, 32); }
#define LDS_WAIT() asm volatile("s_waitcnt lgkmcnt(0)" ::: "memory")

struct Args { const float* in[25]; float* out; unsigned char* ws; int ph_lo, ph_hi; };

__device__ __forceinline__ int win_src(int n) {
    if (n < 1536) return n;
    if (n < 2048) return n + 1024;
    const int pp = n - 2048, grp = pp >> 6, p = pp & 63, g = p >> 3, e = p & 7;
    const int d = (e < 4) ? (4 * g + e) : (32 + 4 * g + (e - 4));
    return 1536 + grp * 64 + d;
}
template <bool PERMW>
__device__ __forceinline__ void p0_transpose_item(const float* W, int K, int N, bf16* WT, LAS float* scr, int item, int lane) {
    const int nblk = N / 32, kb = item / nblk, nb = item % nblk, k0 = 64 * kb, n0 = 32 * nb;
    const int sc = PERMW ? win_src(n0 + (lane & 31)) : (n0 + (lane & 31));
#pragma unroll 8
    for (int i = 0; i < 32; ++i) { const int kk = 2 * i + (lane >> 5); scr[kk * 33 + (lane & 31)] = W[(size_t)(k0 + kk) * N + sc]; }
    LDS_WAIT(); asm volatile("" ::: "memory");
    const int c = lane & 7;
#pragma unroll
    for (int j = 0; j < 4; ++j) { const int n = (lane >> 3) + 8 * j; const LAS float* s = scr + (8 * c) * 33 + n;
        u32x4 o; o.x = pk2(s[0 * 33], s[1 * 33]); o.y = pk2(s[2 * 33], s[3 * 33]); o.z = pk2(s[4 * 33], s[5 * 33]); o.w = pk2(s[6 * 33], s[7 * 33]);
        *(u32x4*)(WT + (size_t)(n0 + n) * K + k0 + 8 * c) = o; }
    LDS_WAIT(); asm volatile("" ::: "memory");
}
__device__ __forceinline__ void rms_row_to_bf16(const float* xrow, const float* gain, bf16* orow, int lane) {
    const f32x4* xr = (const f32x4*)xrow + lane; const f32x4* gr = (const f32x4*)gain + lane;
    f32x4 v[4]; float s = 0.f;
#pragma unroll
    for (int j = 0; j < 4; ++j) { v[j] = xr[64 * j]; s += (v[j].x * v[j].x + v[j].y * v[j].y) + (v[j].z * v[j].z + v[j].w * v[j].w); }
    const float r = 1.0f / sqrtf(wave_sum(s) * (1.f / DM) + NORM_EPS);
    unsigned long long* o8 = (unsigned long long*)orow + lane;
#pragma unroll
    for (int j = 0; j < 4; ++j) { const f32x4 g = gr[64 * j];
        o8[64 * j] = (unsigned long long)pk2(v[j].x * r * g.x, v[j].y * r * g.y) | ((unsigned long long)pk2(v[j].z * r * g.z, v[j].w * r * g.w) << 32); }
}

__device__ __forceinline__ void filter_item(LAS unsigned char* lds, const Args& a, bf16* HR, int pg, int tid) {
    LAS float* Z = (LAS float*)lds;
    LAS float* HA = Z + 16 * 33;
    LAS float* HB = HA + 16 * 64;
    const float* w1 = a.in[6]; const float* b1 = a.in[7]; const float* w2 = a.in[8]; const float* b2 = a.in[9];
    const float* w3 = a.in[10]; const float* b3 = a.in[11]; const float* w4 = a.in[12]; const float* freq = a.in[13]; const float* fbias = a.in[14];
    const int t0 = 16 * pg;
    for (int i = tid; i < 16 * 33; i += NTHR) { const int p = i / 33, f = i % 33; const int pos = t0 + p; float val;
        if (f == 0) val = (float)pos * (1.0f / (float)(SEQ - 1));
        else { const int j = (f - 1) & 15; const float fj = 1e-4f + (float)j * ((15.0f - 1e-4f) / 15.0f); const float w = (6.283185307179586f / (float)SEQ) * (float)pos; const float arg = fj * w;
            val = (f <= 16) ? cosf(arg) : -sinf(arg); }
        Z[i] = val; }
    __syncthreads();
    for (int o = tid; o < 1024; o += NTHR) { const int p = o >> 6, n = o & 63; float acc = b1[n];
#pragma unroll 3
        for (int f = 0; f < 33; ++f) acc += Z[p * 33 + f] * w1[f * 64 + n];
        HA[o] = sinf(freq[n] * acc); }
    __syncthreads();
    for (int o = tid; o < 1024; o += NTHR) { const int p = o >> 6, n = o & 63; float acc = b2[n];
#pragma unroll 4
        for (int f = 0; f < 64; ++f) acc += HA[p * 64 + f] * w2[f * 64 + n];
        HB[o] = sinf(freq[n] * acc); }
    __syncthreads();
    for (int o = tid; o < 1024; o += NTHR) { const int p = o >> 6, n = o & 63; float acc = b3[n];
#pragma unroll 4
        for (int f = 0; f < 64; ++f) acc += HB[p * 64 + f] * w3[f * 64 + n];
        HA[o] = sinf(freq[n] * acc); }
    __syncthreads();
    {   const int c = tid;
        float af[16], ab[16];
#pragma unroll
        for (int p = 0; p < 16; ++p) { af[p] = 0.f; ab[p] = 0.f; }
#pragma unroll 2
        for (int k = 0; k < 64; ++k) { const float wf = w4[k * 1024 + c], wb = w4[k * 1024 + 512 + c];
#pragma unroll
            for (int p = 0; p < 16; ++p) { const float hv = HA[p * 64 + k]; af[p] += hv * wf; ab[p] += hv * wb; } }
        const float min_decay = -4.605170185988091f / 1.5f, max_decay = -4.605170185988091f / 0.3f;
        const float adelta = fabsf(min_decay + (float)c * ((max_decay - min_decay) / 511.0f));
        bf16* hr = HR + (size_t)c * HRLEN;
#pragma unroll
        for (int p = 0; p < 16; ++p) { const int pos = t0 + p; const float tl = (float)pos * (1.0f / (float)(SEQ - 1)); const float dec = expf(-tl * adelta);
            const float vf = af[p] * dec, vb = ab[p] * dec;
            if (pos == 0) hr[4096] = (bf16)f2bf(vf + vb + fbias[c]);
            else { hr[4096 - pos] = (bf16)f2bf(vf); hr[4096 + pos] = (bf16)f2bf(vb); } }
        if (pg == 0) { hr[0] = 0; for (int i = 8192; i < HRLEN; ++i) hr[i] = 0; }
    }
    __syncthreads();
}

namespace att {
constexpr int KP = 272, VP = 136, KBUF = 64 * KP, VBUF = 128 * VP, STG = KBUF + VBUF;
constexpr int NT = SEQ / 64;
__device__ __forceinline__ void unit(LAS unsigned char* lds, const bf16* QK, const bf16* UVT, bf16* MIX, const float* sgain, float lam, int b, int h, int qb) {
    const int tid = threadIdx.x, lane = tid & 63, r32 = lane & 31, hi = lane >> 5; const int wid = __builtin_amdgcn_readfirstlane(tid >> 6);
    const int qsub = wid & 3, c = wid >> 2;
    const size_t rowbase = (size_t)b * SEQ; const int q0 = qb * 128 + qsub * 32;
    bf16x8 qr[4];
    { const bf16* qp = QK + (rowbase + q0 + r32) * 1024 + h * 128 + c * 64 + hi * 8;
#pragma unroll
      for (int ds = 0; ds < 4; ++ds) qr[ds] = *(const bf16x8*)(qp + ds * 16); }
    const bf16* gk[2]; const bf16* gv[2]; int lk[2], lv[2];
#pragma unroll
    for (int i = 0; i < 2; ++i) { const int id = tid + NTHR * i; const int kr = id >> 4, kc = id & 15; const int ve = id >> 3, vc = id & 7;
        gk[i] = QK + (rowbase + kr) * 1024 + 512 + h * 128 + kc * 8; lk[i] = kr * KP + kc * 16;
        gv[i] = UVT + (size_t)(1536 + h * 128 + ve) * MTOK + rowbase + vc * 8; lv[i] = KBUF + ve * VP + vc * 16; }
    u32x4 pk[2], pv[2];
#pragma unroll
    for (int i = 0; i < 2; ++i) { pk[i] = *(const u32x4*)gk[i]; pv[i] = *(const u32x4*)gv[i]; }
#pragma unroll
    for (int i = 0; i < 2; ++i) { *(LAS u32x4*)(lds + lk[i]) = pk[i]; *(LAS u32x2*)(lds + lv[i]) = (u32x2){pv[i].x, pv[i].y}; *(LAS u32x2*)(lds + lv[i] + 8) = (u32x2){pv[i].z, pv[i].w}; }
    __syncthreads();
    f32x16 o[4];
#pragma unroll
    for (int e = 0; e < 4; ++e) o[e] = (f32x16){};
    float mref = -1e30f, lsum = 0.f;
    for (int t = 0; t < NT; ++t) {
        LAS unsigned char* st = lds + (t & 1) * STG;
        LAS unsigned char* nx = lds + ((t + 1) & 1) * STG;
        const bool more = (t + 1 < NT);
        if (more) {
#pragma unroll
            for (int i = 0; i < 2; ++i) { pk[i] = *(const u32x4*)(gk[i] + (size_t)(t + 1) * 64 * 1024); pv[i] = *(const u32x4*)(gv[i] + (size_t)(t + 1) * 64); } }
        f32x16 s0 = (f32x16){}, s1 = (f32x16){};
        { const LAS unsigned char* kb = st + r32 * KP + c * 128 + hi * 16;
#pragma unroll
          for (int ds = 0; ds < 4; ++ds) { const bf16x8 a0 = *(const LAS bf16x8*)(kb + ds * 32), a1 = *(const LAS bf16x8*)(kb + 32 * KP + ds * 32);
              s0 = __builtin_amdgcn_mfma_f32_32x32x16_bf16(a0, qr[ds], s0, 0, 0, 0); s1 = __builtin_amdgcn_mfma_f32_32x32x16_bf16(a1, qr[ds], s1, 0, 0, 0); } }
        float mx = fmaxf(s0[0], s1[0]);
#pragma unroll
        for (int r = 1; r < 16; ++r) mx = fmaxf(mx, fmaxf(s0[r], s1[r]));
        mx = fmaxf(mx, swap_hi(mx));
        if (__any(mx > mref + 8.0f)) { const float mnew = fmaxf(mref, mx); const float al = __builtin_amdgcn_exp2f(mref - mnew);
#pragma unroll
            for (int e = 0; e < 4; ++e)
#pragma unroll
                for (int r = 0; r < 16; ++r) o[e][r] *= al;
            lsum *= al; mref = mnew; }
        float ps = 0.f;
#pragma unroll
        for (int r = 0; r < 16; ++r) { s0[r] = __builtin_amdgcn_exp2f(s0[r] - mref); s1[r] = __builtin_amdgcn_exp2f(s1[r] - mref); ps += s0[r] + s1[r]; }
        lsum += ps;
        { const LAS unsigned char* vb = st + KBUF + r32 * VP + hi * 8;
#pragma unroll
          for (int ks = 0; ks < 4; ++ks) { u32x4 pw;
              if (ks < 2) { const int bs = 8 * (ks & 1); pw.x = cvtpk(s0[bs], s0[bs + 1]); pw.y = cvtpk(s0[bs + 2], s0[bs + 3]); pw.z = cvtpk(s0[bs + 4], s0[bs + 5]); pw.w = cvtpk(s0[bs + 6], s0[bs + 7]); }
              else { const int bs = 8 * (ks & 1); pw.x = cvtpk(s1[bs], s1[bs + 1]); pw.y = cvtpk(s1[bs + 2], s1[bs + 3]); pw.z = cvtpk(s1[bs + 4], s1[bs + 5]); pw.w = cvtpk(s1[bs + 6], s1[bs + 7]); }
              const bf16x8 pb = __builtin_bit_cast(bf16x8, pw);
#pragma unroll
              for (int e = 0; e < 4; ++e) { const u32x2 v0 = *(const LAS u32x2*)(vb + e * 32 * VP + ks * 32), v1 = *(const LAS u32x2*)(vb + e * 32 * VP + ks * 32 + 16);
                  const bf16x8 va = __builtin_bit_cast(bf16x8, (u32x4){v0.x, v0.y, v1.x, v1.y});
                  o[e] = __builtin_amdgcn_mfma_f32_32x32x16_bf16(va, pb, o[e], 0, 0, 0); } } }
        if (more) {
#pragma unroll
            for (int i = 0; i < 2; ++i) { *(LAS u32x4*)(nx + lk[i]) = pk[i]; *(LAS u32x2*)(nx + lv[i]) = (u32x2){pv[i].x, pv[i].y}; *(LAS u32x2*)(nx + lv[i] + 8) = (u32x2){pv[i].z, pv[i].w}; } }
        __syncthreads();
    }
    lsum += swap_hi(lsum);
    const float sc = (c == 0) ? (1.0f / lsum) : (lam / lsum);
    LAS float* X = (LAS float*)lds + qsub * (128 * 32);
    if (c == 1) {
#pragma unroll
        for (int e = 0; e < 4; ++e)
#pragma unroll
            for (int r = 0; r < 16; ++r) { const int ee = 32 * e + (r & 3) + 8 * (r >> 2) + 4 * hi; X[ee * 32 + r32] = o[e][r] * sc; } }
    __syncthreads();
    if (c == 0) { float ss = 0.f;
#pragma unroll
        for (int e = 0; e < 4; ++e)
#pragma unroll
            for (int r = 0; r < 16; ++r) { const int ee = 32 * e + (r & 3) + 8 * (r >> 2) + 4 * hi; const float v = o[e][r] * sc - X[ee * 32 + r32]; o[e][r] = v; ss += v * v; }
        ss += swap_hi(ss);
        const float rs = (1.0f / sqrtf(ss * (1.0f / 128.0f) + SUBLN_EPS)) * 0.8f;
        bf16* op = MIX + (rowbase + q0 + r32) * 1024 + 512 + h * 128;
#pragma unroll
        for (int e = 0; e < 4; ++e)
#pragma unroll
            for (int q4 = 0; q4 < 4; ++q4) { const int ee = 32 * e + 8 * q4 + 4 * hi; const f32x4 g = *(const f32x4*)(sgain + ee);
                u32x2 w; w.x = cvtpk(o[e][4 * q4] * rs * g.x, o[e][4 * q4 + 1] * rs * g.y); w.y = cvtpk(o[e][4 * q4 + 2] * rs * g.z, o[e][4 * q4 + 3] * rs * g.w);
                *(u32x2*)(op + ee) = w; } }
    __syncthreads();
}
}

namespace hy {
constexpr int UP = 264, UBUF = 32 * UP * 2, HRB = HRLEN * 2;
constexpr int NCH = 17;
__device__ __forceinline__ float ldbf(const bf16* p) { return bf2f(*p); }
__device__ __forceinline__ void stage(LAS unsigned char* ub, const bf16* X1, const bf16* V, const float (&w1)[4], const float (&wv)[4], int j, int tid) {
    for (int it = tid; it < 520; it += NTHR) { const int b = it / 65, tt = it - b * 65; const int s0 = 256 * j - 4 + 4 * tt;
        float g[4] = {0.f, 0.f, 0.f, 0.f};
        if (s0 >= 0 && s0 < SEQ) { const bf16* x1p = X1 + (size_t)b * SEQ + s0; const bf16* vp = V + (size_t)b * SEQ + s0;
            const u32x2 xa = *(const u32x2*)x1p, va = *(const u32x2*)vp;
            float xs[6], vs[6];
            xs[0] = (s0 > 0) ? ldbf(x1p - 1) : 0.f; vs[0] = (s0 > 0) ? ldbf(vp - 1) : 0.f;
            xs[5] = (s0 + 4 < SEQ) ? ldbf(x1p + 4) : 0.f; vs[5] = (s0 + 4 < SEQ) ? ldbf(vp + 4) : 0.f;
            xs[1] = bflo(xa.x); xs[2] = bfhi(xa.x); xs[3] = bflo(xa.y); xs[4] = bfhi(xa.y);
            vs[1] = bflo(va.x); vs[2] = bfhi(va.x); vs[3] = bflo(va.y); vs[4] = bfhi(va.y);
#pragma unroll
            for (int i = 0; i < 4; ++i) { const float cx = w1[0] * xs[i] + w1[1] * xs[i + 1] + w1[2] * xs[i + 2] + w1[3]; const float cv = wv[0] * vs[i] + wv[1] * vs[i + 1] + wv[2] * vs[i + 2] + wv[3]; g[i] = cx * cv; } }
        LAS bf16* U = (LAS bf16*)ub;
#pragma unroll
        for (int r = 0; r < 4; ++r)
#pragma unroll
            for (int i = 0; i < 4; ++i) { const int kk = 4 * tt + i - r; if (kk >= 0 && kk < 256) U[(4 * b + r) * UP + kk] = (bf16)f2bf(g[i]); } }
}
__device__ __forceinline__ void channel(LAS unsigned char* lds, const bf16* UVT, const bf16* HR, const float* conv_w, const float* conv_b, bf16* YT, int c) {
    const int tid = threadIdx.x, lane = tid & 63, r32 = lane & 31, hi = lane >> 5; const int wid = __builtin_amdgcn_readfirstlane(tid >> 6);
    const bf16* X0 = UVT + (size_t)c * MTOK; const bf16* X1 = UVT + (size_t)(512 + c) * MTOK; const bf16* V = UVT + (size_t)(1024 + c) * MTOK;
    float w0[4], w1[4], wv[4];
#pragma unroll
    for (int k = 0; k < 3; ++k) { w0[k] = conv_w[k * 1536 + c]; w1[k] = conv_w[k * 1536 + 512 + c]; wv[k] = conv_w[k * 1536 + 1024 + c]; }
    w0[3] = conv_b[c]; w1[3] = conv_b[512 + c]; wv[3] = conv_b[1024 + c];
    for (int i = tid; i < HRB / 16; i += NTHR) ((LAS u32x4*)lds)[i] = ((const u32x4*)(HR + (size_t)c * HRLEN))[i];
    LAS unsigned char* ub0 = lds + HRB;
    stage(ub0, X1, V, w1, wv, 0, tid);
    __syncthreads();
    f32x16 acc[4];
#pragma unroll
    for (int n = 0; n < 4; ++n) acc[n] = (f32x16){};
    const int hb0 = (4096 - 4 * (128 * wid + r32) - 4 + 8 * hi) * 2;
    for (int j = 0; j < NCH; ++j) {
        LAS unsigned char* ucur = ub0 + (j & 1) * UBUF;
        if (j + 1 < NCH) stage(ub0 + ((j + 1) & 1) * UBUF, X1, V, w1, wv, j + 1, tid);
        const int nks = (j < NCH - 1) ? 16 : 1;
        const LAS unsigned char* ua = ucur + r32 * (UP * 2) + hi * 16;
        const LAS unsigned char* hp = lds + hb0 + j * 512;
#pragma unroll 4
        for (int ks = 0; ks < nks; ++ks) { const bf16x8 a = *(const LAS bf16x8*)(ua + ks * 32);
#pragma unroll
            for (int n = 0; n < 4; ++n) { const LAS unsigned char* p = hp + ks * 32 - n * 256; const u32x2 b0 = *(const LAS u32x2*)p, b1 = *(const LAS u32x2*)(p + 8);
                const bf16x8 bb = __builtin_bit_cast(bf16x8, (u32x4){b0.x, b0.y, b1.x, b1.y});
                acc[n] = __builtin_amdgcn_mfma_f32_32x32x16_bf16(a, bb, acc[n], 0, 0, 0); } }
        __syncthreads();
    }
#pragma unroll
    for (int n = 0; n < 4; ++n) { const int t = 4 * (128 * wid + 32 * n + r32);
#pragma unroll
        for (int q = 0; q < 4; ++q) { const int b = 2 * q + hi; const bf16* xp = X0 + (size_t)b * SEQ + t; const u32x2 xa = *(const u32x2*)xp; float xs[6];
            xs[0] = (t > 0) ? ldbf(xp - 1) : 0.f; xs[5] = (t + 4 < SEQ) ? ldbf(xp + 4) : 0.f;
            xs[1] = bflo(xa.x); xs[2] = bfhi(xa.x); xs[3] = bflo(xa.y); xs[4] = bfhi(xa.y);
            float y[4];
#pragma unroll
            for (int i = 0; i < 4; ++i) y[i] = acc[n][4 * q + i] * (w0[0] * xs[i] + w0[1] * xs[i + 1] + w0[2] * xs[i + 2] + w0[3]);
            u32x2 w; w.x = pk2(y[0], y[1]); w.y = pk2(y[2], y[3]);
            *(u32x2*)(YT + (size_t)c * MTOK + (size_t)b * SEQ + t) = w; } }
    __syncthreads();
}
}

#define XB_TMO      128
#define XB_XCNT(j)  (256  + 64 * (j))
#define XB_XSUB(j)  (1280 + 64 * (j))
#define XB_XGEN(j)  (2304 + 64 * (j))
#define XB_TOP      3328
#define XB_TOPGEN   3392
#define XCD_BAR_WORDS 3456
#define XB_SPIN_CAP (1u << 18)

__device__ __forceinline__ unsigned xb_ld(unsigned* p)              { return __hip_atomic_load(p, __ATOMIC_RELAXED, __HIP_MEMORY_SCOPE_AGENT); }
__device__ __forceinline__ unsigned xb_add(unsigned* p, unsigned v) { return __hip_atomic_fetch_add(p, v, __ATOMIC_RELAXED, __HIP_MEMORY_SCOPE_AGENT); }
__device__ __forceinline__ unsigned xb_xcc_id() { return (unsigned)__builtin_amdgcn_s_getreg((3 << 11) | 20) & 0xFu; }
#define XB_SPIN(cond, bar) do { unsigned _sp = 0; while (cond) { __builtin_amdgcn_s_sleep(1); \
    if ((++_sp & 255u) == 0u) { if (xb_ld(&(bar)[XB_TMO])) break; if (_sp > XB_SPIN_CAP) { atomicAdd(&(bar)[XB_TMO], 1u); break; } } } } while (0)

struct XcdBarrier {
    unsigned* bar; unsigned x;
    volatile LAS unsigned* st;
};

__device__ __forceinline__ XcdBarrier xcd_barrier_post(unsigned* bar, volatile LAS unsigned* st) {
    XcdBarrier b; b.bar = bar; b.x = xb_xcc_id(); b.st = st;
    if (threadIdx.x == 0) (void)xb_add(&bar[XB_XCNT(b.x)], 1u);
    return b;
}
__device__ __forceinline__ void xcd_barrier_complete(unsigned* bar, unsigned x, unsigned& nloc, unsigned& nx) {
    const unsigned G = gridDim.x * gridDim.y * gridDim.z;
    unsigned sum, cnt, mine, sp = 0u;
    for (;;) {
        sum = 0u; cnt = 0u; mine = 0u;
#pragma unroll
        for (unsigned j = 0; j < 16; ++j) { const unsigned c = xb_ld(&bar[XB_XCNT(j)]); sum += c; cnt += (c > 0u) ? 1u : 0u; mine = (j == x) ? c : mine; }
        if (sum == G) break;
        __builtin_amdgcn_s_sleep(1);
        if ((++sp & 255u) == 0u) { if (xb_ld(&bar[XB_TMO])) break; if (sp > XB_SPIN_CAP) { atomicAdd(&bar[XB_TMO], 1u); break; } }
    }
    nloc = mine > 0u ? mine : 1u; nx = cnt > 0u ? cnt : 1u;
}

__device__ __forceinline__ void xcd_barrier(const XcdBarrier& b) {
    asm volatile("s_waitcnt vmcnt(0)" ::: "memory");
    __syncthreads();
    if (threadIdx.x == 0) {
        unsigned* bar = b.bar;
        __builtin_amdgcn_s_waitcnt(0);
        unsigned nloc = b.st[0], nx = b.st[1];
        if (nloc == 0u) { xcd_barrier_complete(bar, b.x, nloc, nx); b.st[0] = nloc; b.st[1] = nx; }
        const unsigned old = xb_add(&bar[XB_XSUB(b.x)], 1u);
        const unsigned gen = old / nloc;
        if (old + 1u == (gen + 1u) * nloc) {
            __builtin_amdgcn_fence(__ATOMIC_RELEASE, "agent");
            asm volatile("s_waitcnt vmcnt(0)" ::: "memory");
            const unsigned og = xb_add(&bar[XB_TOP], 1u);
            const unsigned tg = og / nx;
            if (og + 1u == (tg + 1u) * nx) xb_add(&bar[XB_TOPGEN], 1u);
            else XB_SPIN(xb_ld(&bar[XB_TOPGEN]) == tg, bar);
            __builtin_amdgcn_fence(__ATOMIC_ACQUIRE, "agent");
            xb_add(&bar[XB_XGEN(b.x)], 1u);
            asm volatile("s_waitcnt vmcnt(0)" ::: "memory");
        } else {
            XB_SPIN(xb_ld(&bar[XB_XGEN(b.x)]) == gen, bar);
            __builtin_amdgcn_fence(__ATOMIC_ACQUIRE, "agent");
            asm volatile("s_waitcnt vmcnt(0)" ::: "memory");
        }
    }
    __syncthreads();
}

__global__ void __launch_bounds__(NTHR, 2) fwd_kernel(Args a) {
    extern __shared__ __attribute__((aligned(16))) unsigned char lds_raw[];
    LAS unsigned char* lds = (LAS unsigned char*)lds_raw;
    const int tid = threadIdx.x, lane = tid & 63; const int wave = __builtin_amdgcn_readfirstlane(tid >> 6);
    const int G = gridDim.x, bx = blockIdx.x;
    const int gw = bx * NWAVES + wave, NGW = G * NWAVES;
    unsigned char* ws = a.ws;
    bf16* Win_t = (bf16*)(ws + WS_WIN); bf16* Wout_t = (bf16*)(ws + WS_WOUT); bf16* Wup_t = (bf16*)(ws + WS_WUP); bf16* Wdown_t = (bf16*)(ws + WS_WDOWN);
    bf16* HR = (bf16*)(ws + WS_HR); float* ROPE = (float*)(ws + WS_ROPE);
    bf16* XN = (bf16*)(ws + WS_XN); bf16* MO = (bf16*)(ws + WS_MO); bf16* YT = (bf16*)(ws + WS_YT); bf16* UVT = (bf16*)(ws + WS_UVT);
    bf16* QK = (bf16*)(ws + WS_QK); bf16* MIX = (bf16*)(ws + WS_MIX); bf16* HB = (bf16*)(ws + WS_H);
    const float* x = a.in[0];
    const int lo = a.ph_lo, hi_ph = a.ph_hi;
#if MK_COOP
    cg::grid_group grid = cg::this_grid();
    volatile LAS unsigned* bst = (volatile LAS unsigned*)(lds + 131072 + 64);
    if (tid < 4) bst[tid] = 0u;
    __syncthreads();
    XcdBarrier xbar = xcd_barrier_post((unsigned*)(ws + WS_CTL), bst);
#define SEAM(k) do { if (lo <= (k) && (k) + 1 < hi_ph) { if ((k) == 0) grid.sync(); else xcd_barrier(xbar); } } while (0)
#else
#define SEAM(k) do { } while (0)
#endif
#ifndef PHMASK
#define PHMASK 0x1ff
#endif
#define IN(k) (((PHMASK >> (k)) & 1) && lo <= (k) && (k) < hi_ph)

    if (IN(0)) {
        LAS float* scr = (LAS float*)(lds + wave * 16384);
        constexpr int I_IN = (DM / 64) * (NIN / 32), I_OUT = (DM / 64) * (DM / 32), I_UP = (DM / 64) * (DFF / 32), I_DN = (DFF / 64) * (DM / 32);
        for (int it = gw; it < I_IN + I_OUT + I_UP + I_DN; it += NGW) { int r = it;
            if (r < I_IN) { p0_transpose_item<true>(a.in[3], DM, NIN, Win_t, scr, r, lane); continue; } r -= I_IN;
            if (r < I_OUT) { p0_transpose_item<false>(a.in[20], DM, DM, Wout_t, scr, r, lane); continue; } r -= I_OUT;
            if (r < I_UP) { p0_transpose_item<false>(a.in[23], DM, DFF, Wup_t, scr, r, lane); continue; } r -= I_UP;
            p0_transpose_item<false>(a.in[24], DFF, DM, Wdown_t, scr, r, lane); }
        for (int m = gw; m < MTOK; m += NGW) rms_row_to_bf16(x + (size_t)m * DM, a.in[1], XN + (size_t)m * DM, lane);
        for (int i = bx * NTHR + tid; i < SEQ * 32; i += G * NTHR) { const int pos = i >> 5, k = i & 31;
            const float inv = exp2f(-(float)(2 * k) * (13.287712379549449f / 64.0f)); const float ang = (float)pos * inv;
            ROPE[2 * i] = cosf(ang); ROPE[2 * i + 1] = sinf(ang); }
        __syncthreads();
        for (int pg = bx; pg < SEQ / 16; pg += G) filter_item(lds, a, HR, pg, tid);
    }
    SEAM(0);
    if (IN(1)) {
        { pg8::Gemm g{Win_t, XN, 2048, MTOK, DM}; pg8::StaticOrder S; S.init(2048, MTOK, G, bx);
          pg8::EpiBf16<0> E{UVT, MTOK};
          pg8::gemm_phase<pg8::EpiBf16<0>, pg8::StaticOrder, true, true>(lds, g, S, E); }
        { pg8::Gemm g{XN, Win_t + (size_t)2048 * DM, MTOK, 1024, DM}; pg8::StaticOrder S; S.init(MTOK, 1024, G, bx);
          pg8::EpiRope E{QK, 1024, ROPE, QSCALE};
          pg8::gemm_phase<pg8::EpiRope, pg8::StaticOrder, true, true>(lds, g, S, E); }
    }
    SEAM(1);
    if (IN(2)) {
        float lam;
        { const float p1 = a.in[15][lane] * a.in[16][lane], p2 = a.in[17][lane] * a.in[18][lane];
          lam = expf(wave_sum(p1)) - expf(wave_sum(p2)) + 0.2f; }
#ifndef DUP_ATT
#define DUP_ATT 1
#endif
#ifndef DUP_HY
#define DUP_HY 1
#endif
        for (int rep = 0; rep < DUP_ATT; ++rep)
        for (int u = bx; u < 1024; u += G) { const int bh = (u & 7) + 8 * (u >> 8), qb = (u >> 3) & 31;
            att::unit(lds, QK, UVT, MIX, a.in[19], lam, bh >> 2, bh & 3, qb); }
        for (int rep = 0; rep < DUP_HY; ++rep)
        for (int c = bx; c < HYW; c += G) hy::channel(lds, UVT, HR, a.in[4], a.in[5], YT, c);
    }
    SEAM(2);
    if (IN(3)) {
        LAS unsigned short* scr = (LAS unsigned short*)(lds + wave * 16384);
        for (int it = gw; it < 8 * (MTOK / 64); it += NGW) { const int ct = it & 7, mt = it >> 3; const int c0 = 64 * ct, m0 = 64 * mt;
#pragma unroll
            for (int i = 0; i < 8; ++i) { const int cc = 8 * i + (lane >> 3), mch = lane & 7; const u32x4 v = *(const u32x4*)(YT + (size_t)(c0 + cc) * MTOK + m0 + 8 * mch);
                LAS unsigned* d = (LAS unsigned*)(scr + cc * 66 + 8 * mch); d[0] = v.x; d[1] = v.y; d[2] = v.z; d[3] = v.w; }
            LDS_WAIT(); asm volatile("" ::: "memory");
#pragma unroll
            for (int i = 0; i < 8; ++i) { const int mm = 8 * i + (lane >> 3), cch = lane & 7; const LAS unsigned short* s = scr + (8 * cch) * 66 + mm;
                u32x4 o; o.x = (unsigned)s[0] | ((unsigned)s[66] << 16); o.y = (unsigned)s[2 * 66] | ((unsigned)s[3 * 66] << 16);
                o.z = (unsigned)s[4 * 66] | ((unsigned)s[5 * 66] << 16); o.w = (unsigned)s[6 * 66] | ((unsigned)s[7 * 66] << 16);
                *(u32x4*)(MIX + (size_t)(m0 + mm) * 1024 + c0 + 8 * cch) = o; }
            LDS_WAIT(); asm volatile("" ::: "memory"); }
        __syncthreads();
    }
    SEAM(3);
    if (IN(4)) {
        pg8::Gemm g{MIX, Wout_t, MTOK, DM, DM}; pg8::StaticOrder S; S.init(MTOK, DM, G, bx);
        pg8::EpiBf16<0> E{MO, DM};
        pg8::gemm_phase<pg8::EpiBf16<0>, pg8::StaticOrder, true, true>(lds, g, S, E);
    }
    SEAM(4);
    if (IN(5)) {
        const f32x4* gp = (const f32x4*)a.in[2] + lane; const f32x4* gm = (const f32x4*)a.in[21] + lane;
        for (int m = gw; m < MTOK; m += NGW) {
            const f32x4* xr = (const f32x4*)(x + (size_t)m * DM) + lane; const u32x2* mr = (const u32x2*)(MO + (size_t)m * DM) + lane;
            f32x4 v[4], y[4]; float s = 0.f;
#pragma unroll
            for (int j = 0; j < 4; ++j) { v[j] = xr[64 * j]; const u32x2 w = mr[64 * j]; y[j] = (f32x4){bflo(w.x), bfhi(w.x), bflo(w.y), bfhi(w.y)};
                s += (y[j].x * y[j].x + y[j].y * y[j].y) + (y[j].z * y[j].z + y[j].w * y[j].w); }
            const float r = 1.0f / sqrtf(wave_sum(s) * (1.f / DM) + NORM_EPS); float s2 = 0.f;
            f32x4* orow = (f32x4*)(a.out + (size_t)m * DM) + lane;
#pragma unroll
            for (int j = 0; j < 4; ++j) { const f32x4 g = gp[64 * j]; v[j] = v[j] + y[j] * r * g; orow[64 * j] = v[j];
                s2 += (v[j].x * v[j].x + v[j].y * v[j].y) + (v[j].z * v[j].z + v[j].w * v[j].w); }
            const float r2 = 1.0f / sqrtf(wave_sum(s2) * (1.f / DM) + NORM_EPS);
            unsigned long long* o8 = (unsigned long long*)(XN + (size_t)m * DM) + lane;
#pragma unroll
            for (int j = 0; j < 4; ++j) { const f32x4 g = gm[64 * j];
                o8[64 * j] = (unsigned long long)pk2(v[j].x * r2 * g.x, v[j].y * r2 * g.y) | ((unsigned long long)pk2(v[j].z * r2 * g.z, v[j].w * r2 * g.w) << 32); }
        }
    }
    SEAM(5);
    if (IN(6)) {
        pg8::Gemm g{XN, Wup_t, MTOK, DFF, DM}; pg8::StaticOrder S; S.init(MTOK, DFF, G, bx);
        pg8::EpiBf16<1> E{HB, DFF};
        pg8::gemm_phase<pg8::EpiBf16<1>, pg8::StaticOrder, true, true>(lds, g, S, E);
    }
    SEAM(6);
    if (IN(7)) {
        pg8::Gemm g{HB, Wdown_t, MTOK, DM, DFF}; pg8::StaticOrder S; S.init(MTOK, DM, G, bx);
        pg8::EpiBf16<0> E{MO, DM};
        pg8::gemm_phase<pg8::EpiBf16<0>, pg8::StaticOrder, true, true>(lds, g, S, E);
    }
    SEAM(7);
    if (IN(8)) {
        const f32x4* gp = (const f32x4*)a.in[22] + lane;
        for (int m = gw; m < MTOK; m += NGW) {
            f32x4* orow = (f32x4*)(a.out + (size_t)m * DM) + lane; const u32x2* mr = (const u32x2*)(MO + (size_t)m * DM) + lane;
            f32x4 v[4], y[4]; float s = 0.f;
#pragma unroll
            for (int j = 0; j < 4; ++j) { v[j] = orow[64 * j]; const u32x2 w = mr[64 * j]; y[j] = (f32x4){bflo(w.x), bfhi(w.x), bflo(w.y), bfhi(w.y)};
                s += (y[j].x * y[j].x + y[j].y * y[j].y) + (y[j].z * y[j].z + y[j].w * y[j].w); }
            const float r = 1.0f / sqrtf(wave_sum(s) * (1.f / DM) + NORM_EPS);
#pragma unroll
            for (int j = 0; j < 4; ++j) { const f32x4 g = gp[64 * j]; orow[64 * j] = v[j] + y[j] * r * g; }
        }
    }
#undef IN
#undef SEAM
}

constexpr int NPHASE = 9;
extern "C" void kernel_launch(void* const* d_in, const int* in_sizes, int n_in, void* d_out, int out_size, void* d_ws, size_t ws_size, hipStream_t stream) {
    static int grid = 0;
    if (grid == 0) {
        if (n_in != 25 || in_sizes[0] != MTOK * DM || out_size != MTOK * DM || ws_size < WS_END) {
            fprintf(stderr, "kernel_launch: unexpected shapes (n_in %d in0 %d out %d ws %zu)\n", n_in, n_in > 0 ? in_sizes[0] : -1, out_size, ws_size); grid = -1; return; }
        int dev = 0, cus = 0, per_cu = 0;
        hipGetDevice(&dev); hipDeviceGetAttribute(&cus, hipDeviceAttributeMultiprocessorCount, dev);
        hipFuncSetAttribute((const void*)fwd_kernel, hipFuncAttributeMaxDynamicSharedMemorySize, LDS_BYTES);
        hipOccupancyMaxActiveBlocksPerMultiprocessor(&per_cu, (const void*)fwd_kernel, NTHR, LDS_BYTES);
        if (per_cu < 1) { fprintf(stderr, "kernel_launch: occupancy query says %d blocks/CU\n", per_cu); per_cu = 1; }
        (void)hipGetLastError();
        grid = cus * 1;
    }
    if (grid < 0) return;
    Args a{};
    for (int i = 0; i < 25; ++i) a.in[i] = (const float*)d_in[i];
    a.out = (float*)d_out; a.ws = (unsigned char*)d_ws;
#if MK_COOP
    a.ph_lo = 0; a.ph_hi = NPHASE;
    if (hipMemsetAsync((unsigned char*)d_ws + WS_CTL, 0, CTL_BYTES, stream) != hipSuccess) { fprintf(stderr, "kernel_launch: memset of the barrier words failed\n"); return; }
    void* args[] = {&a};
    hipError_t e = hipLaunchCooperativeKernel((const void*)fwd_kernel, dim3(grid), dim3(NTHR), args, LDS_BYTES, stream);
    if (e != hipSuccess) fprintf(stderr, "cooperative launch failed: %s (grid %d)\n", hipGetErrorString(e), grid);
#else
    for (int p = 0; p < NPHASE; ++p) { a.ph_lo = p; a.ph_hi = p + 1; hipLaunchKernelGGL(fwd_kernel, dim3(grid), dim3(NTHR), LDS_BYTES, stream, a); }
#endif
}
```

```cpp
#include <hip/hip_runtime.h>
#include <hip/hip_cooperative_groups.h>
#include <cstdio>
#include <cstdint>
#include <cmath>
namespace cg = cooperative_groups;
#ifndef MK_COOP
#define MK_COOP 1
#endif
namespace pg8 {
#define PG8_LAS __attribute__((address_space(3)))
typedef unsigned short bf16_t;
typedef short bf16x8 __attribute__((ext_vector_type(8)));
typedef float f32x4 __attribute__((ext_vector_type(4)));
typedef unsigned u32x4 __attribute__((ext_vector_type(4)));
constexpr int BM = 256, BK = 64, HALF = 128, HTB = HALF * BK * 2  , STAGE_BYTES = 8 * HTB, NXCD = 8, WGM = 8;

__host__ __device__ __forceinline__ int lds_byte(int r, int c) { const int st = (r >> 4) * 2 + (c >> 5), rr = r & 15, cc = c & 31, ob = rr * 64 + cc * 2; return st * 1024 + (ob ^ (((ob >> 9) & 1) << 5)); }
__host__ __device__ __forceinline__ void stage_rc(int b, int& R, int& C) { const int st = b / 1024, sb = b % 1024, swz = sb ^ (((sb >> 9) & 1) << 5); R = (st >> 1) * 16 + swz / 64; C = (st & 1) * 32 + (swz % 64) / 2; }
__host__ __device__ __forceinline__ int perm32(int rho) { const int n = rho >> 4, i = rho & 15; return 8 * (i >> 2) + 4 * n + (i & 3); }

struct Unit { int pm, pn; };
struct Gemm { const bf16_t* A; const bf16_t* Bt; int M, N, K; };

struct StaticOrder {
    int nM, nN, nwg, G, c;
    __host__ __device__ void init(int M, int N, int G_, int c_) { nM = M / BM; nN = N / BM; nwg = nM * nN; G = G_; c = c_; }
    __host__ __device__ bool next(int i, Unit& u) const {
        const long L = (long)i * G + c; if (L >= nwg) return false;
        int wgid = (int)L; { const int q = nwg / NXCD, r = nwg % NXCD, xcd = wgid % NXCD, off = wgid / NXCD; wgid = (xcd < r ? xcd * (q + 1) : r * (q + 1) + (xcd - r) * q) + off; }
        const int nig = WGM * nN, gid = wgid / nig, fm = gid * WGM, gsz = (nM - fm) < WGM ? (nM - fm) : WGM;
        u.pm = fm + ((wgid % nig) % gsz); u.pn = (wgid % nig) / gsz; return true;
    }
    __device__ __forceinline__ void a_ready(const Unit&) const {}
    __device__ __forceinline__ void done(const Unit&) const {}
};

__device__ __forceinline__ unsigned cvt_pk_bf16(float lo, float hi) { unsigned r; asm volatile("v_cvt_pk_bf16_f32 %0, %1, %2" : "=v"(r) : "v"(lo), "v"(hi)); return r; }
typedef float f32x2 __attribute__((ext_vector_type(2)));
typedef float f32x2 __attribute__((ext_vector_type(2)));
typedef unsigned u32x2 __attribute__((ext_vector_type(2)));
template <int ACT> struct EpiBf16 {
    static constexpr bool PERM = true, AFTER_DRAIN = false;
    bf16_t* O; int ldc;
    __device__ __forceinline__ void operator()(const f32x4 (&acc)[2][2][4][2], const Unit& u, int wr, int wc, int fr, int fq) const {
        const int row0 = u.pm * BM + wr * 64 + fr; const int col0 = u.pn * BM + wc * 32 + 8 * fq;
#pragma unroll
        for (int ai = 0; ai < 2; ++ai)
#pragma unroll
            for (int m = 0; m < 4; ++m) { bf16_t* rowp = O + (size_t)(row0 + ai * HALF + m * 16) * ldc + col0;
#pragma unroll
                for (int bj = 0; bj < 2; ++bj) { f32x4 v0 = acc[ai][bj][m][0], v1 = acc[ai][bj][m][1];
                    if (ACT == 1) {
#pragma unroll
                        for (int j = 0; j < 4; ++j) { float a = v0[j] > 0.f ? v0[j] : 0.f; v0[j] = a * a; float b = v1[j] > 0.f ? v1[j] : 0.f; v1[j] = b * b; } }
                    u32x4 w; w.x = cvt_pk_bf16(v0[0], v0[1]); w.y = cvt_pk_bf16(v0[2], v0[3]); w.z = cvt_pk_bf16(v1[0], v1[1]); w.w = cvt_pk_bf16(v1[2], v1[3]);
                    *(u32x4*)(rowp + bj * HALF) = w; } }
    }
};
struct EpiRope {
    static constexpr bool PERM = true, AFTER_DRAIN = false;
    bf16_t* Q; bf16_t* KT; const float* rope; float qscale;
    __device__ __forceinline__ void operator()(const f32x4 (&acc)[2][2][4][2], const Unit& u, int wr, int wc, int fr, int fq) const {
        const int row0 = u.pm * BM + wr * 64 + fr; const int col0 = u.pn * BM + wc * 32 + 8 * fq;
        const int g = (wc & 1) * 4 + fq;
        const float sc = (u.pn < 2) ? qscale : 1.0f;
#pragma unroll
        for (int ai = 0; ai < 2; ++ai)
#pragma unroll
            for (int m = 0; m < 4; ++m) { const int row = row0 + ai * HALF + m * 16; const int pos = row & 4095;
                const f32x4 cs0 = *(const f32x4*)(rope + (size_t)pos * 64 + 8 * g), cs1 = *(const f32x4*)(rope + (size_t)pos * 64 + 8 * g + 4);
                const float c[4] = {cs0[0], cs0[2], cs1[0], cs1[2]}, s[4] = {cs0[1], cs0[3], cs1[1], cs1[3]};
                bf16_t* rowp;
                if (u.pn < 2) rowp = Q + (size_t)row * 512 + col0;
                else { const int ck = col0 - 512, hh = ck >> 7, cc = ck & 127; rowp = KT + ((size_t)(((row >> 12) * 4 + hh) * 64 + (pos >> 6)) * 8192 + (pos & 63) * 128 + cc); }
#pragma unroll
                for (int bj = 0; bj < 2; ++bj) { const f32x4 lo = acc[ai][bj][m][0], hi = acc[ai][bj][m][1]; float ol[4], oh[4];
#pragma unroll
                    for (int j = 0; j < 4; ++j) { ol[j] = (lo[j] * c[j] - hi[j] * s[j]) * sc; oh[j] = (hi[j] * c[j] + lo[j] * s[j]) * sc; }
                    u32x4 w; w.x = cvt_pk_bf16(ol[0], ol[1]); w.y = cvt_pk_bf16(ol[2], ol[3]); w.z = cvt_pk_bf16(oh[0], oh[1]); w.w = cvt_pk_bf16(oh[2], oh[3]);
                    *(u32x4*)(rowp + ((u.pn < 2) ? bj * HALF : bj * (64 * 8192))) = w; } }
    }
};
struct EpiUV {
    static constexpr bool PERM = true, AFTER_DRAIN = false;
    bf16_t* UT; bf16_t* VT;
    __device__ __forceinline__ void operator()(const f32x4 (&acc)[2][2][4][2], const Unit& u, int wr, int wc, int fr, int fq) const {
        const int row0 = u.pm * BM + wr * 64 + fr; const int col0 = u.pn * BM + wc * 32 + 8 * fq;
#pragma unroll
        for (int ai = 0; ai < 2; ++ai)
#pragma unroll
            for (int m = 0; m < 4; ++m) { const int row = row0 + ai * HALF + m * 16;
#pragma unroll
                for (int bj = 0; bj < 2; ++bj) { const int col = col0 + bj * HALF; bf16_t* p;
                    if (u.pm < 6) p = UT + (size_t)row * 32768 + col;
                    else { const int ev = row - 1536, hh = ev >> 7, ee = ev & 127, bb = col >> 12, pos = col & 4095;
                        p = VT + ((size_t)((bb * 4 + hh) * 64 + (pos >> 6)) * 8192 + ee * 64 + (pos & 48) + ((pos & 8) >> 1)); }
                    const f32x4 v0 = acc[ai][bj][m][0], v1 = acc[ai][bj][m][1];
                    u32x4 w; w.x = cvt_pk_bf16(v0[0], v0[1]); w.y = cvt_pk_bf16(v0[2], v0[3]); w.z = cvt_pk_bf16(v1[0], v1[1]); w.w = cvt_pk_bf16(v1[2], v1[3]);
                    if (u.pm < 6) *(u32x4*)p = w;
                    else { *(u32x2*)p = (u32x2){w.x, w.y}; *(u32x2*)(p + 8) = (u32x2){w.z, w.w}; } } }
    }
};
template <class Epi, class Sched, bool ALIGN_EPI = false, bool SP2 = false>
__device__ __forceinline__ void gemm_phase(PG8_LAS unsigned char* lds, const Gemm g, const Sched& S, const Epi& E) {
    const int tid = threadIdx.x, wid = __builtin_amdgcn_readfirstlane(tid >> 6), lane = tid & 63, wr = wid >> 2, wc = wid & 3, fr = lane & 15, fq = lane >> 4;
    const int K = g.K, nt = K / BK;
    unsigned voffA[2], voffB[2];
#pragma unroll
    for (int i = 0; i < 2; ++i) { int R, C; stage_rc(tid * 16 + i * 8192, R, C); const int Rb = Epi::PERM ? ((R & ~31) + perm32(R & 31)) : R;
        voffA[i] = (unsigned)(R * K + C) * 2u; voffB[i] = (unsigned)(Rb * K + C) * 2u; }
    const size_t kstep = (size_t)(BK * 2);
    const size_t hstep = (size_t)HALF * K * 2;
    const size_t tstep = 2 * hstep;
    const unsigned ldsw = (unsigned)wid * 1024u;
    const int aoff = lds_byte(wr * 64 + fr, fq * 8), boff = lds_byte(wc * 32 + fr, fq * 8);
#define PG8_SA(b, h) (((b) * 2 + (h)) * HTB)
#define PG8_SB(b, h) ((4 + (b) * 2 + (h)) * HTB)
#define PG8_STAGE(bufoff, gbase, voff) do { _Pragma("unroll") for (int _i = 0; _i < 2; ++_i) \
        __builtin_amdgcn_global_load_lds((const unsigned*)((const char*)(gbase) + (voff)[_i]), (PG8_LAS unsigned*)(lds + (bufoff) + ldsw + _i * 8192), 16, 0, 0); } while (0)
#define PG8_LDA(dst, b, h) do { _Pragma("unroll") for (int m = 0; m < 4; ++m) _Pragma("unroll") for (int k = 0; k < 2; ++k) dst[m][k] = *(const PG8_LAS bf16x8*)(lds + PG8_SA(b, h) + aoff + m * 2048 + k * 1024); } while (0)
#define PG8_LDB(dst, b, h) do { _Pragma("unroll") for (int n = 0; n < 2; ++n) _Pragma("unroll") for (int k = 0; k < 2; ++k) dst[n][k] = *(const PG8_LAS bf16x8*)(lds + PG8_SB(b, h) + boff + n * 2048 + k * 1024); } while (0)
#define PG8_MMA(ai, bj, At, Bt) do { __builtin_amdgcn_s_setprio(1); _Pragma("unroll") for (int m = 0; m < 4; ++m) _Pragma("unroll") for (int n = 0; n < 2; ++n) _Pragma("unroll") for (int k = 0; k < 2; ++k) \
        acc[ai][bj][m][n] = __builtin_amdgcn_mfma_f32_16x16x32_bf16(Bt[n][k], At[m][k], acc[ai][bj][m][n], 0, 0, 0); __builtin_amdgcn_s_setprio(0); } while (0)
#define PG8_WAIT_V(n) asm volatile("s_waitcnt vmcnt(" #n ")" ::: "memory")
#define PG8_WAIT_L(n) asm volatile("s_waitcnt lgkmcnt(" #n ")" ::: "memory")
#define PG8_BAR __builtin_amdgcn_s_barrier()
#define PG8_SCHED __builtin_amdgcn_sched_barrier(0)
    Unit cur, nxt; int ui = 0;
    if (!S.next(0, cur)) return;
    f32x4 acc[2][2][4][2];
#pragma unroll
    for (int a = 0; a < 2; ++a)
#pragma unroll
        for (int b = 0; b < 2; ++b)
#pragma unroll
            for (int m = 0; m < 4; ++m)
#pragma unroll
                for (int n = 0; n < 2; ++n) acc[a][b][m][n] = (f32x4){0.f, 0.f, 0.f, 0.f};
    bf16x8 At[4][2], B0[2][2], B1[2][2];
    const char* cA = (const char*)g.A + (size_t)cur.pm * tstep; const char* cB = (const char*)g.Bt + (size_t)cur.pn * tstep;
    S.a_ready(cur);
    if constexpr (SP2) {
        PG8_STAGE(PG8_SB(0, 0), cB, voffB); PG8_STAGE(PG8_SB(0, 1), cB + hstep, voffB); PG8_STAGE(PG8_SA(0, 0), cA, voffA); PG8_STAGE(PG8_SA(0, 1), cA + hstep, voffA);
        if (wr == 1) PG8_BAR;
        PG8_WAIT_V(2); PG8_BAR;
        PG8_STAGE(PG8_SB(1, 0), cB + kstep, voffB); PG8_STAGE(PG8_SA(1, 0), cA + kstep, voffA); PG8_STAGE(PG8_SB(1, 1), cB + hstep + kstep, voffB);
        PG8_WAIT_V(6); PG8_BAR;
    } else {
        PG8_STAGE(PG8_SB(0, 0), cB, voffB); PG8_STAGE(PG8_SA(0, 0), cA, voffA); PG8_STAGE(PG8_SB(0, 1), cB + hstep, voffB); PG8_STAGE(PG8_SA(0, 1), cA + hstep, voffA);
        if (wr == 1) PG8_BAR;
        PG8_WAIT_V(4); PG8_BAR;
        PG8_STAGE(PG8_SB(1, 0), cB + kstep, voffB); PG8_STAGE(PG8_SA(1, 0), cA + kstep, voffA); PG8_STAGE(PG8_SB(1, 1), cB + hstep + kstep, voffB);
        PG8_WAIT_V(6); PG8_BAR;
    }
    for (;;) {
        const bool has_next = S.next(ui + 1, nxt);
        const char* nA = has_next ? (const char*)g.A + (size_t)nxt.pm * tstep : cA; const char* nB = has_next ? (const char*)g.Bt + (size_t)nxt.pn * tstep : cB;
        for (int t = 0; t < nt; t += 2) {
            const bool last = (t == nt - 2);
            const char* a1 = cA + (size_t)(t + 1) * kstep;
            const char* a2 = last ? nA : cA + (size_t)(t + 2) * kstep; const char* b2 = last ? nB : cB + (size_t)(t + 2) * kstep;
            const char* a3 = a2 + kstep; const char* b3 = b2 + kstep;
            if (last && has_next) S.a_ready(nxt);
            if constexpr (SP2) {
            PG8_LDB(B0, 0, 0); PG8_LDB(B1, 0, 1); PG8_SCHED; PG8_LDA(At, 0, 0); PG8_STAGE(PG8_SA(1, 1), a1 + hstep, voffA);
            PG8_WAIT_V(8); PG8_WAIT_L(0); PG8_BAR; PG8_MMA(0, 0, At, B0); PG8_MMA(0, 1, At, B1); PG8_BAR; PG8_SCHED;
            PG8_LDA(At, 0, 1); PG8_STAGE(PG8_SB(0, 0), b2, voffB); PG8_STAGE(PG8_SB(0, 1), b2 + hstep, voffB); PG8_STAGE(PG8_SA(0, 0), a2, voffA);
            PG8_WAIT_V(8); PG8_WAIT_L(0); PG8_BAR; PG8_MMA(1, 0, At, B0); PG8_MMA(1, 1, At, B1); PG8_BAR; PG8_SCHED;
            PG8_LDB(B0, 1, 0); PG8_LDB(B1, 1, 1); PG8_SCHED; PG8_LDA(At, 1, 0); PG8_STAGE(PG8_SA(0, 1), a2 + hstep, voffA);
            PG8_WAIT_V(8); PG8_WAIT_L(0); PG8_BAR; PG8_MMA(0, 0, At, B0); PG8_MMA(0, 1, At, B1); PG8_BAR; PG8_SCHED;
            PG8_LDA(At, 1, 1); PG8_STAGE(PG8_SB(1, 0), b3, voffB); PG8_STAGE(PG8_SB(1, 1), b3 + hstep, voffB); PG8_STAGE(PG8_SA(1, 0), a3, voffA);
            PG8_WAIT_V(8); PG8_WAIT_L(0); PG8_BAR; PG8_MMA(1, 0, At, B0); PG8_MMA(1, 1, At, B1); PG8_BAR; PG8_SCHED;
            } else {
            PG8_LDB(B0, 0, 0); PG8_SCHED; PG8_LDA(At, 0, 0); PG8_STAGE(PG8_SA(1, 1), a1 + hstep, voffA);
            PG8_WAIT_L(8); PG8_BAR; PG8_WAIT_L(0); PG8_MMA(0, 0, At, B0); PG8_BAR; PG8_SCHED;
            PG8_LDB(B1, 0, 1); PG8_STAGE(PG8_SB(0, 0), b2, voffB);
            PG8_BAR; PG8_WAIT_L(0); PG8_MMA(0, 1, At, B1); PG8_BAR;
            PG8_LDA(At, 0, 1); PG8_STAGE(PG8_SA(0, 0), a2, voffA);
            PG8_BAR; PG8_WAIT_L(0); PG8_MMA(1, 0, At, B0); PG8_BAR; PG8_SCHED;
            PG8_STAGE(PG8_SB(0, 1), b2 + hstep, voffB);
            PG8_WAIT_V(6); PG8_BAR; PG8_MMA(1, 1, At, B1); PG8_BAR;
            PG8_LDB(B0, 1, 0); PG8_SCHED; PG8_LDA(At, 1, 0); PG8_STAGE(PG8_SA(0, 1), a2 + hstep, voffA);
            PG8_WAIT_L(8); PG8_BAR; PG8_WAIT_L(0); PG8_MMA(0, 0, At, B0); PG8_BAR; PG8_SCHED;
            PG8_LDB(B1, 1, 1); PG8_STAGE(PG8_SB(1, 0), b3, voffB);
            PG8_BAR; PG8_WAIT_L(0); PG8_MMA(0, 1, At, B1); PG8_BAR;
            PG8_LDA(At, 1, 1); PG8_STAGE(PG8_SA(1, 0), a3, voffA);
            PG8_BAR; PG8_WAIT_L(0); PG8_MMA(1, 0, At, B0); PG8_BAR; PG8_SCHED;
            PG8_STAGE(PG8_SB(1, 1), b3 + hstep, voffB);
            PG8_WAIT_V(6); PG8_BAR; PG8_MMA(1, 1, At, B1); PG8_BAR;
            }
        }
        if constexpr (ALIGN_EPI) { if (wr == 0) PG8_BAR; }
        if constexpr (!Epi::AFTER_DRAIN) { E(acc, cur, wr, wc, fr, fq); S.done(cur); }
        if (!has_next) break;
#pragma unroll
        for (int a = 0; a < 2; ++a)
#pragma unroll
            for (int b = 0; b < 2; ++b)
#pragma unroll
                for (int m = 0; m < 4; ++m)
#pragma unroll
                    for (int n = 0; n < 2; ++n) acc[a][b][m][n] = (f32x4){0.f, 0.f, 0.f, 0.f};
        cur = nxt; cA = nA; cB = nB; ++ui;
        if constexpr (ALIGN_EPI) { if (wr == 1) PG8_BAR; }
    }
    PG8_WAIT_V(0);
    if constexpr (!ALIGN_EPI) { if (wr == 0) PG8_BAR; }
    PG8_BAR;
    if constexpr (Epi::AFTER_DRAIN) { E.fused(acc, cur, wr, wc, fr, fq, lds, wid, lane); S.done(cur); }
#undef PG8_SA
#undef PG8_SB
#undef PG8_STAGE
#undef PG8_LDA
#undef PG8_LDB
#undef PG8_MMA
#undef PG8_WAIT_V
#undef PG8_WAIT_L
#undef PG8_BAR
#undef PG8_SCHED
}
}

constexpr int BATCH = 8, SEQ = 4096, DM = 1024, MTOK = BATCH * SEQ, HYW = 512, NIN = 3072, DFF = 4096;
constexpr int NWAVES = 8, NTHR = 512;
constexpr float NORM_EPS = 1e-6f, SUBLN_EPS = 1e-5f;
constexpr float QSCALE = 0.125f * 1.4426950408889634f;
constexpr int HRLEN = 8224;
constexpr size_t MiB = 1u << 20;
constexpr size_t WS_WIN = 0, WS_WOUT = 6 * MiB, WS_WUP = 8 * MiB, WS_WDOWN = 16 * MiB;
constexpr size_t WS_HR = 24 * MiB;
constexpr size_t WS_ROPE = 33 * MiB;
constexpr size_t WS_CTL = 34 * MiB, CTL_BYTES = 16384;
constexpr size_t WS_XN = 40 * MiB;
constexpr size_t WS_MO = 104 * MiB;
constexpr size_t WS_YT = 168 * MiB;
constexpr size_t WS_UVT = 200 * MiB;
constexpr size_t WS_QK = 328 * MiB;
constexpr size_t WS_KT = 360 * MiB;
constexpr size_t WS_VT = 296 * MiB;
constexpr size_t WS_MIX = 392 * MiB;
constexpr size_t WS_H = 200 * MiB;
constexpr size_t WS_END = 456 * MiB;
constexpr int LDS_BYTES = 135168;

#define LAS __attribute__((address_space(3)))
typedef unsigned short bf16;
typedef unsigned u32x4 __attribute__((ext_vector_type(4)));
typedef unsigned u32x2 __attribute__((ext_vector_type(2)));
typedef float f32x4 __attribute__((ext_vector_type(4)));
typedef float f32x16 __attribute__((ext_vector_type(16)));
typedef short bf16x8 __attribute__((ext_vector_type(8)));
typedef short s16x4 __attribute__((ext_vector_type(4)));

__device__ __forceinline__ unsigned f2bf(float f) { unsigned u = __builtin_bit_cast(unsigned, f); return (u + 0x7fffu + ((u >> 16) & 1u)) >> 16; }
__device__ __forceinline__ unsigned pk2(float lo, float hi) { return f2bf(lo) | (f2bf(hi) << 16); }
typedef float f32x2_t __attribute__((ext_vector_type(2))); typedef __bf16 bf16x2_t __attribute__((ext_vector_type(2)));
__device__ __forceinline__ unsigned cvtpk(float lo, float hi) { f32x2_t v = {lo, hi}; bf16x2_t b = __builtin_convertvector(v, bf16x2_t); return __builtin_bit_cast(unsigned, b); }
__device__ __forceinline__ float bf2f(unsigned short b) { return __builtin_bit_cast(float, (unsigned)b << 16); }
__device__ __forceinline__ float bflo(unsigned w) { return __builtin_bit_cast(float, w << 16); }
__device__ __forceinline__ float bfhi(unsigned w) { return __builtin_bit_cast(float, w & 0xffff0000u); }
__device__ __forceinline__ float wave_sum(float v) {
#pragma unroll
    for (int o = 1; o < 64; o <<= 1) v += __shfl_xor(v, o);
    return v;
}
__device__ __forceinline__ float swap_hi(float v) { return __shfl_xor(v, 32); }
#define LDS_WAIT() asm volatile("s_waitcnt lgkmcnt(0)" ::: "memory")

struct Args { const float* in[25]; float* out; unsigned char* ws; int ph_lo, ph_hi; };

__device__ __forceinline__ int win_src(int n) {
    if (n < 1536) return n;
    if (n < 2048) return n + 1024;
    const int pp = n - 2048, grp = pp >> 6, p = pp & 63, g = p >> 3, e = p & 7;
    const int d = (e < 4) ? (4 * g + e) : (32 + 4 * g + (e - 4));
    return 1536 + grp * 64 + d;
}
template <bool PERMW>
__device__ __forceinline__ void p0_transpose_item(const float* W, int K, int N, bf16* WT, LAS float* scr, int item, int lane) {
    const int nblk = N / 32, kb = item / nblk, nb = item % nblk, k0 = 64 * kb, n0 = 32 * nb;
    const int sc = PERMW ? win_src(n0 + (lane & 31)) : (n0 + (lane & 31));
#pragma unroll 8
    for (int i = 0; i < 32; ++i) { const int kk = 2 * i + (lane >> 5); scr[kk * 33 + (lane & 31)] = W[(size_t)(k0 + kk) * N + sc]; }
    LDS_WAIT(); asm volatile("" ::: "memory");
    const int c = lane & 7;
#pragma unroll
    for (int j = 0; j < 4; ++j) { const int n = (lane >> 3) + 8 * j; const LAS float* s = scr + (8 * c) * 33 + n;
        u32x4 o; o.x = pk2(s[0 * 33], s[1 * 33]); o.y = pk2(s[2 * 33], s[3 * 33]); o.z = pk2(s[4 * 33], s[5 * 33]); o.w = pk2(s[6 * 33], s[7 * 33]);
        *(u32x4*)(WT + (size_t)(n0 + n) * K + k0 + 8 * c) = o; }
    LDS_WAIT(); asm volatile("" ::: "memory");
}
__device__ __forceinline__ void rms_row_to_bf16(const float* xrow, const float* gain, bf16* orow, int lane) {
    const f32x4* xr = (const f32x4*)xrow + lane; const f32x4* gr = (const f32x4*)gain + lane;
    f32x4 v[4]; float s = 0.f;
#pragma unroll
    for (int j = 0; j < 4; ++j) { v[j] = xr[64 * j]; s += (v[j].x * v[j].x + v[j].y * v[j].y) + (v[j].z * v[j].z + v[j].w * v[j].w); }
    const float r = 1.0f / sqrtf(wave_sum(s) * (1.f / DM) + NORM_EPS);
    unsigned long long* o8 = (unsigned long long*)orow + lane;
#pragma unroll
    for (int j = 0; j < 4; ++j) { const f32x4 g = gr[64 * j];
        o8[64 * j] = (unsigned long long)pk2(v[j].x * r * g.x, v[j].y * r * g.y) | ((unsigned long long)pk2(v[j].z * r * g.z, v[j].w * r * g.w) << 32); }
}

__device__ __forceinline__ void filter_item(LAS unsigned char* lds, const Args& a, bf16* HR, int pg, int tid) {
    LAS float* Z = (LAS float*)lds;
    LAS float* HA = Z + 16 * 33;
    LAS float* HB = HA + 16 * 64;
    const float* w1 = a.in[6]; const float* b1 = a.in[7]; const float* w2 = a.in[8]; const float* b2 = a.in[9];
    const float* w3 = a.in[10]; const float* b3 = a.in[11]; const float* w4 = a.in[12]; const float* freq = a.in[13]; const float* fbias = a.in[14];
    const int t0 = 16 * pg;
    for (int i = tid; i < 16 * 33; i += NTHR) { const int p = i / 33, f = i % 33; const int pos = t0 + p; float val;
        if (f == 0) val = (float)pos * (1.0f / (float)(SEQ - 1));
        else { const int j = (f - 1) & 15; const float fj = 1e-4f + (float)j * ((15.0f - 1e-4f) / 15.0f); const float w = (6.283185307179586f / (float)SEQ) * (float)pos; const float arg = fj * w;
            val = (f <= 16) ? cosf(arg) : -sinf(arg); }
        Z[i] = val; }
    __syncthreads();
    for (int o = tid; o < 1024; o += NTHR) { const int p = o >> 6, n = o & 63; float acc = b1[n];
#pragma unroll 3
        for (int f = 0; f < 33; ++f) acc += Z[p * 33 + f] * w1[f * 64 + n];
        HA[o] = sinf(freq[n] * acc); }
    __syncthreads();
    for (int o = tid; o < 1024; o += NTHR) { const int p = o >> 6, n = o & 63; float acc = b2[n];
#pragma unroll 4
        for (int f = 0; f < 64; ++f) acc += HA[p * 64 + f] * w2[f * 64 + n];
        HB[o] = sinf(freq[n] * acc); }
    __syncthreads();
    for (int o = tid; o < 1024; o += NTHR) { const int p = o >> 6, n = o & 63; float acc = b3[n];
#pragma unroll 4
        for (int f = 0; f < 64; ++f) acc += HB[p * 64 + f] * w3[f * 64 + n];
        HA[o] = sinf(freq[n] * acc); }
    __syncthreads();
    {   const int c = tid;
        float af[16], ab[16];
#pragma unroll
        for (int p = 0; p < 16; ++p) { af[p] = 0.f; ab[p] = 0.f; }
#pragma unroll 2
        for (int k = 0; k < 64; ++k) { const float wf = w4[k * 1024 + c], wb = w4[k * 1024 + 512 + c];
#pragma unroll
            for (int p = 0; p < 16; ++p) { const float hv = HA[p * 64 + k]; af[p] += hv * wf; ab[p] += hv * wb; } }
        const float min_decay = -4.605170185988091f / 1.5f, max_decay = -4.605170185988091f / 0.3f;
        const float adelta = fabsf(min_decay + (float)c * ((max_decay - min_decay) / 511.0f));
        bf16* hr = HR + (size_t)c * HRLEN;
#pragma unroll
        for (int p = 0; p < 16; ++p) { const int pos = t0 + p; const float tl = (float)pos * (1.0f / (float)(SEQ - 1)); const float dec = expf(-tl * adelta);
            const float vf = af[p] * dec, vb = ab[p] * dec;
            if (pos == 0) hr[4096] = (bf16)f2bf(vf + vb + fbias[c]);
            else { hr[4096 - pos] = (bf16)f2bf(vf); hr[4096 + pos] = (bf16)f2bf(vb); } }
        if (pg == 0) { hr[0] = 0; for (int i = 8192; i < HRLEN; ++i) hr[i] = 0; }
    }
    __syncthreads();
}

namespace att {
constexpr int KP = 272, VP = 144, KBUF = 64 * KP, VBUF = 128 * VP, VOFF = 2 * KBUF;
constexpr int NT = SEQ / 64;
__device__ __forceinline__ float max3(float a, float b, float c) { return fmaxf(fmaxf(a, b), c); }
__device__ __forceinline__ float fadd_s(float a, float b) { float r; asm("v_add_f32_e32 %0, %1, %2" : "=v"(r) : "v"(a), "v"(b)); return r; }
#define SBAR() __builtin_amdgcn_sched_barrier(0)
__device__ __forceinline__ void v_load(bf16x8 (&vf)[4], const LAS unsigned char* vb, int ks) {
#pragma unroll
    for (int e = 0; e < 4; ++e) vf[e] = *(const LAS bf16x8*)(vb + e * 32 * VP + ks * 32);
}
__device__ __forceinline__ void pv_tile(f32x16 (&o)[4], const u32x4 (&P)[4], bf16x8 (&vf0)[4], const LAS unsigned char* vb) {
    bf16x8 vf1[4];
#pragma unroll
    for (int ks = 0; ks < 4; ++ks) { const bf16x8 pb = __builtin_bit_cast(bf16x8, P[ks]);
        if (ks == 0 || ks == 2) v_load(vf1, vb, ks + 1); else if (ks == 1) v_load(vf0, vb, 2);
        SBAR(); __builtin_amdgcn_s_setprio(1);
#pragma unroll
        for (int e = 0; e < 4; ++e) o[e] = __builtin_amdgcn_mfma_f32_32x32x16_bf16((ks & 1) ? vf1[e] : vf0[e], pb, o[e], 0, 0, 0);
        __builtin_amdgcn_s_setprio(0); SBAR(); }
}
__device__ __forceinline__ float xhalf_max(float v) { auto rr = __builtin_amdgcn_permlane32_swap(__float_as_uint(v), __float_as_uint(v), false, false); return fmaxf(__uint_as_float(rr[0]), __uint_as_float(rr[1])); }
__device__ __forceinline__ float xhalf_sum(float v) { auto rr = __builtin_amdgcn_permlane32_swap(__float_as_uint(v), __float_as_uint(v), false, false); return __uint_as_float(rr[0]) + __uint_as_float(rr[1]); }
constexpr int QOFF = 2 * KBUF + 3 * VBUF;
#define ATT_SLOT(T, PKW, PVW, PKL, PVL) do { const int t = (T); \
        const LAS unsigned char* kst = lds + (t & 1) * KBUF; \
        bf16x8 vf0[4]; \
        if (c == 1 && t > 0) { v_load(vf0, lds + VOFF + vprev + voff, 0); pv_tile(o, P, vf0, lds + VOFF + vprev + voff); } \
        if (t + 1 < NT && VAR != 4) { _Pragma("unroll") for (int i = 0; i < 2; ++i) { PKL[i] = *(const u32x4*)(gk[i] + (size_t)(t + 1) * 8192); PVL[i] = *(const u32x4*)(gv[i] + (size_t)(t + 1) * 8192); } } \
        SBAR(); \
        f32x16 s0, s1; \
        { const LAS unsigned char* kb = kst + r32 * KP + c * 128 + hi * 16; const LAS unsigned char* qb_ = lds + QOFF + wid * 4096 + lane * 16; \
          bf16x8 ka[4], kc2[4], qa[2], qc[2]; \
          qa[0] = *(const LAS bf16x8*)(qb_); qa[1] = *(const LAS bf16x8*)(qb_ + 1024); \
          ka[0] = *(const LAS bf16x8*)(kb); ka[1] = *(const LAS bf16x8*)(kb + 32 * KP); ka[2] = *(const LAS bf16x8*)(kb + 32); ka[3] = *(const LAS bf16x8*)(kb + 32 * KP + 32); \
          SBAR(); \
          qc[0] = *(const LAS bf16x8*)(qb_ + 2048); qc[1] = *(const LAS bf16x8*)(qb_ + 3072); \
          kc2[0] = *(const LAS bf16x8*)(kb + 64); kc2[1] = *(const LAS bf16x8*)(kb + 32 * KP + 64); kc2[2] = *(const LAS bf16x8*)(kb + 96); kc2[3] = *(const LAS bf16x8*)(kb + 32 * KP + 96); \
          __builtin_amdgcn_s_setprio(1); s0 = __builtin_amdgcn_mfma_f32_32x32x16_bf16(ka[0], qa[0], zero16, 0, 0, 0); s1 = __builtin_amdgcn_mfma_f32_32x32x16_bf16(ka[1], qa[0], zero16, 0, 0, 0); \
          s0 = __builtin_amdgcn_mfma_f32_32x32x16_bf16(ka[2], qa[1], s0, 0, 0, 0); s1 = __builtin_amdgcn_mfma_f32_32x32x16_bf16(ka[3], qa[1], s1, 0, 0, 0); \
          SBAR(); \
          s0 = __builtin_amdgcn_mfma_f32_32x32x16_bf16(kc2[0], qc[0], s0, 0, 0, 0); s1 = __builtin_amdgcn_mfma_f32_32x32x16_bf16(kc2[1], qc[0], s1, 0, 0, 0); \
          s0 = __builtin_amdgcn_mfma_f32_32x32x16_bf16(kc2[2], qc[1], s0, 0, 0, 0); s1 = __builtin_amdgcn_mfma_f32_32x32x16_bf16(kc2[3], qc[1], s1, 0, 0, 0); __builtin_amdgcn_s_setprio(0); } \
        if (c == 0) v_load(vf0, lds + VOFF + vcur + voff, 0); \
        SBAR(); \
        float mx = max3(s0[0], s1[0], s0[1]); \
        mx = max3(mx, s1[1], s0[2]); mx = max3(mx, s1[2], s0[3]); mx = max3(mx, s1[3], s0[4]); mx = max3(mx, s1[4], s0[5]); \
        mx = max3(mx, s1[5], s0[6]); mx = max3(mx, s1[6], s0[7]); mx = max3(mx, s1[7], s0[8]); mx = max3(mx, s1[8], s0[9]); \
        mx = max3(mx, s1[9], s0[10]); mx = max3(mx, s1[10], s0[11]); mx = max3(mx, s1[11], s0[12]); mx = max3(mx, s1[12], s0[13]); \
        mx = max3(mx, s1[13], s0[14]); mx = max3(mx, s1[14], s0[15]); mx = fmaxf(mx, s1[15]); \
        mx = xhalf_max(mx); \
        if (t == 0) { if (__any(fabsf(mx) > 8.0f)) { mref = mx; gen = true; } } \
        else if (__any(mx > mref + 8.0f)) { const float mnew = fmaxf(mx, mref); const float al = __builtin_amdgcn_exp2f(mref - mnew); \
            _Pragma("unroll") for (int e = 0; e < 4; ++e) _Pragma("unroll") for (int r = 0; r < 16; ++r) o[e][r] *= al; \
            lsum *= al; mref = mnew; gen = true; } \
        float ps0 = 0.f, ps1 = 0.f; \
        if (gen) { _Pragma("unroll") for (int r = 0; r < 16; ++r) { s0[r] = __builtin_amdgcn_exp2f(s0[r] - mref); s1[r] = __builtin_amdgcn_exp2f(s1[r] - mref); ps0 += s0[r]; ps0 += s1[r]; } } \
        else { _Pragma("unroll") for (int r = 0; r < 16; ++r) { s0[r] = __builtin_amdgcn_exp2f(s0[r]); s1[r] = __builtin_amdgcn_exp2f(s1[r]); ps0 += s0[r]; ps0 += s1[r]; } } \
        lsum += ps0 + ps1; \
        P[0] = (u32x4){cvtpk(s0[0], s0[1]), cvtpk(s0[2], s0[3]), cvtpk(s0[4], s0[5]), cvtpk(s0[6], s0[7])}; \
        P[1] = (u32x4){cvtpk(s0[8], s0[9]), cvtpk(s0[10], s0[11]), cvtpk(s0[12], s0[13]), cvtpk(s0[14], s0[15])}; \
        P[2] = (u32x4){cvtpk(s1[0], s1[1]), cvtpk(s1[2], s1[3]), cvtpk(s1[4], s1[5]), cvtpk(s1[6], s1[7])}; \
        P[3] = (u32x4){cvtpk(s1[8], s1[9]), cvtpk(s1[10], s1[11]), cvtpk(s1[12], s1[13]), cvtpk(s1[14], s1[15])}; \
        if (c == 0) pv_tile(o, P, vf0, lds + VOFF + vcur + voff); \
        if (t + 1 < NT && VAR != 4) { LAS unsigned char* kn = lds + ((t + 1) & 1) * KBUF; LAS unsigned char* vn = lds + vnext; \
            _Pragma("unroll") for (int i = 0; i < 2; ++i) { *(LAS u32x4*)(kn + lk[i]) = PKW[i]; *(LAS u32x4*)(vn + lv[i]) = PVW[i]; } } \
        { const int tmp = vprev; vprev = vcur; vcur = vnext; vnext = tmp; } \
        if (VAR != 3) __syncthreads(); \
    } while (0)
template <int VAR> __device__ __forceinline__ void unit(LAS unsigned char* lds, const bf16* QK, const bf16* KT, const bf16* VT, bf16* MIX, const float* sgain, float lam, int b, int h, int qb) {
    const int tid = threadIdx.x, lane = tid & 63, r32 = lane & 31, hi = lane >> 5; const int wid = __builtin_amdgcn_readfirstlane(tid >> 6);
    const int qsub = wid & 3, c = wid >> 2;
    const size_t rowbase = (size_t)b * SEQ; const int q0 = qb * 128 + qsub * 32;
    { const bf16* qp = QK + (rowbase + q0 + r32) * 512 + h * 128 + c * 64 + hi * 8;
#pragma unroll
      for (int ds = 0; ds < 4; ++ds) *(LAS bf16x8*)(lds + QOFF + wid * 4096 + ds * 1024 + lane * 16) = *(const bf16x8*)(qp + ds * 16); }
    const bf16* gk[2]; const bf16* gv[2]; int lk[2], lv[2];
#pragma unroll
    for (int i = 0; i < 2; ++i) { const int id = tid + NTHR * i; const int kr = id >> 4, kc = id & 15; const int ve = id >> 3, vc = id & 7;
        gk[i] = KT + (size_t)(b * 4 + h) * 64 * 8192 + id * 8; lk[i] = kr * KP + kc * 16;
        gv[i] = VT + (size_t)(b * 4 + h) * 64 * 8192 + id * 8; lv[i] = VOFF + ve * VP + vc * 16; }
    u32x4 pkA[2], pvA[2];
#pragma unroll
    for (int i = 0; i < 2; ++i) { pkA[i] = *(const u32x4*)gk[i]; pvA[i] = *(const u32x4*)gv[i]; }
#pragma unroll
    for (int i = 0; i < 2; ++i) { *(LAS u32x4*)(lds + lk[i]) = pkA[i]; *(LAS u32x4*)(lds + lv[i]) = pvA[i]; }
    __syncthreads();
    f32x16 o[4];
#pragma unroll
    for (int e = 0; e < 4; ++e) o[e] = (f32x16){};
    const f32x16 zero16 = (f32x16){};
    float mref = 0.f, lsum = 0.f; bool gen = false;
    u32x4 P[4];
#pragma unroll
    for (int ks = 0; ks < 4; ++ks) P[ks] = (u32x4){0u, 0u, 0u, 0u};
    int vcur = 0, vprev = 2 * VBUF, vnext = VBUF;
    const int voff = r32 * VP + hi * 16;
    for (int tt = 0; tt < NT; ++tt) {
        ATT_SLOT(tt, pkA, pvA, pkA, pvA);
    }
    if (c == 1) { bf16x8 vf0[4]; v_load(vf0, lds + VOFF + vprev + voff, 0); pv_tile(o, P, vf0, lds + VOFF + vprev + voff); }
    __syncthreads();
    lsum = xhalf_sum(lsum);
    const float sc = (c == 0) ? (1.0f / lsum) : (lam / lsum);
    LAS float* X = (LAS float*)lds + qsub * (128 * 32);
    if (c == 1) {
#pragma unroll
        for (int e = 0; e < 4; ++e)
#pragma unroll
            for (int r = 0; r < 16; ++r) { const int ee = 32 * e + (r & 3) + 8 * (r >> 2) + 4 * hi; X[ee * 32 + r32] = o[e][r] * sc; } }
    __syncthreads();
    if (c == 0) { float ss = 0.f;
#pragma unroll
        for (int e = 0; e < 4; ++e)
#pragma unroll
            for (int r = 0; r < 16; ++r) { const int ee = 32 * e + (r & 3) + 8 * (r >> 2) + 4 * hi; const float v = o[e][r] * sc - X[ee * 32 + r32]; o[e][r] = v; ss += v * v; }
        ss = xhalf_sum(ss);
        const float rs = (1.0f / sqrtf(ss * (1.0f / 128.0f) + SUBLN_EPS)) * 0.8f;
        bf16* op = MIX + (rowbase + q0 + r32) * 1024 + 512 + h * 128;
#pragma unroll
        for (int e = 0; e < 4; ++e)
#pragma unroll
            for (int q4 = 0; q4 < 4; ++q4) { const int ee = 32 * e + 8 * q4 + 4 * hi; const f32x4 g = *(const f32x4*)(sgain + ee);
                u32x2 w; w.x = cvtpk(o[e][4 * q4] * rs * g.x, o[e][4 * q4 + 1] * rs * g.y); w.y = cvtpk(o[e][4 * q4 + 2] * rs * g.z, o[e][4 * q4 + 3] * rs * g.w);
                *(u32x2*)(op + ee) = w; } }
    __syncthreads();
}
}

namespace hy {
constexpr int UP = 264, UBUF = 32 * UP * 2, HRB = HRLEN * 2;
constexpr int NCH = 17;
__device__ __forceinline__ float ldbf(const bf16* p) { return bf2f(*p); }
__device__ __forceinline__ void stage(LAS unsigned char* ub, const bf16* X1, const bf16* V, const float (&w1)[4], const float (&wv)[4], int j, int tid) {
    for (int it = tid; it < 520; it += NTHR) { const int b = it / 65, tt = it - b * 65; const int s0 = 256 * j - 4 + 4 * tt;
        float g[4] = {0.f, 0.f, 0.f, 0.f};
        if (s0 >= 0 && s0 < SEQ) { const bf16* x1p = X1 + (size_t)b * SEQ + s0; const bf16* vp = V + (size_t)b * SEQ + s0;
            const u32x2 xa = *(const u32x2*)x1p, va = *(const u32x2*)vp;
            float xs[6], vs[6];
            xs[0] = (s0 > 0) ? ldbf(x1p - 1) : 0.f; vs[0] = (s0 > 0) ? ldbf(vp - 1) : 0.f;
            xs[5] = (s0 + 4 < SEQ) ? ldbf(x1p + 4) : 0.f; vs[5] = (s0 + 4 < SEQ) ? ldbf(vp + 4) : 0.f;
            xs[1] = bflo(xa.x); xs[2] = bfhi(xa.x); xs[3] = bflo(xa.y); xs[4] = bfhi(xa.y);
            vs[1] = bflo(va.x); vs[2] = bfhi(va.x); vs[3] = bflo(va.y); vs[4] = bfhi(va.y);
#pragma unroll
            for (int i = 0; i < 4; ++i) { const float cx = w1[0] * xs[i] + w1[1] * xs[i + 1] + w1[2] * xs[i + 2] + w1[3]; const float cv = wv[0] * vs[i] + wv[1] * vs[i + 1] + wv[2] * vs[i + 2] + wv[3]; g[i] = cx * cv; } }
        LAS bf16* U = (LAS bf16*)ub;
#pragma unroll
        for (int r = 0; r < 4; ++r)
#pragma unroll
            for (int i = 0; i < 4; ++i) { const int kk = 4 * tt + i - r; if (kk >= 0 && kk < 256) U[(4 * b + r) * UP + kk] = (bf16)f2bf(g[i]); } }
}
__device__ __forceinline__ void channel(LAS unsigned char* lds, const bf16* UVT, const bf16* HR, const float* conv_w, const float* conv_b, bf16* YT, int c) {
    const int tid = threadIdx.x, lane = tid & 63, r32 = lane & 31, hi = lane >> 5; const int wid = __builtin_amdgcn_readfirstlane(tid >> 6);
    const bf16* X0 = UVT + (size_t)c * MTOK; const bf16* X1 = UVT + (size_t)(512 + c) * MTOK; const bf16* V = UVT + (size_t)(1024 + c) * MTOK;
    float w0[4], w1[4], wv[4];
#pragma unroll
    for (int k = 0; k < 3; ++k) { w0[k] = conv_w[k * 1536 + c]; w1[k] = conv_w[k * 1536 + 512 + c]; wv[k] = conv_w[k * 1536 + 1024 + c]; }
    w0[3] = conv_b[c]; w1[3] = conv_b[512 + c]; wv[3] = conv_b[1024 + c];
    for (int i = tid; i < HRB / 16; i += NTHR) ((LAS u32x4*)lds)[i] = ((const u32x4*)(HR + (size_t)c * HRLEN))[i];
    LAS unsigned char* ub0 = lds + HRB;
    stage(ub0, X1, V, w1, wv, 0, tid);
    __syncthreads();
    f32x16 acc[4];
#pragma unroll
    for (int n = 0; n < 4; ++n) acc[n] = (f32x16){};
    const int hb0 = (4096 - 4 * (128 * wid + r32) - 4 + 8 * hi) * 2;
    for (int j = 0; j < NCH; ++j) {
        LAS unsigned char* ucur = ub0 + (j & 1) * UBUF;
        if (j + 1 < NCH) stage(ub0 + ((j + 1) & 1) * UBUF, X1, V, w1, wv, j + 1, tid);
        const int nks = (j < NCH - 1) ? 16 : 1;
        const LAS unsigned char* ua = ucur + r32 * (UP * 2) + hi * 16;
        const LAS unsigned char* hp = lds + hb0 + j * 512;
#pragma unroll 4
        for (int ks = 0; ks < nks; ++ks) { const bf16x8 a = *(const LAS bf16x8*)(ua + ks * 32);
#pragma unroll
            for (int n = 0; n < 4; ++n) { const LAS unsigned char* p = hp + ks * 32 - n * 256; const u32x2 b0 = *(const LAS u32x2*)p, b1 = *(const LAS u32x2*)(p + 8);
                const bf16x8 bb = __builtin_bit_cast(bf16x8, (u32x4){b0.x, b0.y, b1.x, b1.y});
                acc[n] = __builtin_amdgcn_mfma_f32_32x32x16_bf16(a, bb, acc[n], 0, 0, 0); } }
        __syncthreads();
    }
#pragma unroll
    for (int n = 0; n < 4; ++n) { const int t = 4 * (128 * wid + 32 * n + r32);
#pragma unroll
        for (int q = 0; q < 4; ++q) { const int b = 2 * q + hi; const bf16* xp = X0 + (size_t)b * SEQ + t; const u32x2 xa = *(const u32x2*)xp; float xs[6];
            xs[0] = (t > 0) ? ldbf(xp - 1) : 0.f; xs[5] = (t + 4 < SEQ) ? ldbf(xp + 4) : 0.f;
            xs[1] = bflo(xa.x); xs[2] = bfhi(xa.x); xs[3] = bflo(xa.y); xs[4] = bfhi(xa.y);
            float y[4];
#pragma unroll
            for (int i = 0; i < 4; ++i) y[i] = acc[n][4 * q + i] * (w0[0] * xs[i] + w0[1] * xs[i + 1] + w0[2] * xs[i + 2] + w0[3]);
            u32x2 w; w.x = pk2(y[0], y[1]); w.y = pk2(y[2], y[3]);
            *(u32x2*)(YT + (size_t)c * MTOK + (size_t)b * SEQ + t) = w; } }
    __syncthreads();
}
}

#define XB_TMO      128
#define XB_XCNT(j)  (256  + 64 * (j))
#define XB_XSUB(j)  (1280 + 64 * (j))
#define XB_XGEN(j)  (2304 + 64 * (j))
#define XB_TOP      3328
#define XB_TOPGEN   3392
#define XCD_BAR_WORDS 3456
#define XB_SPIN_CAP (1u << 18)

__device__ __forceinline__ unsigned xb_ld(unsigned* p)              { return __hip_atomic_load(p, __ATOMIC_RELAXED, __HIP_MEMORY_SCOPE_AGENT); }
__device__ __forceinline__ unsigned xb_add(unsigned* p, unsigned v) { return __hip_atomic_fetch_add(p, v, __ATOMIC_RELAXED, __HIP_MEMORY_SCOPE_AGENT); }
__device__ __forceinline__ unsigned xb_xcc_id() { return (unsigned)__builtin_amdgcn_s_getreg((3 << 11) | 20) & 0xFu; }
#define XB_SPIN(cond, bar) do { unsigned _sp = 0; while (cond) { __builtin_amdgcn_s_sleep(1); \
    if ((++_sp & 255u) == 0u) { if (xb_ld(&(bar)[XB_TMO])) break; if (_sp > XB_SPIN_CAP) { atomicAdd(&(bar)[XB_TMO], 1u); break; } } } } while (0)

struct XcdBarrier {
    unsigned* bar; unsigned x;
    volatile LAS unsigned* st;
};

__device__ __forceinline__ XcdBarrier xcd_barrier_post(unsigned* bar, volatile LAS unsigned* st) {
    XcdBarrier b; b.bar = bar; b.x = xb_xcc_id(); b.st = st;
    if (threadIdx.x == 0) (void)xb_add(&bar[XB_XCNT(b.x)], 1u);
    return b;
}
__device__ __forceinline__ void xcd_barrier_complete(unsigned* bar, unsigned x, unsigned& nloc, unsigned& nx) {
    const unsigned G = gridDim.x * gridDim.y * gridDim.z;
    unsigned sum, cnt, mine, sp = 0u;
    for (;;) {
        sum = 0u; cnt = 0u; mine = 0u;
#pragma unroll
        for (unsigned j = 0; j < 16; ++j) { const unsigned c = xb_ld(&bar[XB_XCNT(j)]); sum += c; cnt += (c > 0u) ? 1u : 0u; mine = (j == x) ? c : mine; }
        if (sum == G) break;
        __builtin_amdgcn_s_sleep(1);
        if ((++sp & 255u) == 0u) { if (xb_ld(&bar[XB_TMO])) break; if (sp > XB_SPIN_CAP) { atomicAdd(&bar[XB_TMO], 1u); break; } }
    }
    nloc = mine > 0u ? mine : 1u; nx = cnt > 0u ? cnt : 1u;
}

__device__ __forceinline__ void xcd_barrier(const XcdBarrier& b) {
    asm volatile("s_waitcnt vmcnt(0)" ::: "memory");
    __syncthreads();
    if (threadIdx.x == 0) {
        unsigned* bar = b.bar;
        __builtin_amdgcn_s_waitcnt(0);
        unsigned nloc = b.st[0], nx = b.st[1];
        if (nloc == 0u) { xcd_barrier_complete(bar, b.x, nloc, nx); b.st[0] = nloc; b.st[1] = nx; }
        const unsigned old = xb_add(&bar[XB_XSUB(b.x)], 1u);
        const unsigned gen = old / nloc;
        if (old + 1u == (gen + 1u) * nloc) {
            __builtin_amdgcn_fence(__ATOMIC_RELEASE, "agent");
            asm volatile("s_waitcnt vmcnt(0)" ::: "memory");
            const unsigned og = xb_add(&bar[XB_TOP], 1u);
            const unsigned tg = og / nx;
            if (og + 1u == (tg + 1u) * nx) xb_add(&bar[XB_TOPGEN], 1u);
            else XB_SPIN(xb_ld(&bar[XB_TOPGEN]) == tg, bar);
            __builtin_amdgcn_fence(__ATOMIC_ACQUIRE, "agent");
            xb_add(&bar[XB_XGEN(b.x)], 1u);
            asm volatile("s_waitcnt vmcnt(0)" ::: "memory");
        } else {
            XB_SPIN(xb_ld(&bar[XB_XGEN(b.x)]) == gen, bar);
            __builtin_amdgcn_fence(__ATOMIC_ACQUIRE, "agent");
            asm volatile("s_waitcnt vmcnt(0)" ::: "memory");
        }
    }
    __syncthreads();
}

__global__ void __launch_bounds__(NTHR, 2) fwd_kernel(Args a) {
    extern __shared__ __attribute__((aligned(16))) unsigned char lds_raw[];
    LAS unsigned char* lds = (LAS unsigned char*)lds_raw;
    const int tid = threadIdx.x, lane = tid & 63; const int wave = __builtin_amdgcn_readfirstlane(tid >> 6);
    const int G = gridDim.x, bx = blockIdx.x;
    const int gw = bx * NWAVES + wave, NGW = G * NWAVES;
    unsigned char* ws = a.ws;
    bf16* Win_t = (bf16*)(ws + WS_WIN); bf16* Wout_t = (bf16*)(ws + WS_WOUT); bf16* Wup_t = (bf16*)(ws + WS_WUP); bf16* Wdown_t = (bf16*)(ws + WS_WDOWN);
    bf16* HR = (bf16*)(ws + WS_HR); float* ROPE = (float*)(ws + WS_ROPE);
    bf16* XN = (bf16*)(ws + WS_XN); bf16* MO = (bf16*)(ws + WS_MO); bf16* YT = (bf16*)(ws + WS_YT); bf16* UVT = (bf16*)(ws + WS_UVT);
    bf16* QK = (bf16*)(ws + WS_QK); bf16* KT = (bf16*)(ws + WS_KT); bf16* VT = (bf16*)(ws + WS_VT); bf16* MIX = (bf16*)(ws + WS_MIX); bf16* HB = (bf16*)(ws + WS_H);
    const float* x = a.in[0];
    const int lo = a.ph_lo, hi_ph = a.ph_hi;
#if MK_COOP
    cg::grid_group grid = cg::this_grid();
    volatile LAS unsigned* bst = (volatile LAS unsigned*)(lds + 131072 + 64);
    if (tid < 4) bst[tid] = 0u;
    __syncthreads();
    XcdBarrier xbar = xcd_barrier_post((unsigned*)(ws + WS_CTL), bst);
#define SEAM(k) do { if (lo <= (k) && (k) + 1 < hi_ph) { if ((k) == 0) grid.sync(); else xcd_barrier(xbar); } } while (0)
#else
#define SEAM(k) do { } while (0)
#endif
#ifndef PHMASK
#define PHMASK 0x1ff
#endif
#define IN(k) (((PHMASK >> (k)) & 1) && lo <= (k) && (k) < hi_ph)

#ifndef DUP_P0
#define DUP_P0 1
#endif
    if (IN(0)) for (int rep0 = 0; rep0 < DUP_P0; ++rep0) {
        LAS float* scr = (LAS float*)(lds + wave * 16384);
        constexpr int I_IN = (DM / 64) * (NIN / 32), I_OUT = (DM / 64) * (DM / 32), I_UP = (DM / 64) * (DFF / 32), I_DN = (DFF / 64) * (DM / 32);
        for (int it = gw; it < I_IN + I_OUT + I_UP + I_DN; it += NGW) { int r = it;
            if (r < I_IN) { p0_transpose_item<true>(a.in[3], DM, NIN, Win_t, scr, r, lane); continue; } r -= I_IN;
            if (r < I_OUT) { p0_transpose_item<false>(a.in[20], DM, DM, Wout_t, scr, r, lane); continue; } r -= I_OUT;
            if (r < I_UP) { p0_transpose_item<false>(a.in[23], DM, DFF, Wup_t, scr, r, lane); continue; } r -= I_UP;
            p0_transpose_item<false>(a.in[24], DFF, DM, Wdown_t, scr, r, lane); }
        for (int m = gw; m < MTOK; m += NGW) rms_row_to_bf16(x + (size_t)m * DM, a.in[1], XN + (size_t)m * DM, lane);
        for (int i = bx * NTHR + tid; i < SEQ * 32; i += G * NTHR) { const int pos = i >> 5, k = i & 31;
            const float inv = exp2f(-(float)(2 * k) * (13.287712379549449f / 64.0f)); const float ang = (float)pos * inv;
            ROPE[2 * i] = cosf(ang); ROPE[2 * i + 1] = sinf(ang); }
        __syncthreads();
        for (int pg = bx; pg < SEQ / 16; pg += G) filter_item(lds, a, HR, pg, tid);
    }
    SEAM(0);
#ifndef DUP_P1
#define DUP_P1 1
#endif
    if (IN(1)) for (int rep1 = 0; rep1 < DUP_P1; ++rep1) {
        { pg8::Gemm g{Win_t, XN, 2048, MTOK, DM}; pg8::StaticOrder S; S.init(2048, MTOK, G, bx);
          pg8::EpiUV E{UVT, VT};
          pg8::gemm_phase<pg8::EpiUV, pg8::StaticOrder, true, true>(lds, g, S, E); }
        { pg8::Gemm g{XN, Win_t + (size_t)2048 * DM, MTOK, 1024, DM}; pg8::StaticOrder S; S.init(MTOK, 1024, G, bx);
          pg8::EpiRope E{QK, KT, ROPE, QSCALE};
          pg8::gemm_phase<pg8::EpiRope, pg8::StaticOrder, true, true>(lds, g, S, E); }
    }
    SEAM(1);
    if (IN(2)) {
        float lam;
        { const float p1 = a.in[15][lane] * a.in[16][lane], p2 = a.in[17][lane] * a.in[18][lane];
          lam = expf(wave_sum(p1)) - expf(wave_sum(p2)) + 0.2f; }
#ifndef DUP_ATT
#define DUP_ATT 1
#endif
#ifndef DUP_HY
#define DUP_HY 1
#endif
#ifndef ATT_VAR
#define ATT_VAR 0
#endif
        for (int u = bx; u < 1024; u += G) { const int bh = (u & 7) + 8 * (u >> 8), qb = (u >> 3) & 31;
            att::unit<0>(lds, QK, KT, VT, MIX, a.in[19], lam, bh >> 2, bh & 3, qb); }
        if (DUP_ATT > 1)
        for (int u = bx; u < 1024; u += G) { const int bh = (u & 7) + 8 * (u >> 8), qb = (u >> 3) & 31;
            att::unit<ATT_VAR>(lds, QK, KT, VT, MO, a.in[19], lam, bh >> 2, bh & 3, qb); }
        for (int rep = 0; rep < DUP_HY; ++rep)
        for (int c = bx; c < HYW; c += G) hy::channel(lds, UVT, HR, a.in[4], a.in[5], YT, c);
    }
    SEAM(2);
#ifndef DUP_P3
#define DUP_P3 1
#endif
    if (IN(3)) for (int rep3 = 0; rep3 < DUP_P3; ++rep3) {
        LAS unsigned short* scr = (LAS unsigned short*)(lds + wave * 16384);
        for (int it = gw; it < 8 * (MTOK / 64); it += NGW) { const int ct = it & 7, mt = it >> 3; const int c0 = 64 * ct, m0 = 64 * mt;
#pragma unroll
            for (int i = 0; i < 8; ++i) { const int cc = 8 * i + (lane >> 3), mch = lane & 7; const u32x4 v = *(const u32x4*)(YT + (size_t)(c0 + cc) * MTOK + m0 + 8 * mch);
                LAS unsigned* d = (LAS unsigned*)(scr + cc * 66 + 8 * mch); d[0] = v.x; d[1] = v.y; d[2] = v.z; d[3] = v.w; }
            LDS_WAIT(); asm volatile("" ::: "memory");
#pragma unroll
            for (int i = 0; i < 8; ++i) { const int mm = 8 * i + (lane >> 3), cch = lane & 7; const LAS unsigned short* s = scr + (8 * cch) * 66 + mm;
                u32x4 o; o.x = (unsigned)s[0] | ((unsigned)s[66] << 16); o.y = (unsigned)s[2 * 66] | ((unsigned)s[3 * 66] << 16);
                o.z = (unsigned)s[4 * 66] | ((unsigned)s[5 * 66] << 16); o.w = (unsigned)s[6 * 66] | ((unsigned)s[7 * 66] << 16);
                *(u32x4*)(MIX + (size_t)(m0 + mm) * 1024 + c0 + 8 * cch) = o; }
            LDS_WAIT(); asm volatile("" ::: "memory"); }
        __syncthreads();
    }
    SEAM(3);
    if (IN(4)) {
        pg8::Gemm g{MIX, Wout_t, MTOK, DM, DM}; pg8::StaticOrder S; S.init(MTOK, DM, G, bx);
        pg8::EpiBf16<0> E{MO, DM};
        pg8::gemm_phase<pg8::EpiBf16<0>, pg8::StaticOrder, true, true>(lds, g, S, E);
    }
    SEAM(4);
#ifndef DUP_P5
#define DUP_P5 1
#endif
    if (IN(5)) for (int rep5 = 0; rep5 < DUP_P5; ++rep5) {
        const f32x4* gp = (const f32x4*)a.in[2] + lane; const f32x4* gm = (const f32x4*)a.in[21] + lane;
        for (int m = gw; m < MTOK; m += NGW) {
            const f32x4* xr = (const f32x4*)(x + (size_t)m * DM) + lane; const u32x2* mr = (const u32x2*)(MO + (size_t)m * DM) + lane;
            f32x4 v[4], y[4]; float s = 0.f;
#pragma unroll
            for (int j = 0; j < 4; ++j) { v[j] = xr[64 * j]; const u32x2 w = mr[64 * j]; y[j] = (f32x4){bflo(w.x), bfhi(w.x), bflo(w.y), bfhi(w.y)};
                s += (y[j].x * y[j].x + y[j].y * y[j].y) + (y[j].z * y[j].z + y[j].w * y[j].w); }
            const float r = 1.0f / sqrtf(wave_sum(s) * (1.f / DM) + NORM_EPS); float s2 = 0.f;
            f32x4* orow = (f32x4*)(a.out + (size_t)m * DM) + lane;
#pragma unroll
            for (int j = 0; j < 4; ++j) { const f32x4 g = gp[64 * j]; v[j] = v[j] + y[j] * r * g; orow[64 * j] = v[j];
                s2 += (v[j].x * v[j].x + v[j].y * v[j].y) + (v[j].z * v[j].z + v[j].w * v[j].w); }
            const float r2 = 1.0f / sqrtf(wave_sum(s2) * (1.f / DM) + NORM_EPS);
            unsigned long long* o8 = (unsigned long long*)(XN + (size_t)m * DM) + lane;
#pragma unroll
            for (int j = 0; j < 4; ++j) { const f32x4 g = gm[64 * j];
                o8[64 * j] = (unsigned long long)pk2(v[j].x * r2 * g.x, v[j].y * r2 * g.y) | ((unsigned long long)pk2(v[j].z * r2 * g.z, v[j].w * r2 * g.w) << 32); }
        }
    }
    SEAM(5);
#ifndef DUP_P6
#define DUP_P6 1
#endif
    if (IN(6)) for (int rep6 = 0; rep6 < DUP_P6; ++rep6) {
        pg8::Gemm g{XN, Wup_t, MTOK, DFF, DM}; pg8::StaticOrder S; S.init(MTOK, DFF, G, bx);
        pg8::EpiBf16<1> E{HB, DFF};
        pg8::gemm_phase<pg8::EpiBf16<1>, pg8::StaticOrder, true, true>(lds, g, S, E);
    }
    SEAM(6);
    if (IN(7)) {
        pg8::Gemm g{HB, Wdown_t, MTOK, DM, DFF}; pg8::StaticOrder S; S.init(MTOK, DM, G, bx);
        pg8::EpiBf16<0> E{MO, DM};
        pg8::gemm_phase<pg8::EpiBf16<0>, pg8::StaticOrder, true, true>(lds, g, S, E);
    }
    SEAM(7);
    if (IN(8)) {
        const f32x4* gp = (const f32x4*)a.in[22] + lane;
        for (int m = gw; m < MTOK; m += NGW) {
            f32x4* orow = (f32x4*)(a.out + (size_t)m * DM) + lane; const u32x2* mr = (const u32x2*)(MO + (size_t)m * DM) + lane;
            f32x4 v[4], y[4]; float s = 0.f;
#pragma unroll
            for (int j = 0; j < 4; ++j) { v[j] = orow[64 * j]; const u32x2 w = mr[64 * j]; y[j] = (f32x4){bflo(w.x), bfhi(w.x), bflo(w.y), bfhi(w.y)};
                s += (y[j].x * y[j].x + y[j].y * y[j].y) + (y[j].z * y[j].z + y[j].w * y[j].w); }
            const float r = 1.0f / sqrtf(wave_sum(s) * (1.f / DM) + NORM_EPS);
#pragma unroll
            for (int j = 0; j < 4; ++j) { const f32x4 g = gp[64 * j]; orow[64 * j] = v[j] + y[j] * r * g; }
        }
    }
#undef IN
#undef SEAM
}

constexpr int NPHASE = 9;
extern "C" void kernel_launch(void* const* d_in, const int* in_sizes, int n_in, void* d_out, int out_size, void* d_ws, size_t ws_size, hipStream_t stream) {
    static int grid = 0;
    if (grid == 0) {
        if (n_in != 25 || in_sizes[0] != MTOK * DM || out_size != MTOK * DM || ws_size < WS_END) {
            fprintf(stderr, "kernel_launch: unexpected shapes (n_in %d in0 %d out %d ws %zu)\n", n_in, n_in > 0 ? in_sizes[0] : -1, out_size, ws_size); grid = -1; return; }
        int dev = 0, cus = 0, per_cu = 0;
        hipGetDevice(&dev); hipDeviceGetAttribute(&cus, hipDeviceAttributeMultiprocessorCount, dev);
        hipFuncSetAttribute((const void*)fwd_kernel, hipFuncAttributeMaxDynamicSharedMemorySize, LDS_BYTES);
        hipOccupancyMaxActiveBlocksPerMultiprocessor(&per_cu, (const void*)fwd_kernel, NTHR, LDS_BYTES);
        if (per_cu < 1) { fprintf(stderr, "kernel_launch: occupancy query says %d blocks/CU\n", per_cu); per_cu = 1; }
        (void)hipGetLastError();
        grid = cus * 1;
    }
    if (grid < 0) return;
    Args a{};
    for (int i = 0; i < 25; ++i) a.in[i] = (const float*)d_in[i];
    a.out = (float*)d_out; a.ws = (unsigned char*)d_ws;
#if MK_COOP
    a.ph_lo = 0; a.ph_hi = NPHASE;
    if (hipMemsetAsync((unsigned char*)d_ws + WS_CTL, 0, CTL_BYTES, stream) != hipSuccess) { fprintf(stderr, "kernel_launch: memset of the barrier words failed\n"); return; }
    void* args[] = {&a};
    hipError_t e = hipLaunchCooperativeKernel((const void*)fwd_kernel, dim3(grid), dim3(NTHR), args, LDS_BYTES, stream);
    if (e != hipSuccess) fprintf(stderr, "cooperative launch failed: %s (grid %d)\n", hipGetErrorString(e), grid);
#else
    for (int p = 0; p < NPHASE; ++p) { a.ph_lo = p; a.ph_hi = p + 1; hipLaunchKernelGGL(fwd_kernel, dim3(grid), dim3(NTHR), LDS_BYTES, stream, a); }
#endif
}
```

```cpp
#include <hip/hip_runtime.h>
#include <hip/hip_cooperative_groups.h>
#include <cstdio>
#include <cstdint>
#include <cmath>
namespace cg = cooperative_groups;
#ifndef MK_COOP
#define MK_COOP 1
#endif
namespace pg8 {
#define PG8_LAS __attribute__((address_space(3)))
typedef unsigned short bf16_t;
typedef short bf16x8 __attribute__((ext_vector_type(8)));
typedef float f32x4 __attribute__((ext_vector_type(4)));
typedef unsigned u32x4 __attribute__((ext_vector_type(4)));
constexpr int BM = 256, BK = 64, HALF = 128, HTB = HALF * BK * 2  , STAGE_BYTES = 8 * HTB, NXCD = 8, WGM = 8;

__host__ __device__ __forceinline__ int lds_byte(int r, int c) { const int st = (r >> 4) * 2 + (c >> 5), rr = r & 15, cc = c & 31, ob = rr * 64 + cc * 2; return st * 1024 + (ob ^ (((ob >> 9) & 1) << 5)); }
__host__ __device__ __forceinline__ void stage_rc(int b, int& R, int& C) { const int st = b / 1024, sb = b % 1024, swz = sb ^ (((sb >> 9) & 1) << 5); R = (st >> 1) * 16 + swz / 64; C = (st & 1) * 32 + (swz % 64) / 2; }
__host__ __device__ __forceinline__ int perm32(int rho) { const int n = rho >> 4, i = rho & 15; return 8 * (i >> 2) + 4 * n + (i & 3); }

struct Unit { int pm, pn; };
struct Gemm { const bf16_t* A; const bf16_t* Bt; int M, N, K; };

struct StaticOrder {
    int nM, nN, nwg, G, c;
    __host__ __device__ void init(int M, int N, int G_, int c_) { nM = M / BM; nN = N / BM; nwg = nM * nN; G = G_; c = c_; }
    __host__ __device__ bool next(int i, Unit& u) const {
        const long L = (long)i * G + c; if (L >= nwg) return false;
        int wgid = (int)L; { const int q = nwg / NXCD, r = nwg % NXCD, xcd = wgid % NXCD, off = wgid / NXCD; wgid = (xcd < r ? xcd * (q + 1) : r * (q + 1) + (xcd - r) * q) + off; }
        const int nig = WGM * nN, gid = wgid / nig, fm = gid * WGM, gsz = (nM - fm) < WGM ? (nM - fm) : WGM;
        u.pm = fm + ((wgid % nig) % gsz); u.pn = (wgid % nig) / gsz; return true;
    }
    __device__ __forceinline__ void a_ready(const Unit&) const {}
    __device__ __forceinline__ void done(const Unit&) const {}
};

__device__ __forceinline__ unsigned cvt_pk_bf16(float lo, float hi) { unsigned r; asm volatile("v_cvt_pk_bf16_f32 %0, %1, %2" : "=v"(r) : "v"(lo), "v"(hi)); return r; }
typedef float f32x2 __attribute__((ext_vector_type(2)));
typedef float f32x2 __attribute__((ext_vector_type(2)));
typedef unsigned u32x2 __attribute__((ext_vector_type(2)));
template <int ACT> struct EpiBf16 {
    static constexpr bool PERM = true, AFTER_DRAIN = false;
    bf16_t* O; int ldc;
    __device__ __forceinline__ void operator()(const f32x4 (&acc)[2][2][4][2], const Unit& u, int wr, int wc, int fr, int fq) const {
        const int row0 = u.pm * BM + wr * 64 + fr; const int col0 = u.pn * BM + wc * 32 + 8 * fq;
#pragma unroll
        for (int ai = 0; ai < 2; ++ai)
#pragma unroll
            for (int m = 0; m < 4; ++m) { bf16_t* rowp = O + (size_t)(row0 + ai * HALF + m * 16) * ldc + col0;
#pragma unroll
                for (int bj = 0; bj < 2; ++bj) { f32x4 v0 = acc[ai][bj][m][0], v1 = acc[ai][bj][m][1];
                    if (ACT == 1) {
#pragma unroll
                        for (int j = 0; j < 4; ++j) { float a = v0[j] > 0.f ? v0[j] : 0.f; v0[j] = a * a; float b = v1[j] > 0.f ? v1[j] : 0.f; v1[j] = b * b; } }
                    u32x4 w; w.x = cvt_pk_bf16(v0[0], v0[1]); w.y = cvt_pk_bf16(v0[2], v0[3]); w.z = cvt_pk_bf16(v1[0], v1[1]); w.w = cvt_pk_bf16(v1[2], v1[3]);
                    *(u32x4*)(rowp + bj * HALF) = w; } }
    }
};
struct EpiRope {
    static constexpr bool PERM = true, AFTER_DRAIN = false;
    bf16_t* Q; bf16_t* KT; const float* rope; float qscale;
    __device__ __forceinline__ void operator()(const f32x4 (&acc)[2][2][4][2], const Unit& u, int wr, int wc, int fr, int fq) const {
        const int row0 = u.pm * BM + wr * 64 + fr; const int col0 = u.pn * BM + wc * 32 + 8 * fq;
        const int g = (wc & 1) * 4 + fq;
        const float sc = (u.pn < 2) ? qscale : 1.0f;
#pragma unroll
        for (int ai = 0; ai < 2; ++ai)
#pragma unroll
            for (int m = 0; m < 4; ++m) { const int row = row0 + ai * HALF + m * 16; const int pos = row & 4095;
                const f32x4 cs0 = *(const f32x4*)(rope + (size_t)pos * 64 + 8 * g), cs1 = *(const f32x4*)(rope + (size_t)pos * 64 + 8 * g + 4);
                const float c[4] = {cs0[0], cs0[2], cs1[0], cs1[2]}, s[4] = {cs0[1], cs0[3], cs1[1], cs1[3]};
                bf16_t* rowp;
                if (u.pn < 2) rowp = Q + (size_t)row * 512 + col0;
                else { const int ck = col0 - 512, hh = ck >> 7, cc = ck & 127; rowp = KT + ((size_t)(((row >> 12) * 4 + hh) * 64 + (pos >> 6)) * 8192 + (pos & 63) * 128 + cc); }
#pragma unroll
                for (int bj = 0; bj < 2; ++bj) { const f32x4 lo = acc[ai][bj][m][0], hi = acc[ai][bj][m][1]; float ol[4], oh[4];
#pragma unroll
                    for (int j = 0; j < 4; ++j) { ol[j] = (lo[j] * c[j] - hi[j] * s[j]) * sc; oh[j] = (hi[j] * c[j] + lo[j] * s[j]) * sc; }
                    u32x4 w; w.x = cvt_pk_bf16(ol[0], ol[1]); w.y = cvt_pk_bf16(ol[2], ol[3]); w.z = cvt_pk_bf16(oh[0], oh[1]); w.w = cvt_pk_bf16(oh[2], oh[3]);
                    *(u32x4*)(rowp + ((u.pn < 2) ? bj * HALF : bj * (64 * 8192))) = w; } }
    }
};
struct EpiUV {
    static constexpr bool PERM = true, AFTER_DRAIN = false;
    bf16_t* UT; bf16_t* VT;
    __device__ __forceinline__ void operator()(const f32x4 (&acc)[2][2][4][2], const Unit& u, int wr, int wc, int fr, int fq) const {
        const int row0 = u.pm * BM + wr * 64 + fr; const int col0 = u.pn * BM + wc * 32 + 8 * fq;
#pragma unroll
        for (int ai = 0; ai < 2; ++ai)
#pragma unroll
            for (int m = 0; m < 4; ++m) { const int row = row0 + ai * HALF + m * 16;
#pragma unroll
                for (int bj = 0; bj < 2; ++bj) { const int col = col0 + bj * HALF; bf16_t* p;
                    if (u.pm < 6) p = UT + (size_t)row * 32768 + col;
                    else { const int ev = row - 1536, hh = ev >> 7, ee = ev & 127, bb = col >> 12, pos = col & 4095;
                        p = VT + ((size_t)((bb * 4 + hh) * 64 + (pos >> 6)) * 8192 + ee * 64 + (pos & 48) + ((pos & 8) >> 1)); }
                    const f32x4 v0 = acc[ai][bj][m][0], v1 = acc[ai][bj][m][1];
                    u32x4 w; w.x = cvt_pk_bf16(v0[0], v0[1]); w.y = cvt_pk_bf16(v0[2], v0[3]); w.z = cvt_pk_bf16(v1[0], v1[1]); w.w = cvt_pk_bf16(v1[2], v1[3]);
                    if (u.pm < 6) *(u32x4*)p = w;
                    else { *(u32x2*)p = (u32x2){w.x, w.y}; *(u32x2*)(p + 8) = (u32x2){w.z, w.w}; } } }
    }
};
template <class Epi, class Sched, bool ALIGN_EPI = false, bool SP2 = false>
__device__ __forceinline__ void gemm_phase(PG8_LAS unsigned char* lds, const Gemm g, const Sched& S, const Epi& E) {
    const int tid = threadIdx.x, wid = __builtin_amdgcn_readfirstlane(tid >> 6), lane = tid & 63, wr = wid >> 2, wc = wid & 3, fr = lane & 15, fq = lane >> 4;
    const int K = g.K, nt = K / BK;
    unsigned voffA[2], voffB[2];
#pragma unroll
    for (int i = 0; i < 2; ++i) { int R, C; stage_rc(tid * 16 + i * 8192, R, C); const int Rb = Epi::PERM ? ((R & ~31) + perm32(R & 31)) : R;
        voffA[i] = (unsigned)(R * K + C) * 2u; voffB[i] = (unsigned)(Rb * K + C) * 2u; }
    const size_t kstep = (size_t)(BK * 2);
    const size_t hstep = (size_t)HALF * K * 2;
    const size_t tstep = 2 * hstep;
    const unsigned ldsw = (unsigned)wid * 1024u;
    const int aoff = lds_byte(wr * 64 + fr, fq * 8), boff = lds_byte(wc * 32 + fr, fq * 8);
#define PG8_SA(b, h) (((b) * 2 + (h)) * HTB)
#define PG8_SB(b, h) ((4 + (b) * 2 + (h)) * HTB)
#define PG8_STAGE(bufoff, gbase, voff) do { _Pragma("unroll") for (int _i = 0; _i < 2; ++_i) \
        __builtin_amdgcn_global_load_lds((const unsigned*)((const char*)(gbase) + (voff)[_i]), (PG8_LAS unsigned*)(lds + (bufoff) + ldsw + _i * 8192), 16, 0, 0); } while (0)
#define PG8_LDA(dst, b, h) do { _Pragma("unroll") for (int m = 0; m < 4; ++m) _Pragma("unroll") for (int k = 0; k < 2; ++k) dst[m][k] = *(const PG8_LAS bf16x8*)(lds + PG8_SA(b, h) + aoff + m * 2048 + k * 1024); } while (0)
#define PG8_LDB(dst, b, h) do { _Pragma("unroll") for (int n = 0; n < 2; ++n) _Pragma("unroll") for (int k = 0; k < 2; ++k) dst[n][k] = *(const PG8_LAS bf16x8*)(lds + PG8_SB(b, h) + boff + n * 2048 + k * 1024); } while (0)
#define PG8_MMA(ai, bj, At, Bt) do { __builtin_amdgcn_s_setprio(1); _Pragma("unroll") for (int m = 0; m < 4; ++m) _Pragma("unroll") for (int n = 0; n < 2; ++n) _Pragma("unroll") for (int k = 0; k < 2; ++k) \
        acc[ai][bj][m][n] = __builtin_amdgcn_mfma_f32_16x16x32_bf16(Bt[n][k], At[m][k], acc[ai][bj][m][n], 0, 0, 0); __builtin_amdgcn_s_setprio(0); } while (0)
#define PG8_WAIT_V(n) asm volatile("s_waitcnt vmcnt(" #n ")" ::: "memory")
#define PG8_WAIT_L(n) asm volatile("s_waitcnt lgkmcnt(" #n ")" ::: "memory")
#define PG8_BAR __builtin_amdgcn_s_barrier()
#define PG8_SCHED __builtin_amdgcn_sched_barrier(0)
    Unit cur, nxt; int ui = 0;
    if (!S.next(0, cur)) return;
    f32x4 acc[2][2][4][2];
#pragma unroll
    for (int a = 0; a < 2; ++a)
#pragma unroll
        for (int b = 0; b < 2; ++b)
#pragma unroll
            for (int m = 0; m < 4; ++m)
#pragma unroll
                for (int n = 0; n < 2; ++n) acc[a][b][m][n] = (f32x4){0.f, 0.f, 0.f, 0.f};
    bf16x8 At[4][2], B0[2][2], B1[2][2];
    const char* cA = (const char*)g.A + (size_t)cur.pm * tstep; const char* cB = (const char*)g.Bt + (size_t)cur.pn * tstep;
    S.a_ready(cur);
    if constexpr (SP2) {
        PG8_STAGE(PG8_SB(0, 0), cB, voffB); PG8_STAGE(PG8_SB(0, 1), cB + hstep, voffB); PG8_STAGE(PG8_SA(0, 0), cA, voffA); PG8_STAGE(PG8_SA(0, 1), cA + hstep, voffA);
        if (wr == 1) PG8_BAR;
        PG8_WAIT_V(2); PG8_BAR;
        PG8_STAGE(PG8_SB(1, 0), cB + kstep, voffB); PG8_STAGE(PG8_SA(1, 0), cA + kstep, voffA); PG8_STAGE(PG8_SB(1, 1), cB + hstep + kstep, voffB);
        PG8_WAIT_V(6); PG8_BAR;
    } else {
        PG8_STAGE(PG8_SB(0, 0), cB, voffB); PG8_STAGE(PG8_SA(0, 0), cA, voffA); PG8_STAGE(PG8_SB(0, 1), cB + hstep, voffB); PG8_STAGE(PG8_SA(0, 1), cA + hstep, voffA);
        if (wr == 1) PG8_BAR;
        PG8_WAIT_V(4); PG8_BAR;
        PG8_STAGE(PG8_SB(1, 0), cB + kstep, voffB); PG8_STAGE(PG8_SA(1, 0), cA + kstep, voffA); PG8_STAGE(PG8_SB(1, 1), cB + hstep + kstep, voffB);
        PG8_WAIT_V(6); PG8_BAR;
    }
    for (;;) {
        const bool has_next = S.next(ui + 1, nxt);
        const char* nA = has_next ? (const char*)g.A + (size_t)nxt.pm * tstep : cA; const char* nB = has_next ? (const char*)g.Bt + (size_t)nxt.pn * tstep : cB;
        for (int t = 0; t < nt; t += 2) {
            const bool last = (t == nt - 2);
            const char* a1 = cA + (size_t)(t + 1) * kstep;
            const char* a2 = last ? nA : cA + (size_t)(t + 2) * kstep; const char* b2 = last ? nB : cB + (size_t)(t + 2) * kstep;
            const char* a3 = a2 + kstep; const char* b3 = b2 + kstep;
            if (last && has_next) S.a_ready(nxt);
            if constexpr (SP2) {
            PG8_LDB(B0, 0, 0); PG8_LDB(B1, 0, 1); PG8_SCHED; PG8_LDA(At, 0, 0); PG8_STAGE(PG8_SA(1, 1), a1 + hstep, voffA);
            PG8_WAIT_V(8); PG8_WAIT_L(0); PG8_BAR; PG8_MMA(0, 0, At, B0); PG8_MMA(0, 1, At, B1); PG8_BAR; PG8_SCHED;
            PG8_LDA(At, 0, 1); PG8_STAGE(PG8_SB(0, 0), b2, voffB); PG8_STAGE(PG8_SB(0, 1), b2 + hstep, voffB); PG8_STAGE(PG8_SA(0, 0), a2, voffA);
            PG8_WAIT_V(8); PG8_WAIT_L(0); PG8_BAR; PG8_MMA(1, 0, At, B0); PG8_MMA(1, 1, At, B1); PG8_BAR; PG8_SCHED;
            PG8_LDB(B0, 1, 0); PG8_LDB(B1, 1, 1); PG8_SCHED; PG8_LDA(At, 1, 0); PG8_STAGE(PG8_SA(0, 1), a2 + hstep, voffA);
            PG8_WAIT_V(8); PG8_WAIT_L(0); PG8_BAR; PG8_MMA(0, 0, At, B0); PG8_MMA(0, 1, At, B1); PG8_BAR; PG8_SCHED;
            PG8_LDA(At, 1, 1); PG8_STAGE(PG8_SB(1, 0), b3, voffB); PG8_STAGE(PG8_SB(1, 1), b3 + hstep, voffB); PG8_STAGE(PG8_SA(1, 0), a3, voffA);
            PG8_WAIT_V(8); PG8_WAIT_L(0); PG8_BAR; PG8_MMA(1, 0, At, B0); PG8_MMA(1, 1, At, B1); PG8_BAR; PG8_SCHED;
            } else {
            PG8_LDB(B0, 0, 0); PG8_SCHED; PG8_LDA(At, 0, 0); PG8_STAGE(PG8_SA(1, 1), a1 + hstep, voffA);
            PG8_WAIT_L(8); PG8_BAR; PG8_WAIT_L(0); PG8_MMA(0, 0, At, B0); PG8_BAR; PG8_SCHED;
            PG8_LDB(B1, 0, 1); PG8_STAGE(PG8_SB(0, 0), b2, voffB);
            PG8_BAR; PG8_WAIT_L(0); PG8_MMA(0, 1, At, B1); PG8_BAR;
            PG8_LDA(At, 0, 1); PG8_STAGE(PG8_SA(0, 0), a2, voffA);
            PG8_BAR; PG8_WAIT_L(0); PG8_MMA(1, 0, At, B0); PG8_BAR; PG8_SCHED;
            PG8_STAGE(PG8_SB(0, 1), b2 + hstep, voffB);
            PG8_WAIT_V(6); PG8_BAR; PG8_MMA(1, 1, At, B1); PG8_BAR;
            PG8_LDB(B0, 1, 0); PG8_SCHED; PG8_LDA(At, 1, 0); PG8_STAGE(PG8_SA(0, 1), a2 + hstep, voffA);
            PG8_WAIT_L(8); PG8_BAR; PG8_WAIT_L(0); PG8_MMA(0, 0, At, B0); PG8_BAR; PG8_SCHED;
            PG8_LDB(B1, 1, 1); PG8_STAGE(PG8_SB(1, 0), b3, voffB);
            PG8_BAR; PG8_WAIT_L(0); PG8_MMA(0, 1, At, B1); PG8_BAR;
            PG8_LDA(At, 1, 1); PG8_STAGE(PG8_SA(1, 0), a3, voffA);
            PG8_BAR; PG8_WAIT_L(0); PG8_MMA(1, 0, At, B0); PG8_BAR; PG8_SCHED;
            PG8_STAGE(PG8_SB(1, 1), b3 + hstep, voffB);
            PG8_WAIT_V(6); PG8_BAR; PG8_MMA(1, 1, At, B1); PG8_BAR;
            }
        }
        if constexpr (ALIGN_EPI) { if (wr == 0) PG8_BAR; }
        if constexpr (!Epi::AFTER_DRAIN) { E(acc, cur, wr, wc, fr, fq); S.done(cur); }
        if (!has_next) break;
#pragma unroll
        for (int a = 0; a < 2; ++a)
#pragma unroll
            for (int b = 0; b < 2; ++b)
#pragma unroll
                for (int m = 0; m < 4; ++m)
#pragma unroll
                    for (int n = 0; n < 2; ++n) acc[a][b][m][n] = (f32x4){0.f, 0.f, 0.f, 0.f};
        cur = nxt; cA = nA; cB = nB; ++ui;
        if constexpr (ALIGN_EPI) { if (wr == 1) PG8_BAR; }
    }
    PG8_WAIT_V(0);
    if constexpr (!ALIGN_EPI) { if (wr == 0) PG8_BAR; }
    PG8_BAR;
    if constexpr (Epi::AFTER_DRAIN) { E.fused(acc, cur, wr, wc, fr, fq, lds, wid, lane); S.done(cur); }
#undef PG8_SA
#undef PG8_SB
#undef PG8_STAGE
#undef PG8_LDA
#undef PG8_LDB
#undef PG8_MMA
#undef PG8_WAIT_V
#undef PG8_WAIT_L
#undef PG8_BAR
#undef PG8_SCHED
}
}

constexpr int BATCH = 8, SEQ = 4096, DM = 1024, MTOK = BATCH * SEQ, HYW = 512, NIN = 3072, DFF = 4096;
constexpr int NWAVES = 8, NTHR = 512;
constexpr float NORM_EPS = 1e-6f, SUBLN_EPS = 1e-5f;
constexpr float QSCALE = 0.125f * 1.4426950408889634f;
constexpr int HRLEN = 8224;
constexpr size_t MiB = 1u << 20;
constexpr size_t WS_WIN = 0, WS_WOUT = 6 * MiB, WS_WUP = 8 * MiB, WS_WDOWN = 16 * MiB;
constexpr size_t WS_HR = 24 * MiB;
constexpr size_t WS_ROPE = 33 * MiB;
constexpr size_t WS_CTL = 34 * MiB, CTL_BYTES = 16384;
constexpr size_t WS_XN = 40 * MiB;
constexpr size_t WS_MO = 104 * MiB;
constexpr size_t WS_YT = 168 * MiB;
constexpr size_t WS_UVT = 200 * MiB;
constexpr size_t WS_QK = 328 * MiB;
constexpr size_t WS_KT = 360 * MiB;
constexpr size_t WS_VT = 296 * MiB;
constexpr size_t WS_MIX = 392 * MiB;
constexpr size_t WS_H = 200 * MiB;
constexpr size_t WS_END = 456 * MiB;
constexpr int LDS_BYTES = 135168;

#define LAS __attribute__((address_space(3)))
typedef unsigned short bf16;
typedef unsigned u32x4 __attribute__((ext_vector_type(4)));
typedef unsigned u32x2 __attribute__((ext_vector_type(2)));
typedef float f32x4 __attribute__((ext_vector_type(4)));
typedef float f32x16 __attribute__((ext_vector_type(16)));
typedef short bf16x8 __attribute__((ext_vector_type(8)));
typedef short s16x4 __attribute__((ext_vector_type(4)));

__device__ __forceinline__ unsigned f2bf(float f) { unsigned u = __builtin_bit_cast(unsigned, f); return (u + 0x7fffu + ((u >> 16) & 1u)) >> 16; }
__device__ __forceinline__ unsigned pk2(float lo, float hi) { return f2bf(lo) | (f2bf(hi) << 16); }
typedef float f32x2_t __attribute__((ext_vector_type(2))); typedef __bf16 bf16x2_t __attribute__((ext_vector_type(2)));
__device__ __forceinline__ unsigned cvtpk(float lo, float hi) { f32x2_t v = {lo, hi}; bf16x2_t b = __builtin_convertvector(v, bf16x2_t); return __builtin_bit_cast(unsigned, b); }
__device__ __forceinline__ float bf2f(unsigned short b) { return __builtin_bit_cast(float, (unsigned)b << 16); }
__device__ __forceinline__ float bflo(unsigned w) { return __builtin_bit_cast(float, w << 16); }
__device__ __forceinline__ float bfhi(unsigned w) { return __builtin_bit_cast(float, w & 0xffff0000u); }
__device__ __forceinline__ float wave_sum(float v) {
#pragma unroll
    for (int o = 1; o < 64; o <<= 1) v += __shfl_xor(v, o);
    return v;
}
__device__ __forceinline__ float swap_hi(float v) { return __shfl_xor(v, 32); }
#define LDS_WAIT() asm volatile("s_waitcnt lgkmcnt(0)" ::: "memory")

struct Args { const float* in[25]; float* out; unsigned char* ws; int ph_lo, ph_hi; };

__device__ __forceinline__ int win_src(int n) {
    if (n < 1536) return n;
    if (n < 2048) return n + 1024;
    const int pp = n - 2048, grp = pp >> 6, p = pp & 63, g = p >> 3, e = p & 7;
    const int d = (e < 4) ? (4 * g + e) : (32 + 4 * g + (e - 4));
    return 1536 + grp * 64 + d;
}
template <bool PERMW>
__device__ __forceinline__ void p0_transpose_item(const float* W, int K, int N, bf16* WT, LAS float* scr, int item, int lane) {
    const int nblk = N / 32, kb = item / nblk, nb = item % nblk, k0 = 64 * kb, n0 = 32 * nb;
    const int sc = PERMW ? win_src(n0 + (lane & 31)) : (n0 + (lane & 31));
#pragma unroll 8
    for (int i = 0; i < 32; ++i) { const int kk = 2 * i + (lane >> 5); scr[kk * 33 + (lane & 31)] = W[(size_t)(k0 + kk) * N + sc]; }
    LDS_WAIT(); asm volatile("" ::: "memory");
    const int c = lane & 7;
#pragma unroll
    for (int j = 0; j < 4; ++j) { const int n = (lane >> 3) + 8 * j; const LAS float* s = scr + (8 * c) * 33 + n;
        u32x4 o; o.x = pk2(s[0 * 33], s[1 * 33]); o.y = pk2(s[2 * 33], s[3 * 33]); o.z = pk2(s[4 * 33], s[5 * 33]); o.w = pk2(s[6 * 33], s[7 * 33]);
        *(u32x4*)(WT + (size_t)(n0 + n) * K + k0 + 8 * c) = o; }
    LDS_WAIT(); asm volatile("" ::: "memory");
}
__device__ __forceinline__ void rms_row_to_bf16(const float* xrow, const float* gain, bf16* orow, int lane) {
    const f32x4* xr = (const f32x4*)xrow + lane; const f32x4* gr = (const f32x4*)gain + lane;
    f32x4 v[4]; float s = 0.f;
#pragma unroll
    for (int j = 0; j < 4; ++j) { v[j] = xr[64 * j]; s += (v[j].x * v[j].x + v[j].y * v[j].y) + (v[j].z * v[j].z + v[j].w * v[j].w); }
    const float r = 1.0f / sqrtf(wave_sum(s) * (1.f / DM) + NORM_EPS);
    unsigned long long* o8 = (unsigned long long*)orow + lane;
#pragma unroll
    for (int j = 0; j < 4; ++j) { const f32x4 g = gr[64 * j];
        o8[64 * j] = (unsigned long long)pk2(v[j].x * r * g.x, v[j].y * r * g.y) | ((unsigned long long)pk2(v[j].z * r * g.z, v[j].w * r * g.w) << 32); }
}

__device__ __forceinline__ void filter_item(LAS unsigned char* lds, const Args& a, bf16* HR, int pg, int tid) {
    LAS float* Z = (LAS float*)lds;
    LAS float* HA = Z + 16 * 33;
    LAS float* HB = HA + 16 * 64;
    const float* w1 = a.in[6]; const float* b1 = a.in[7]; const float* w2 = a.in[8]; const float* b2 = a.in[9];
    const float* w3 = a.in[10]; const float* b3 = a.in[11]; const float* w4 = a.in[12]; const float* freq = a.in[13]; const float* fbias = a.in[14];
    const int t0 = 16 * pg;
    for (int i = tid; i < 16 * 33; i += NTHR) { const int p = i / 33, f = i % 33; const int pos = t0 + p; float val;
        if (f == 0) val = (float)pos * (1.0f / (float)(SEQ - 1));
        else { const int j = (f - 1) & 15; const float fj = 1e-4f + (float)j * ((15.0f - 1e-4f) / 15.0f); const float w = (6.283185307179586f / (float)SEQ) * (float)pos; const float arg = fj * w;
            val = (f <= 16) ? cosf(arg) : -sinf(arg); }
        Z[i] = val; }
    __syncthreads();
    for (int o = tid; o < 1024; o += NTHR) { const int p = o >> 6, n = o & 63; float acc = b1[n];
#pragma unroll 3
        for (int f = 0; f < 33; ++f) acc += Z[p * 33 + f] * w1[f * 64 + n];
        HA[o] = sinf(freq[n] * acc); }
    __syncthreads();
    for (int o = tid; o < 1024; o += NTHR) { const int p = o >> 6, n = o & 63; float acc = b2[n];
#pragma unroll 4
        for (int f = 0; f < 64; ++f) acc += HA[p * 64 + f] * w2[f * 64 + n];
        HB[o] = sinf(freq[n] * acc); }
    __syncthreads();
    for (int o = tid; o < 1024; o += NTHR) { const int p = o >> 6, n = o & 63; float acc = b3[n];
#pragma unroll 4
        for (int f = 0; f < 64; ++f) acc += HB[p * 64 + f] * w3[f * 64 + n];
        HA[o] = sinf(freq[n] * acc); }
    __syncthreads();
    {   const int c = tid;
        float af[16], ab[16];
#pragma unroll
        for (int p = 0; p < 16; ++p) { af[p] = 0.f; ab[p] = 0.f; }
#pragma unroll 2
        for (int k = 0; k < 64; ++k) { const float wf = w4[k * 1024 + c], wb = w4[k * 1024 + 512 + c];
#pragma unroll
            for (int p = 0; p < 16; ++p) { const float hv = HA[p * 64 + k]; af[p] += hv * wf; ab[p] += hv * wb; } }
        const float min_decay = -4.605170185988091f / 1.5f, max_decay = -4.605170185988091f / 0.3f;
        const float adelta = fabsf(min_decay + (float)c * ((max_decay - min_decay) / 511.0f));
        bf16* hr = HR + (size_t)c * HRLEN;
#pragma unroll
        for (int p = 0; p < 16; ++p) { const int pos = t0 + p; const float tl = (float)pos * (1.0f / (float)(SEQ - 1)); const float dec = expf(-tl * adelta);
            const float vf = af[p] * dec, vb = ab[p] * dec;
            if (pos == 0) hr[4096] = (bf16)f2bf(vf + vb + fbias[c]);
            else { hr[4096 - pos] = (bf16)f2bf(vf); hr[4096 + pos] = (bf16)f2bf(vb); } }
        if (pg == 0) { hr[0] = 0; for (int i = 8192; i < HRLEN; ++i) hr[i] = 0; }
    }
    __syncthreads();
}

namespace att {
constexpr int KP = 272, VP = 144, KBUF = 64 * KP, VBUF = 128 * VP, VOFF = 2 * KBUF;
constexpr int NT = SEQ / 64;
__device__ __forceinline__ float max3(float a, float b, float c) { return fmaxf(fmaxf(a, b), c); }
__device__ __forceinline__ float fadd_s(float a, float b) { float r; asm("v_add_f32_e32 %0, %1, %2" : "=v"(r) : "v"(a), "v"(b)); return r; }
#define SBAR() __builtin_amdgcn_sched_barrier(0)
__device__ __forceinline__ void v_load(bf16x8 (&vf)[4], const LAS unsigned char* vb, int ks) {
#pragma unroll
    for (int e = 0; e < 4; ++e) vf[e] = *(const LAS bf16x8*)(vb + e * 32 * VP + ks * 32);
}
__device__ __forceinline__ void pv_tile(f32x16 (&o)[4], const u32x4 (&P)[4], bf16x8 (&vf0)[4], const LAS unsigned char* vb) {
    bf16x8 vf1[4];
#pragma unroll
    for (int ks = 0; ks < 4; ++ks) { const bf16x8 pb = __builtin_bit_cast(bf16x8, P[ks]);
        if (ks == 0 || ks == 2) v_load(vf1, vb, ks + 1); else if (ks == 1) v_load(vf0, vb, 2);
        SBAR(); __builtin_amdgcn_s_setprio(1);
#pragma unroll
        for (int e = 0; e < 4; ++e) o[e] = __builtin_amdgcn_mfma_f32_32x32x16_bf16((ks & 1) ? vf1[e] : vf0[e], pb, o[e], 0, 0, 0);
        __builtin_amdgcn_s_setprio(0); SBAR(); }
}
__device__ __forceinline__ float xhalf_max(float v) { auto rr = __builtin_amdgcn_permlane32_swap(__float_as_uint(v), __float_as_uint(v), false, false); return fmaxf(__uint_as_float(rr[0]), __uint_as_float(rr[1])); }
__device__ __forceinline__ float xhalf_sum(float v) { auto rr = __builtin_amdgcn_permlane32_swap(__float_as_uint(v), __float_as_uint(v), false, false); return __uint_as_float(rr[0]) + __uint_as_float(rr[1]); }
constexpr int QOFF = 2 * KBUF + 3 * VBUF;
#define ATT_SLOT(T, PKW, PVW, PKL, PVL) do { const int t = (T); \
        const LAS unsigned char* kst = lds + (t & 1) * KBUF; \
        bf16x8 vf0[4]; \
        if (c == 1 && t > 0) { v_load(vf0, lds + VOFF + vprev + voff, 0); pv_tile(o, P, vf0, lds + VOFF + vprev + voff); } \
        if (t + 1 < NT && VAR != 4) { _Pragma("unroll") for (int i = 0; i < 2; ++i) { PKL[i] = *(const u32x4*)(gk[i] + (size_t)(t + 1) * 8192); PVL[i] = *(const u32x4*)(gv[i] + (size_t)(t + 1) * 8192); } } \
        SBAR(); \
        f32x16 s0, s1; \
        { const LAS unsigned char* kb = kst + r32 * KP + c * 128 + hi * 16; const LAS unsigned char* qb_ = lds + QOFF + wid * 4096 + lane * 16; \
          bf16x8 ka[4], kc2[4], qa[2], qc[2]; \
          qa[0] = *(const LAS bf16x8*)(qb_); qa[1] = *(const LAS bf16x8*)(qb_ + 1024); \
          ka[0] = *(const LAS bf16x8*)(kb); ka[1] = *(const LAS bf16x8*)(kb + 32 * KP); ka[2] = *(const LAS bf16x8*)(kb + 32); ka[3] = *(const LAS bf16x8*)(kb + 32 * KP + 32); \
          SBAR(); \
          qc[0] = *(const LAS bf16x8*)(qb_ + 2048); qc[1] = *(const LAS bf16x8*)(qb_ + 3072); \
          kc2[0] = *(const LAS bf16x8*)(kb + 64); kc2[1] = *(const LAS bf16x8*)(kb + 32 * KP + 64); kc2[2] = *(const LAS bf16x8*)(kb + 96); kc2[3] = *(const LAS bf16x8*)(kb + 32 * KP + 96); \
          __builtin_amdgcn_s_setprio(1); s0 = __builtin_amdgcn_mfma_f32_32x32x16_bf16(ka[0], qa[0], zero16, 0, 0, 0); s1 = __builtin_amdgcn_mfma_f32_32x32x16_bf16(ka[1], qa[0], zero16, 0, 0, 0); \
          s0 = __builtin_amdgcn_mfma_f32_32x32x16_bf16(ka[2], qa[1], s0, 0, 0, 0); s1 = __builtin_amdgcn_mfma_f32_32x32x16_bf16(ka[3], qa[1], s1, 0, 0, 0); \
          SBAR(); \
          s0 = __builtin_amdgcn_mfma_f32_32x32x16_bf16(kc2[0], qc[0], s0, 0, 0, 0); s1 = __builtin_amdgcn_mfma_f32_32x32x16_bf16(kc2[1], qc[0], s1, 0, 0, 0); \
          s0 = __builtin_amdgcn_mfma_f32_32x32x16_bf16(kc2[2], qc[1], s0, 0, 0, 0); s1 = __builtin_amdgcn_mfma_f32_32x32x16_bf16(kc2[3], qc[1], s1, 0, 0, 0); __builtin_amdgcn_s_setprio(0); } \
        if (c == 0) v_load(vf0, lds + VOFF + vcur + voff, 0); \
        SBAR(); \
        float mx = max3(s0[0], s1[0], s0[1]); \
        mx = max3(mx, s1[1], s0[2]); mx = max3(mx, s1[2], s0[3]); mx = max3(mx, s1[3], s0[4]); mx = max3(mx, s1[4], s0[5]); \
        mx = max3(mx, s1[5], s0[6]); mx = max3(mx, s1[6], s0[7]); mx = max3(mx, s1[7], s0[8]); mx = max3(mx, s1[8], s0[9]); \
        mx = max3(mx, s1[9], s0[10]); mx = max3(mx, s1[10], s0[11]); mx = max3(mx, s1[11], s0[12]); mx = max3(mx, s1[12], s0[13]); \
        mx = max3(mx, s1[13], s0[14]); mx = max3(mx, s1[14], s0[15]); mx = fmaxf(mx, s1[15]); \
        mx = xhalf_max(mx); \
        if (t == 0) { if (__any(fabsf(mx) > 8.0f)) { mref = mx; gen = true; } } \
        else if (__any(mx > mref + 8.0f)) { const float mnew = fmaxf(mx, mref); const float al = __builtin_amdgcn_exp2f(mref - mnew); \
            _Pragma("unroll") for (int e = 0; e < 4; ++e) _Pragma("unroll") for (int r = 0; r < 16; ++r) o[e][r] *= al; \
            lsum *= al; mref = mnew; gen = true; } \
        float ps0 = 0.f, ps1 = 0.f; \
        if (gen) { _Pragma("unroll") for (int r = 0; r < 16; ++r) { s0[r] = __builtin_amdgcn_exp2f(s0[r] - mref); s1[r] = __builtin_amdgcn_exp2f(s1[r] - mref); ps0 += s0[r]; ps0 += s1[r]; } } \
        else { _Pragma("unroll") for (int r = 0; r < 16; ++r) { s0[r] = __builtin_amdgcn_exp2f(s0[r]); s1[r] = __builtin_amdgcn_exp2f(s1[r]); ps0 += s0[r]; ps0 += s1[r]; } } \
        lsum += ps0 + ps1; \
        P[0] = (u32x4){cvtpk(s0[0], s0[1]), cvtpk(s0[2], s0[3]), cvtpk(s0[4], s0[5]), cvtpk(s0[6], s0[7])}; \
        P[1] = (u32x4){cvtpk(s0[8], s0[9]), cvtpk(s0[10], s0[11]), cvtpk(s0[12], s0[13]), cvtpk(s0[14], s0[15])}; \
        P[2] = (u32x4){cvtpk(s1[0], s1[1]), cvtpk(s1[2], s1[3]), cvtpk(s1[4], s1[5]), cvtpk(s1[6], s1[7])}; \
        P[3] = (u32x4){cvtpk(s1[8], s1[9]), cvtpk(s1[10], s1[11]), cvtpk(s1[12], s1[13]), cvtpk(s1[14], s1[15])}; \
        if (c == 0) pv_tile(o, P, vf0, lds + VOFF + vcur + voff); \
        if (t + 1 < NT && VAR != 4) { LAS unsigned char* kn = lds + ((t + 1) & 1) * KBUF; LAS unsigned char* vn = lds + vnext; \
            _Pragma("unroll") for (int i = 0; i < 2; ++i) { *(LAS u32x4*)(kn + lk[i]) = PKW[i]; *(LAS u32x4*)(vn + lv[i]) = PVW[i]; } } \
        { const int tmp = vprev; vprev = vcur; vcur = vnext; vnext = tmp; } \
        if (VAR != 3) __syncthreads(); \
    } while (0)
template <int VAR> __device__ __forceinline__ void unit(LAS unsigned char* lds, const bf16* QK, const bf16* KT, const bf16* VT, bf16* MIX, const float* sgain, float lam, int b, int h, int qb) {
    const int tid = threadIdx.x, lane = tid & 63, r32 = lane & 31, hi = lane >> 5; const int wid = __builtin_amdgcn_readfirstlane(tid >> 6);
    const int qsub = wid & 3, c = wid >> 2;
    const size_t rowbase = (size_t)b * SEQ; const int q0 = qb * 128 + qsub * 32;
    { const bf16* qp = QK + (rowbase + q0 + r32) * 512 + h * 128 + c * 64 + hi * 8;
#pragma unroll
      for (int ds = 0; ds < 4; ++ds) *(LAS bf16x8*)(lds + QOFF + wid * 4096 + ds * 1024 + lane * 16) = *(const bf16x8*)(qp + ds * 16); }
    const bf16* gk[2]; const bf16* gv[2]; int lk[2], lv[2];
#pragma unroll
    for (int i = 0; i < 2; ++i) { const int id = tid + NTHR * i; const int kr = id >> 4, kc = id & 15; const int ve = id >> 3, vc = id & 7;
        gk[i] = KT + (size_t)(b * 4 + h) * 64 * 8192 + id * 8; lk[i] = kr * KP + kc * 16;
        gv[i] = VT + (size_t)(b * 4 + h) * 64 * 8192 + id * 8; lv[i] = VOFF + ve * VP + vc * 16; }
    u32x4 pkA[2], pvA[2];
#pragma unroll
    for (int i = 0; i < 2; ++i) { pkA[i] = *(const u32x4*)gk[i]; pvA[i] = *(const u32x4*)gv[i]; }
#pragma unroll
    for (int i = 0; i < 2; ++i) { *(LAS u32x4*)(lds + lk[i]) = pkA[i]; *(LAS u32x4*)(lds + lv[i]) = pvA[i]; }
    __syncthreads();
    f32x16 o[4];
#pragma unroll
    for (int e = 0; e < 4; ++e) o[e] = (f32x16){};
    const f32x16 zero16 = (f32x16){};
    float mref = 0.f, lsum = 0.f; bool gen = false;
    u32x4 P[4];
#pragma unroll
    for (int ks = 0; ks < 4; ++ks) P[ks] = (u32x4){0u, 0u, 0u, 0u};
    int vcur = 0, vprev = 2 * VBUF, vnext = VBUF;
    const int voff = r32 * VP + hi * 16;
    for (int tt = 0; tt < NT; ++tt) {
        ATT_SLOT(tt, pkA, pvA, pkA, pvA);
    }
    if (c == 1) { bf16x8 vf0[4]; v_load(vf0, lds + VOFF + vprev + voff, 0); pv_tile(o, P, vf0, lds + VOFF + vprev + voff); }
    __syncthreads();
    lsum = xhalf_sum(lsum);
    const float sc = (c == 0) ? (1.0f / lsum) : (lam / lsum);
    LAS float* X = (LAS float*)lds + qsub * (128 * 32);
    if (c == 1) {
#pragma unroll
        for (int e = 0; e < 4; ++e)
#pragma unroll
            for (int r = 0; r < 16; ++r) { const int ee = 32 * e + (r & 3) + 8 * (r >> 2) + 4 * hi; X[ee * 32 + r32] = o[e][r] * sc; } }
    __syncthreads();
    if (c == 0) { float ss = 0.f;
#pragma unroll
        for (int e = 0; e < 4; ++e)
#pragma unroll
            for (int r = 0; r < 16; ++r) { const int ee = 32 * e + (r & 3) + 8 * (r >> 2) + 4 * hi; const float v = o[e][r] * sc - X[ee * 32 + r32]; o[e][r] = v; ss += v * v; }
        ss = xhalf_sum(ss);
        const float rs = (1.0f / sqrtf(ss * (1.0f / 128.0f) + SUBLN_EPS)) * 0.8f;
        bf16* op = MIX + (rowbase + q0 + r32) * 1024 + 512 + h * 128;
#pragma unroll
        for (int e = 0; e < 4; ++e)
#pragma unroll
            for (int q4 = 0; q4 < 4; ++q4) { const int ee = 32 * e + 8 * q4 + 4 * hi; const f32x4 g = *(const f32x4*)(sgain + ee);
                u32x2 w; w.x = cvtpk(o[e][4 * q4] * rs * g.x, o[e][4 * q4 + 1] * rs * g.y); w.y = cvtpk(o[e][4 * q4 + 2] * rs * g.z, o[e][4 * q4 + 3] * rs * g.w);
                *(u32x2*)(op + ee) = w; } }
    __syncthreads();
}
}

namespace hy {
constexpr int UP = 264, UBUF = 32 * UP * 2, HRB = HRLEN * 2;
constexpr int NCH = 17;
__device__ __forceinline__ float ldbf(const bf16* p) { return bf2f(*p); }
struct StageRegs { u32x2 xa, xb, va, vb; unsigned short xm, vm; };
__device__ __forceinline__ void stage_load(StageRegs& R, const bf16* X1, const bf16* V, int j, int tid) {
    const int b = tid >> 6, tt = tid & 63; const int S0 = 256 * j + 4 * tt - 4;
    const bool okA = (S0 >= 0 && S0 < SEQ), okB = (S0 + 4 < SEQ), okM = (S0 >= 1 && S0 <= SEQ);
    const size_t ia = (size_t)b * SEQ + (okA ? S0 : 0), ib = (size_t)b * SEQ + (okB ? S0 + 4 : 0), im = (size_t)b * SEQ + (okM ? S0 - 1 : 0);
    R.xa = *(const u32x2*)(X1 + ia); R.xb = *(const u32x2*)(X1 + ib); R.xm = X1[im];
    R.va = *(const u32x2*)(V + ia); R.vb = *(const u32x2*)(V + ib); R.vm = V[im];
}
__device__ __forceinline__ void stage_write(LAS unsigned char* ub, const StageRegs& R, const float (&w1)[4], const float (&wv)[4], int j, int tid) {
    const int b = tid >> 6, tt = tid & 63; const int S0 = 256 * j + 4 * tt - 4;
    const bool okA = (S0 >= 0 && S0 < SEQ), okB = (S0 + 4 < SEQ), okM = (S0 >= 1 && S0 <= SEQ);
    float xs[9], vs[9];
    xs[0] = okM ? bf2f(R.xm) : 0.f; vs[0] = okM ? bf2f(R.vm) : 0.f;
    xs[1] = okA ? bflo(R.xa.x) : 0.f; xs[2] = okA ? bfhi(R.xa.x) : 0.f; xs[3] = okA ? bflo(R.xa.y) : 0.f; xs[4] = okA ? bfhi(R.xa.y) : 0.f;
    xs[5] = okB ? bflo(R.xb.x) : 0.f; xs[6] = okB ? bfhi(R.xb.x) : 0.f; xs[7] = okB ? bflo(R.xb.y) : 0.f; xs[8] = okB ? bfhi(R.xb.y) : 0.f;
    vs[1] = okA ? bflo(R.va.x) : 0.f; vs[2] = okA ? bfhi(R.va.x) : 0.f; vs[3] = okA ? bflo(R.va.y) : 0.f; vs[4] = okA ? bfhi(R.va.y) : 0.f;
    vs[5] = okB ? bflo(R.vb.x) : 0.f; vs[6] = okB ? bfhi(R.vb.x) : 0.f; vs[7] = okB ? bflo(R.vb.y) : 0.f; vs[8] = okB ? bfhi(R.vb.y) : 0.f;
    float g[7];
#pragma unroll
    for (int i = 0; i < 7; ++i) { const float cx = w1[0] * xs[i] + w1[1] * xs[i + 1] + w1[2] * xs[i + 2] + w1[3]; const float cv = wv[0] * vs[i] + wv[1] * vs[i + 1] + wv[2] * vs[i + 2] + wv[3];
        g[i] = ((i < 4) ? okA : okB) ? cx * cv : 0.f; }
#pragma unroll
    for (int r = 0; r < 4; ++r) { u32x2 w; w.x = pk2(g[r], g[r + 1]); w.y = pk2(g[r + 2], g[r + 3]);
        *(LAS u32x2*)(ub + ((4 * b + r) * UP + 4 * tt) * 2) = w; }
}
__device__ __forceinline__ void channel(LAS unsigned char* lds, const bf16* UVT, const bf16* HR, const float* conv_w, const float* conv_b, bf16* YT, int c) {
    const int tid = threadIdx.x, lane = tid & 63, r32 = lane & 31, hi = lane >> 5; const int wid = __builtin_amdgcn_readfirstlane(tid >> 6);
    const bf16* X0 = UVT + (size_t)c * MTOK; const bf16* X1 = UVT + (size_t)(512 + c) * MTOK; const bf16* V = UVT + (size_t)(1024 + c) * MTOK;
    float w0[4], w1[4], wv[4];
#pragma unroll
    for (int k = 0; k < 3; ++k) { w0[k] = conv_w[k * 1536 + c]; w1[k] = conv_w[k * 1536 + 512 + c]; wv[k] = conv_w[k * 1536 + 1024 + c]; }
    w0[3] = conv_b[c]; w1[3] = conv_b[512 + c]; wv[3] = conv_b[1024 + c];
    for (int i = tid; i < HRB / 16; i += NTHR) { const bf16* src = HR + (size_t)c * HRLEN + 8 * i; ((LAS u32x4*)lds)[i] = *(const u32x4*)src;
        const u32x2 lo = *(const u32x2*)(src + 4); const u32x2 hi2 = (8 * i + 8 < HRLEN) ? *(const u32x2*)(src + 8) : (u32x2){0u, 0u};
        ((LAS u32x4*)(lds + HRB))[i] = (u32x4){lo.x, lo.y, hi2.x, hi2.y}; }
    LAS unsigned char* ub0 = lds + 2 * HRB;
    StageRegs SR;
    stage_load(SR, X1, V, 0, tid); stage_write(ub0, SR, w1, wv, 0, tid);
    __syncthreads();
    f32x16 acc[4];
#pragma unroll
    for (int n = 0; n < 4; ++n) acc[n] = (f32x16){};
    const int idx0 = 4096 - 4 * (128 * wid + r32) - 4 + 8 * hi;
    const int hb0 = (r32 & 1) ? idx0 * 2 : HRB + (idx0 - 4) * 2;
    for (int j = 0; j < NCH; ++j) {
        LAS unsigned char* ucur = ub0 + (j & 1) * UBUF;
        if (j + 1 < NCH) stage_load(SR, X1, V, j + 1, tid);
        const int nks = (j < NCH - 1) ? 16 : 1;
        const LAS unsigned char* ua = ucur + r32 * (UP * 2) + hi * 16;
        const LAS unsigned char* hp = lds + hb0 + j * 512;
#pragma unroll 4
        for (int ks = 0; ks < nks; ++ks) { const bf16x8 a = *(const LAS bf16x8*)(ua + ks * 32);
#pragma unroll
            for (int n = 0; n < 4; ++n) { const bf16x8 bb = *(const LAS bf16x8*)(hp + ks * 32 - n * 256);
                acc[n] = __builtin_amdgcn_mfma_f32_32x32x16_bf16(a, bb, acc[n], 0, 0, 0); } }
        if (j + 1 < NCH) stage_write(ub0 + ((j + 1) & 1) * UBUF, SR, w1, wv, j + 1, tid);
        __syncthreads();
    }
#pragma unroll
    for (int n = 0; n < 4; ++n) { const int t = 4 * (128 * wid + 32 * n + r32);
#pragma unroll
        for (int q = 0; q < 4; ++q) { const int b = 2 * q + hi; const bf16* xp = X0 + (size_t)b * SEQ + t; const u32x2 xa = *(const u32x2*)xp; float xs[6];
            { const float xm = ldbf(xp - ((t > 0) ? 1 : 0)), xq = ldbf(xp + ((t + 4 < SEQ) ? 4 : 0)); xs[0] = (t > 0) ? xm : 0.f; xs[5] = (t + 4 < SEQ) ? xq : 0.f; }
            xs[1] = bflo(xa.x); xs[2] = bfhi(xa.x); xs[3] = bflo(xa.y); xs[4] = bfhi(xa.y);
            float y[4];
#pragma unroll
            for (int i = 0; i < 4; ++i) y[i] = acc[n][4 * q + i] * (w0[0] * xs[i] + w0[1] * xs[i + 1] + w0[2] * xs[i + 2] + w0[3]);
            u32x2 w; w.x = pk2(y[0], y[1]); w.y = pk2(y[2], y[3]);
            *(u32x2*)(YT + (size_t)c * MTOK + (size_t)b * SEQ + t) = w; } }
    __syncthreads();
}
}

#define XB_TMO      128
#define XB_XCNT(j)  (256  + 64 * (j))
#define XB_XSUB(j)  (1280 + 64 * (j))
#define XB_XGEN(j)  (2304 + 64 * (j))
#define XB_TOP      3328
#define XB_TOPGEN   3392
#define XCD_BAR_WORDS 3456
#define XB_SPIN_CAP (1u << 18)

__device__ __forceinline__ unsigned xb_ld(unsigned* p)              { return __hip_atomic_load(p, __ATOMIC_RELAXED, __HIP_MEMORY_SCOPE_AGENT); }
__device__ __forceinline__ unsigned xb_add(unsigned* p, unsigned v) { return __hip_atomic_fetch_add(p, v, __ATOMIC_RELAXED, __HIP_MEMORY_SCOPE_AGENT); }
__device__ __forceinline__ unsigned xb_xcc_id() { return (unsigned)__builtin_amdgcn_s_getreg((3 << 11) | 20) & 0xFu; }
#define XB_SPIN(cond, bar) do { unsigned _sp = 0; while (cond) { __builtin_amdgcn_s_sleep(1); \
    if ((++_sp & 255u) == 0u) { if (xb_ld(&(bar)[XB_TMO])) break; if (_sp > XB_SPIN_CAP) { atomicAdd(&(bar)[XB_TMO], 1u); break; } } } } while (0)

struct XcdBarrier {
    unsigned* bar; unsigned x;
    volatile LAS unsigned* st;
};

__device__ __forceinline__ XcdBarrier xcd_barrier_post(unsigned* bar, volatile LAS unsigned* st) {
    XcdBarrier b; b.bar = bar; b.x = xb_xcc_id(); b.st = st;
    if (threadIdx.x == 0) (void)xb_add(&bar[XB_XCNT(b.x)], 1u);
    return b;
}
__device__ __forceinline__ void xcd_barrier_complete(unsigned* bar, unsigned x, unsigned& nloc, unsigned& nx) {
    const unsigned G = gridDim.x * gridDim.y * gridDim.z;
    unsigned sum, cnt, mine, sp = 0u;
    for (;;) {
        sum = 0u; cnt = 0u; mine = 0u;
#pragma unroll
        for (unsigned j = 0; j < 16; ++j) { const unsigned c = xb_ld(&bar[XB_XCNT(j)]); sum += c; cnt += (c > 0u) ? 1u : 0u; mine = (j == x) ? c : mine; }
        if (sum == G) break;
        __builtin_amdgcn_s_sleep(1);
        if ((++sp & 255u) == 0u) { if (xb_ld(&bar[XB_TMO])) break; if (sp > XB_SPIN_CAP) { atomicAdd(&bar[XB_TMO], 1u); break; } }
    }
    nloc = mine > 0u ? mine : 1u; nx = cnt > 0u ? cnt : 1u;
}

__device__ __forceinline__ void xcd_barrier(const XcdBarrier& b) {
    asm volatile("s_waitcnt vmcnt(0)" ::: "memory");
    __syncthreads();
    if (threadIdx.x == 0) {
        unsigned* bar = b.bar;
        __builtin_amdgcn_s_waitcnt(0);
        unsigned nloc = b.st[0], nx = b.st[1];
        if (nloc == 0u) { xcd_barrier_complete(bar, b.x, nloc, nx); b.st[0] = nloc; b.st[1] = nx; }
        const unsigned old = xb_add(&bar[XB_XSUB(b.x)], 1u);
        const unsigned gen = old / nloc;
        if (old + 1u == (gen + 1u) * nloc) {
            __builtin_amdgcn_fence(__ATOMIC_RELEASE, "agent");
            asm volatile("s_waitcnt vmcnt(0)" ::: "memory");
            const unsigned og = xb_add(&bar[XB_TOP], 1u);
            const unsigned tg = og / nx;
            if (og + 1u == (tg + 1u) * nx) xb_add(&bar[XB_TOPGEN], 1u);
            else XB_SPIN(xb_ld(&bar[XB_TOPGEN]) == tg, bar);
            __builtin_amdgcn_fence(__ATOMIC_ACQUIRE, "agent");
            xb_add(&bar[XB_XGEN(b.x)], 1u);
            asm volatile("s_waitcnt vmcnt(0)" ::: "memory");
        } else {
            XB_SPIN(xb_ld(&bar[XB_XGEN(b.x)]) == gen, bar);
            __builtin_amdgcn_fence(__ATOMIC_ACQUIRE, "agent");
            asm volatile("s_waitcnt vmcnt(0)" ::: "memory");
        }
    }
    __syncthreads();
}

__global__ void __launch_bounds__(NTHR, 2) fwd_kernel(Args a) {
    extern __shared__ __attribute__((aligned(16))) unsigned char lds_raw[];
    LAS unsigned char* lds = (LAS unsigned char*)lds_raw;
    const int tid = threadIdx.x, lane = tid & 63; const int wave = __builtin_amdgcn_readfirstlane(tid >> 6);
    const int G = gridDim.x, bx = blockIdx.x;
    const int gw = bx * NWAVES + wave, NGW = G * NWAVES;
    unsigned char* ws = a.ws;
    bf16* Win_t = (bf16*)(ws + WS_WIN); bf16* Wout_t = (bf16*)(ws + WS_WOUT); bf16* Wup_t = (bf16*)(ws + WS_WUP); bf16* Wdown_t = (bf16*)(ws + WS_WDOWN);
    bf16* HR = (bf16*)(ws + WS_HR); float* ROPE = (float*)(ws + WS_ROPE);
    bf16* XN = (bf16*)(ws + WS_XN); bf16* MO = (bf16*)(ws + WS_MO); bf16* YT = (bf16*)(ws + WS_YT); bf16* UVT = (bf16*)(ws + WS_UVT);
    bf16* QK = (bf16*)(ws + WS_QK); bf16* KT = (bf16*)(ws + WS_KT); bf16* VT = (bf16*)(ws + WS_VT); bf16* MIX = (bf16*)(ws + WS_MIX); bf16* HB = (bf16*)(ws + WS_H);
    const float* x = a.in[0];
    const int lo = a.ph_lo, hi_ph = a.ph_hi;
#if MK_COOP
    cg::grid_group grid = cg::this_grid();
    volatile LAS unsigned* bst = (volatile LAS unsigned*)(lds + 131072 + 64);
    if (tid < 4) bst[tid] = 0u;
    __syncthreads();
    XcdBarrier xbar = xcd_barrier_post((unsigned*)(ws + WS_CTL), bst);
#define SEAM(k) do { if (lo <= (k) && (k) + 1 < hi_ph) { if ((k) == 0) grid.sync(); else xcd_barrier(xbar); } } while (0)
#else
#define SEAM(k) do { } while (0)
#endif
#ifndef PHMASK
#define PHMASK 0x1ff
#endif
#define IN(k) (((PHMASK >> (k)) & 1) && lo <= (k) && (k) < hi_ph)

#ifndef DUP_P0
#define DUP_P0 1
#endif
    if (IN(0)) for (int rep0 = 0; rep0 < DUP_P0; ++rep0) {
        LAS float* scr = (LAS float*)(lds + wave * 16384);
        constexpr int I_IN = (DM / 64) * (NIN / 32), I_OUT = (DM / 64) * (DM / 32), I_UP = (DM / 64) * (DFF / 32), I_DN = (DFF / 64) * (DM / 32);
        for (int it = gw; it < I_IN + I_OUT + I_UP + I_DN; it += NGW) { int r = it;
            if (r < I_IN) { p0_transpose_item<true>(a.in[3], DM, NIN, Win_t, scr, r, lane); continue; } r -= I_IN;
            if (r < I_OUT) { p0_transpose_item<false>(a.in[20], DM, DM, Wout_t, scr, r, lane); continue; } r -= I_OUT;
            if (r < I_UP) { p0_transpose_item<false>(a.in[23], DM, DFF, Wup_t, scr, r, lane); continue; } r -= I_UP;
            p0_transpose_item<false>(a.in[24], DFF, DM, Wdown_t, scr, r, lane); }
        for (int m = gw; m < MTOK; m += NGW) rms_row_to_bf16(x + (size_t)m * DM, a.in[1], XN + (size_t)m * DM, lane);
        for (int i = bx * NTHR + tid; i < SEQ * 32; i += G * NTHR) { const int pos = i >> 5, k = i & 31;
            const float inv = exp2f(-(float)(2 * k) * (13.287712379549449f / 64.0f)); const float ang = (float)pos * inv;
            ROPE[2 * i] = cosf(ang); ROPE[2 * i + 1] = sinf(ang); }
        __syncthreads();
        for (int pg = bx; pg < SEQ / 16; pg += G) filter_item(lds, a, HR, pg, tid);
    }
    SEAM(0);
#ifndef DUP_P1
#define DUP_P1 1
#endif
    if (IN(1)) {
        { pg8::Gemm g{Win_t, XN, 2048, MTOK, DM}; pg8::StaticOrder S; S.init(2048, MTOK, G, bx);
          pg8::EpiUV E{UVT, VT};
          pg8::gemm_phase<pg8::EpiUV, pg8::StaticOrder, true, true>(lds, g, S, E); }
        { pg8::Gemm g{XN, Win_t + (size_t)2048 * DM, MTOK, 1024, DM}; pg8::StaticOrder S; S.init(MTOK, 1024, G, bx);
          pg8::EpiRope E{QK, KT, ROPE, QSCALE};
          pg8::gemm_phase<pg8::EpiRope, pg8::StaticOrder, true, true>(lds, g, S, E); }
    }
#if DUP_P1 == 2
    if (IN(1)) {
        { pg8::Gemm g{Win_t, XN, 2048, MTOK, DM}; pg8::StaticOrder S; S.init(2048, MTOK, G, bx);
          pg8::EpiUV E{UVT, VT};
          pg8::gemm_phase<pg8::EpiUV, pg8::StaticOrder, true, true>(lds, g, S, E); }
        { pg8::Gemm g{XN, Win_t + (size_t)2048 * DM, MTOK, 1024, DM}; pg8::StaticOrder S; S.init(MTOK, 1024, G, bx);
          pg8::EpiRope E{QK, KT, ROPE, QSCALE};
          pg8::gemm_phase<pg8::EpiRope, pg8::StaticOrder, true, true>(lds, g, S, E); }
    }
#endif
    SEAM(1);
    if (IN(2)) {
        float lam;
        { const float p1 = a.in[15][lane] * a.in[16][lane], p2 = a.in[17][lane] * a.in[18][lane];
          lam = expf(wave_sum(p1)) - expf(wave_sum(p2)) + 0.2f; }
#ifndef DUP_ATT
#define DUP_ATT 1
#endif
#ifndef DUP_HY
#define DUP_HY 1
#endif
#ifndef ATT_VAR
#define ATT_VAR 0
#endif
        for (int u = bx; u < 1024; u += G) { const int bh = (u & 7) + 8 * (u >> 8), qb = (u >> 3) & 31;
            att::unit<0>(lds, QK, KT, VT, MIX, a.in[19], lam, bh >> 2, bh & 3, qb); }
        if (DUP_ATT > 1)
        for (int u = bx; u < 1024; u += G) { const int bh = (u & 7) + 8 * (u >> 8), qb = (u >> 3) & 31;
            att::unit<ATT_VAR>(lds, QK, KT, VT, MO, a.in[19], lam, bh >> 2, bh & 3, qb); }
        for (int rep = 0; rep < DUP_HY; ++rep)
        for (int c = bx; c < HYW; c += G) hy::channel(lds, UVT, HR, a.in[4], a.in[5], YT, c);
    }
    SEAM(2);
#ifndef DUP_P3
#define DUP_P3 1
#endif
    if (IN(3)) for (int rep3 = 0; rep3 < DUP_P3; ++rep3) {
        LAS unsigned short* scr = (LAS unsigned short*)(lds + wave * 16384);
        for (int it = gw; it < 8 * (MTOK / 64); it += NGW) { const int ct = it & 7, mt = it >> 3; const int c0 = 64 * ct, m0 = 64 * mt;
#pragma unroll
            for (int i = 0; i < 8; ++i) { const int cc = 8 * i + (lane >> 3), mch = lane & 7; const u32x4 v = *(const u32x4*)(YT + (size_t)(c0 + cc) * MTOK + m0 + 8 * mch);
                LAS unsigned* d = (LAS unsigned*)(scr + cc * 66 + 8 * mch); d[0] = v.x; d[1] = v.y; d[2] = v.z; d[3] = v.w; }
            LDS_WAIT(); asm volatile("" ::: "memory");
#pragma unroll
            for (int i = 0; i < 8; ++i) { const int mm = 8 * i + (lane >> 3), cch = lane & 7; const LAS unsigned short* s = scr + (8 * cch) * 66 + mm;
                u32x4 o; o.x = (unsigned)s[0] | ((unsigned)s[66] << 16); o.y = (unsigned)s[2 * 66] | ((unsigned)s[3 * 66] << 16);
                o.z = (unsigned)s[4 * 66] | ((unsigned)s[5 * 66] << 16); o.w = (unsigned)s[6 * 66] | ((unsigned)s[7 * 66] << 16);
                *(u32x4*)(MIX + (size_t)(m0 + mm) * 1024 + c0 + 8 * cch) = o; }
            LDS_WAIT(); asm volatile("" ::: "memory"); }
        __syncthreads();
    }
    SEAM(3);
    if (IN(4)) {
        pg8::Gemm g{MIX, Wout_t, MTOK, DM, DM}; pg8::StaticOrder S; S.init(MTOK, DM, G, bx);
        pg8::EpiBf16<0> E{MO, DM};
        pg8::gemm_phase<pg8::EpiBf16<0>, pg8::StaticOrder, true, true>(lds, g, S, E);
    }
    SEAM(4);
#ifndef DUP_P5
#define DUP_P5 1
#endif
    if (IN(5)) for (int rep5 = 0; rep5 < DUP_P5; ++rep5) {
        const f32x4* gp = (const f32x4*)a.in[2] + lane; const f32x4* gm = (const f32x4*)a.in[21] + lane;
        for (int m = gw; m < MTOK; m += NGW) {
            const f32x4* xr = (const f32x4*)(x + (size_t)m * DM) + lane; const u32x2* mr = (const u32x2*)(MO + (size_t)m * DM) + lane;
            f32x4 v[4], y[4]; float s = 0.f;
#pragma unroll
            for (int j = 0; j < 4; ++j) { v[j] = xr[64 * j]; const u32x2 w = mr[64 * j]; y[j] = (f32x4){bflo(w.x), bfhi(w.x), bflo(w.y), bfhi(w.y)};
                s += (y[j].x * y[j].x + y[j].y * y[j].y) + (y[j].z * y[j].z + y[j].w * y[j].w); }
            const float r = 1.0f / sqrtf(wave_sum(s) * (1.f / DM) + NORM_EPS); float s2 = 0.f;
            f32x4* orow = (f32x4*)(a.out + (size_t)m * DM) + lane;
#pragma unroll
            for (int j = 0; j < 4; ++j) { const f32x4 g = gp[64 * j]; v[j] = v[j] + y[j] * r * g; orow[64 * j] = v[j];
                s2 += (v[j].x * v[j].x + v[j].y * v[j].y) + (v[j].z * v[j].z + v[j].w * v[j].w); }
            const float r2 = 1.0f / sqrtf(wave_sum(s2) * (1.f / DM) + NORM_EPS);
            unsigned long long* o8 = (unsigned long long*)(XN + (size_t)m * DM) + lane;
#pragma unroll
            for (int j = 0; j < 4; ++j) { const f32x4 g = gm[64 * j];
                o8[64 * j] = (unsigned long long)pk2(v[j].x * r2 * g.x, v[j].y * r2 * g.y) | ((unsigned long long)pk2(v[j].z * r2 * g.z, v[j].w * r2 * g.w) << 32); }
        }
    }
    SEAM(5);
#ifndef DUP_P6
#define DUP_P6 1
#endif
    if (IN(6)) for (int rep6 = 0; rep6 < DUP_P6; ++rep6) {
        pg8::Gemm g{XN, Wup_t, MTOK, DFF, DM}; pg8::StaticOrder S; S.init(MTOK, DFF, G, bx);
        pg8::EpiBf16<1> E{HB, DFF};
        pg8::gemm_phase<pg8::EpiBf16<1>, pg8::StaticOrder, true, true>(lds, g, S, E);
    }
    SEAM(6);
    if (IN(7)) {
        pg8::Gemm g{HB, Wdown_t, MTOK, DM, DFF}; pg8::StaticOrder S; S.init(MTOK, DM, G, bx);
        pg8::EpiBf16<0> E{MO, DM};
        pg8::gemm_phase<pg8::EpiBf16<0>, pg8::StaticOrder, true, true>(lds, g, S, E);
    }
    SEAM(7);
    if (IN(8)) {
        const f32x4* gp = (const f32x4*)a.in[22] + lane;
        for (int m = gw; m < MTOK; m += NGW) {
            f32x4* orow = (f32x4*)(a.out + (size_t)m * DM) + lane; const u32x2* mr = (const u32x2*)(MO + (size_t)m * DM) + lane;
            f32x4 v[4], y[4]; float s = 0.f;
#pragma unroll
            for (int j = 0; j < 4; ++j) { v[j] = orow[64 * j]; const u32x2 w = mr[64 * j]; y[j] = (f32x4){bflo(w.x), bfhi(w.x), bflo(w.y), bfhi(w.y)};
                s += (y[j].x * y[j].x + y[j].y * y[j].y) + (y[j].z * y[j].z + y[j].w * y[j].w); }
            const float r = 1.0f / sqrtf(wave_sum(s) * (1.f / DM) + NORM_EPS);
#pragma unroll
            for (int j = 0; j < 4; ++j) { const f32x4 g = gp[64 * j]; orow[64 * j] = v[j] + y[j] * r * g; }
        }
    }
#undef IN
#undef SEAM
}

constexpr int NPHASE = 9;
extern "C" void kernel_launch(void* const* d_in, const int* in_sizes, int n_in, void* d_out, int out_size, void* d_ws, size_t ws_size, hipStream_t stream) {
    static int grid = 0;
    if (grid == 0) {
        if (n_in != 25 || in_sizes[0] != MTOK * DM || out_size != MTOK * DM || ws_size < WS_END) {
            fprintf(stderr, "kernel_launch: unexpected shapes (n_in %d in0 %d out %d ws %zu)\n", n_in, n_in > 0 ? in_sizes[0] : -1, out_size, ws_size); grid = -1; return; }
        int dev = 0, cus = 0, per_cu = 0;
        hipGetDevice(&dev); hipDeviceGetAttribute(&cus, hipDeviceAttributeMultiprocessorCount, dev);
        hipFuncSetAttribute((const void*)fwd_kernel, hipFuncAttributeMaxDynamicSharedMemorySize, LDS_BYTES);
        hipOccupancyMaxActiveBlocksPerMultiprocessor(&per_cu, (const void*)fwd_kernel, NTHR, LDS_BYTES);
        if (per_cu < 1) { fprintf(stderr, "kernel_launch: occupancy query says %d blocks/CU\n", per_cu); per_cu = 1; }
        (void)hipGetLastError();
        grid = cus * 1;
    }
    if (grid < 0) return;
    Args a{};
    for (int i = 0; i < 25; ++i) a.in[i] = (const float*)d_in[i];
    a.out = (float*)d_out; a.ws = (unsigned char*)d_ws;
#if MK_COOP
    a.ph_lo = 0; a.ph_hi = NPHASE;
    if (hipMemsetAsync((unsigned char*)d_ws + WS_CTL, 0, CTL_BYTES, stream) != hipSuccess) { fprintf(stderr, "kernel_launch: memset of the barrier words failed\n"); return; }
    void* args[] = {&a};
    hipError_t e = hipLaunchCooperativeKernel((const void*)fwd_kernel, dim3(grid), dim3(NTHR), args, LDS_BYTES, stream);
    if (e != hipSuccess) fprintf(stderr, "cooperative launch failed: %s (grid %d)\n", hipGetErrorString(e), grid);
#else
    for (int p = 0; p < NPHASE; ++p) { a.ph_lo = p; a.ph_hi = p + 1; hipLaunchKernelGGL(fwd_kernel, dim3(grid), dim3(NTHR), LDS_BYTES, stream, a); }
#endif
}
```

```cpp
#include <hip/hip_runtime.h>
#include <hip/hip_cooperative_groups.h>
#include <cstdio>
#include <cstdint>
#include <cmath>
namespace cg = cooperative_groups;
#ifndef MK_COOP
#define MK_COOP 1
#endif
namespace pg8 {
#define PG8_LAS __attribute__((address_space(3)))
typedef unsigned short bf16_t;
typedef short bf16x8 __attribute__((ext_vector_type(8)));
typedef float f32x4 __attribute__((ext_vector_type(4)));
typedef unsigned u32x4 __attribute__((ext_vector_type(4)));
constexpr int BM = 256, BK = 64, HALF = 128, HTB = HALF * BK * 2  , STAGE_BYTES = 8 * HTB, NXCD = 8, WGM = 8;

__host__ __device__ __forceinline__ int lds_byte(int r, int c) { const int st = (r >> 4) * 2 + (c >> 5), rr = r & 15, cc = c & 31, ob = rr * 64 + cc * 2; return st * 1024 + (ob ^ (((ob >> 9) & 1) << 5)); }
__host__ __device__ __forceinline__ void stage_rc(int b, int& R, int& C) { const int st = b / 1024, sb = b % 1024, swz = sb ^ (((sb >> 9) & 1) << 5); R = (st >> 1) * 16 + swz / 64; C = (st & 1) * 32 + (swz % 64) / 2; }
__host__ __device__ __forceinline__ int perm32(int rho) { const int n = rho >> 4, i = rho & 15; return 8 * (i >> 2) + 4 * n + (i & 3); }

struct Unit { int pm, pn; };
struct Gemm { const bf16_t* A; const bf16_t* Bt; int M, N, K; };

struct StaticOrder {
    int nM, nN, nwg, G, c;
    __host__ __device__ void init(int M, int N, int G_, int c_) { nM = M / BM; nN = N / BM; nwg = nM * nN; G = G_; c = c_; }
    __host__ __device__ bool next(int i, Unit& u) const {
        const long L = (long)i * G + c; if (L >= nwg) return false;
        int wgid = (int)L; { const int q = nwg / NXCD, r = nwg % NXCD, xcd = wgid % NXCD, off = wgid / NXCD; wgid = (xcd < r ? xcd * (q + 1) : r * (q + 1) + (xcd - r) * q) + off; }
        const int nig = WGM * nN, gid = wgid / nig, fm = gid * WGM, gsz = (nM - fm) < WGM ? (nM - fm) : WGM;
        u.pm = fm + ((wgid % nig) % gsz); u.pn = (wgid % nig) / gsz; return true;
    }
    __device__ __forceinline__ void a_ready(const Unit&) const {}
    __device__ __forceinline__ void done(const Unit&) const {}
};

__device__ __forceinline__ unsigned cvt_pk_bf16(float lo, float hi) { unsigned r; asm volatile("v_cvt_pk_bf16_f32 %0, %1, %2" : "=v"(r) : "v"(lo), "v"(hi)); return r; }
typedef float f32x2 __attribute__((ext_vector_type(2)));
typedef float f32x2 __attribute__((ext_vector_type(2)));
typedef unsigned u32x2 __attribute__((ext_vector_type(2)));
template <int ACT> struct EpiBf16 {
    static constexpr bool PERM = true, AFTER_DRAIN = false;
    bf16_t* O; int ldc;
    __device__ __forceinline__ void operator()(const f32x4 (&acc)[2][2][4][2], const Unit& u, int wr, int wc, int fr, int fq) const {
        const int row0 = u.pm * BM + wr * 64 + fr; const int col0 = u.pn * BM + wc * 32 + 8 * fq;
#pragma unroll
        for (int ai = 0; ai < 2; ++ai)
#pragma unroll
            for (int m = 0; m < 4; ++m) { bf16_t* rowp = O + (size_t)(row0 + ai * HALF + m * 16) * ldc + col0;
#pragma unroll
                for (int bj = 0; bj < 2; ++bj) { f32x4 v0 = acc[ai][bj][m][0], v1 = acc[ai][bj][m][1];
                    if (ACT == 1) {
#pragma unroll
                        for (int j = 0; j < 4; ++j) { float a = v0[j] > 0.f ? v0[j] : 0.f; v0[j] = a * a; float b = v1[j] > 0.f ? v1[j] : 0.f; v1[j] = b * b; } }
                    u32x4 w; w.x = cvt_pk_bf16(v0[0], v0[1]); w.y = cvt_pk_bf16(v0[2], v0[3]); w.z = cvt_pk_bf16(v1[0], v1[1]); w.w = cvt_pk_bf16(v1[2], v1[3]);
                    *(u32x4*)(rowp + bj * HALF) = w; } }
    }
};
struct EpiRope {
    static constexpr bool PERM = true, AFTER_DRAIN = false;
    bf16_t* Q; bf16_t* KT; const float* rope; float qscale;
    __device__ __forceinline__ void operator()(const f32x4 (&acc)[2][2][4][2], const Unit& u, int wr, int wc, int fr, int fq) const {
        const int row0 = u.pm * BM + wr * 64 + fr; const int col0 = u.pn * BM + wc * 32 + 8 * fq;
        const int g = (wc & 1) * 4 + fq;
        const float sc = (u.pn < 2) ? qscale : 1.0f;
#pragma unroll
        for (int ai = 0; ai < 2; ++ai)
#pragma unroll
            for (int m = 0; m < 4; ++m) { const int row = row0 + ai * HALF + m * 16; const int pos = row & 4095;
                const f32x4 cs0 = *(const f32x4*)(rope + (size_t)pos * 64 + 8 * g), cs1 = *(const f32x4*)(rope + (size_t)pos * 64 + 8 * g + 4);
                const float c[4] = {cs0[0], cs0[2], cs1[0], cs1[2]}, s[4] = {cs0[1], cs0[3], cs1[1], cs1[3]};
                bf16_t* rowp;
                if (u.pn < 2) rowp = Q + (size_t)row * 512 + col0;
                else { const int ck = col0 - 512, hh = ck >> 7, cc = ck & 127; rowp = KT + ((size_t)(((row >> 12) * 4 + hh) * 64 + (pos >> 6)) * 8192 + (pos & 63) * 128 + cc); }
#pragma unroll
                for (int bj = 0; bj < 2; ++bj) { const f32x4 lo = acc[ai][bj][m][0], hi = acc[ai][bj][m][1]; float ol[4], oh[4];
#pragma unroll
                    for (int j = 0; j < 4; ++j) { ol[j] = (lo[j] * c[j] - hi[j] * s[j]) * sc; oh[j] = (hi[j] * c[j] + lo[j] * s[j]) * sc; }
                    u32x4 w; w.x = cvt_pk_bf16(ol[0], ol[1]); w.y = cvt_pk_bf16(ol[2], ol[3]); w.z = cvt_pk_bf16(oh[0], oh[1]); w.w = cvt_pk_bf16(oh[2], oh[3]);
                    *(u32x4*)(rowp + ((u.pn < 2) ? bj * HALF : bj * (64 * 8192))) = w; } }
    }
};
struct EpiUV {
    static constexpr bool PERM = true, AFTER_DRAIN = false;
    bf16_t* UT; bf16_t* VT;
    __device__ __forceinline__ void operator()(const f32x4 (&acc)[2][2][4][2], const Unit& u, int wr, int wc, int fr, int fq) const {
        const int row0 = u.pm * BM + wr * 64 + fr; const int col0 = u.pn * BM + wc * 32 + 8 * fq;
#pragma unroll
        for (int ai = 0; ai < 2; ++ai)
#pragma unroll
            for (int m = 0; m < 4; ++m) { const int row = row0 + ai * HALF + m * 16;
#pragma unroll
                for (int bj = 0; bj < 2; ++bj) { const int col = col0 + bj * HALF; bf16_t* p;
                    if (u.pm < 6) p = UT + (size_t)row * 32768 + col;
                    else { const int ev = row - 1536, hh = ev >> 7, ee = ev & 127, bb = col >> 12, pos = col & 4095;
                        p = VT + ((size_t)((bb * 4 + hh) * 64 + (pos >> 6)) * 8192 + ee * 64 + (pos & 48) + ((pos & 8) >> 1)); }
                    const f32x4 v0 = acc[ai][bj][m][0], v1 = acc[ai][bj][m][1];
                    u32x4 w; w.x = cvt_pk_bf16(v0[0], v0[1]); w.y = cvt_pk_bf16(v0[2], v0[3]); w.z = cvt_pk_bf16(v1[0], v1[1]); w.w = cvt_pk_bf16(v1[2], v1[3]);
                    if (u.pm < 6) *(u32x4*)p = w;
                    else { *(u32x2*)p = (u32x2){w.x, w.y}; *(u32x2*)(p + 8) = (u32x2){w.z, w.w}; } } }
    }
};

__device__ __forceinline__ void panel_sumsq(const f32x4 (&acc)[2][2][4][2], float* ss, unsigned* cnt, const Unit& u, int wr, int fr, int fq, int lane) {
#pragma unroll
    for (int ai = 0; ai < 2; ++ai)
#pragma unroll
        for (int m = 0; m < 4; ++m) { float s = 0.f;
#pragma unroll
            for (int bj = 0; bj < 2; ++bj)
#pragma unroll
                for (int n = 0; n < 2; ++n) { const f32x4 x = acc[ai][bj][m][n]; s += (x[0] * x[0] + x[1] * x[1]) + (x[2] * x[2] + x[3] * x[3]); }
            s += __shfl_xor(s, 16); s += __shfl_xor(s, 32);
            if (fq == 0) __hip_atomic_fetch_add(ss + u.pm * BM + ai * HALF + wr * 64 + m * 16 + fr, s, __ATOMIC_RELAXED, __HIP_MEMORY_SCOPE_AGENT); }
    asm volatile("s_waitcnt vmcnt(0)" ::: "memory");
    __syncthreads();
    if (threadIdx.x == 0) { __hip_atomic_fetch_add(cnt + u.pm, 1u, __ATOMIC_RELAXED, __HIP_MEMORY_SCOPE_AGENT);
        unsigned spins = 0;
        while (__hip_atomic_load(cnt + u.pm, __ATOMIC_RELAXED, __HIP_MEMORY_SCOPE_AGENT) < 4u) { __builtin_amdgcn_s_sleep(8); if (++spins > (1u << 20)) break; } }
    __syncthreads();
}
struct EpiNormRes {
    static constexpr bool PERM = true, AFTER_DRAIN = false;
    float* out; const float* gain; float* ss; unsigned* cnt; float eps;
    __device__ __forceinline__ void operator()(f32x4 (&acc)[2][2][4][2], const Unit& u, int wr, int wc, int fr, int fq) const {
        const int lane = fq * 16 + fr;
        panel_sumsq(acc, ss, cnt, u, wr, fr, fq, lane);
        const int row0 = u.pm * BM + wr * 64 + fr; const int col0 = u.pn * BM + wc * 32 + 8 * fq;
        f32x4 g[2][2];
#pragma unroll
        for (int bj = 0; bj < 2; ++bj) { g[bj][0] = *(const f32x4*)(gain + col0 + bj * HALF); g[bj][1] = *(const f32x4*)(gain + col0 + bj * HALF + 4); }
#pragma unroll
        for (int ai = 0; ai < 2; ++ai)
#pragma unroll
            for (int m = 0; m < 4; ++m) { const int row = row0 + ai * HALF + m * 16;
                const float r = 1.0f / sqrtf(__hip_atomic_load(ss + row, __ATOMIC_RELAXED, __HIP_MEMORY_SCOPE_AGENT) * (1.0f / 1024.0f) + eps);
                float* rowp = out + (size_t)row * 1024 + col0;
#pragma unroll
                for (int bj = 0; bj < 2; ++bj) { const f32x4 b0 = *(const f32x4*)(rowp + bj * HALF), b1 = *(const f32x4*)(rowp + bj * HALF + 4);
                    *(f32x4*)(rowp + bj * HALF) = b0 + acc[ai][bj][m][0] * r * g[bj][0]; *(f32x4*)(rowp + bj * HALF + 4) = b1 + acc[ai][bj][m][1] * r * g[bj][1]; } }
    }
};
struct EpiNormResNorm {
    static constexpr bool PERM = true, AFTER_DRAIN = false;
    const float* base; float* out; bf16_t* xn; const float* g1; const float* g2; float* ss1; float* ss2; unsigned* cnt1; unsigned* cnt2; float eps;
    __device__ __forceinline__ void operator()(f32x4 (&acc)[2][2][4][2], const Unit& u, int wr, int wc, int fr, int fq) const {
        const int lane = fq * 16 + fr;
        panel_sumsq(acc, ss1, cnt1, u, wr, fr, fq, lane);
        const int row0 = u.pm * BM + wr * 64 + fr; const int col0 = u.pn * BM + wc * 32 + 8 * fq;
        { f32x4 g[2][2];
#pragma unroll
          for (int bj = 0; bj < 2; ++bj) { g[bj][0] = *(const f32x4*)(g1 + col0 + bj * HALF); g[bj][1] = *(const f32x4*)(g1 + col0 + bj * HALF + 4); }
#pragma unroll
          for (int ai = 0; ai < 2; ++ai)
#pragma unroll
            for (int m = 0; m < 4; ++m) { const int row = row0 + ai * HALF + m * 16;
                const float r = 1.0f / sqrtf(__hip_atomic_load(ss1 + row, __ATOMIC_RELAXED, __HIP_MEMORY_SCOPE_AGENT) * (1.0f / 1024.0f) + eps);
                const float* bp = base + (size_t)row * 1024 + col0; float* rowp = out + (size_t)row * 1024 + col0;
#pragma unroll
                for (int bj = 0; bj < 2; ++bj) { const f32x4 b0 = *(const f32x4*)(bp + bj * HALF), b1 = *(const f32x4*)(bp + bj * HALF + 4);
                    const f32x4 x0 = b0 + acc[ai][bj][m][0] * r * g[bj][0], x1 = b1 + acc[ai][bj][m][1] * r * g[bj][1];
                    acc[ai][bj][m][0] = x0; acc[ai][bj][m][1] = x1;
                    *(f32x4*)(rowp + bj * HALF) = x0; *(f32x4*)(rowp + bj * HALF + 4) = x1; } } }
        panel_sumsq(acc, ss2, cnt2, u, wr, fr, fq, lane);
        { f32x4 g[2][2];
#pragma unroll
          for (int bj = 0; bj < 2; ++bj) { g[bj][0] = *(const f32x4*)(g2 + col0 + bj * HALF); g[bj][1] = *(const f32x4*)(g2 + col0 + bj * HALF + 4); }
#pragma unroll
          for (int ai = 0; ai < 2; ++ai)
#pragma unroll
            for (int m = 0; m < 4; ++m) { const int row = row0 + ai * HALF + m * 16;
                const float r = 1.0f / sqrtf(__hip_atomic_load(ss2 + row, __ATOMIC_RELAXED, __HIP_MEMORY_SCOPE_AGENT) * (1.0f / 1024.0f) + eps);
                bf16_t* xp = xn + (size_t)row * 1024 + col0;
#pragma unroll
                for (int bj = 0; bj < 2; ++bj) { const f32x4 v0 = acc[ai][bj][m][0] * r * g[bj][0], v1 = acc[ai][bj][m][1] * r * g[bj][1];
                    u32x4 w; w.x = cvt_pk_bf16(v0[0], v0[1]); w.y = cvt_pk_bf16(v0[2], v0[3]); w.z = cvt_pk_bf16(v1[0], v1[1]); w.w = cvt_pk_bf16(v1[2], v1[3]);
                    *(u32x4*)(xp + bj * HALF) = w; } } }
    }
};
template <class Epi, class Sched, bool ALIGN_EPI = false, bool SP2 = false>
__device__ __forceinline__ void gemm_phase(PG8_LAS unsigned char* lds, const Gemm g, const Sched& S, const Epi& E) {
    const int tid = threadIdx.x, wid = __builtin_amdgcn_readfirstlane(tid >> 6), lane = tid & 63, wr = wid >> 2, wc = wid & 3, fr = lane & 15, fq = lane >> 4;
    const int K = g.K, nt = K / BK;
    unsigned voffA[2], voffB[2];
#pragma unroll
    for (int i = 0; i < 2; ++i) { int R, C; stage_rc(tid * 16 + i * 8192, R, C); const int Rb = Epi::PERM ? ((R & ~31) + perm32(R & 31)) : R;
        voffA[i] = (unsigned)(R * K + C) * 2u; voffB[i] = (unsigned)(Rb * K + C) * 2u; }
    const size_t kstep = (size_t)(BK * 2);
    const size_t hstep = (size_t)HALF * K * 2;
    const size_t tstep = 2 * hstep;
    const unsigned ldsw = (unsigned)wid * 1024u;
    const int aoff = lds_byte(wr * 64 + fr, fq * 8), boff = lds_byte(wc * 32 + fr, fq * 8);
#define PG8_SA(b, h) (((b) * 2 + (h)) * HTB)
#define PG8_SB(b, h) ((4 + (b) * 2 + (h)) * HTB)
#define PG8_STAGE(bufoff, gbase, voff) do { _Pragma("unroll") for (int _i = 0; _i < 2; ++_i) \
        __builtin_amdgcn_global_load_lds((const unsigned*)((const char*)(gbase) + (voff)[_i]), (PG8_LAS unsigned*)(lds + (bufoff) + ldsw + _i * 8192), 16, 0, 0); } while (0)
#define PG8_LDA(dst, b, h) do { _Pragma("unroll") for (int m = 0; m < 4; ++m) _Pragma("unroll") for (int k = 0; k < 2; ++k) dst[m][k] = *(const PG8_LAS bf16x8*)(lds + PG8_SA(b, h) + aoff + m * 2048 + k * 1024); } while (0)
#define PG8_LDB(dst, b, h) do { _Pragma("unroll") for (int n = 0; n < 2; ++n) _Pragma("unroll") for (int k = 0; k < 2; ++k) dst[n][k] = *(const PG8_LAS bf16x8*)(lds + PG8_SB(b, h) + boff + n * 2048 + k * 1024); } while (0)
#define PG8_MMA(ai, bj, At, Bt) do { __builtin_amdgcn_s_setprio(1); _Pragma("unroll") for (int m = 0; m < 4; ++m) _Pragma("unroll") for (int n = 0; n < 2; ++n) _Pragma("unroll") for (int k = 0; k < 2; ++k) \
        acc[ai][bj][m][n] = __builtin_amdgcn_mfma_f32_16x16x32_bf16(Bt[n][k], At[m][k], acc[ai][bj][m][n], 0, 0, 0); __builtin_amdgcn_s_setprio(0); } while (0)
#define PG8_WAIT_V(n) asm volatile("s_waitcnt vmcnt(" #n ")" ::: "memory")
#define PG8_WAIT_L(n) asm volatile("s_waitcnt lgkmcnt(" #n ")" ::: "memory")
#define PG8_BAR __builtin_amdgcn_s_barrier()
#define PG8_SCHED __builtin_amdgcn_sched_barrier(0)
    Unit cur, nxt; int ui = 0;
    if (!S.next(0, cur)) return;
    f32x4 acc[2][2][4][2];
#pragma unroll
    for (int a = 0; a < 2; ++a)
#pragma unroll
        for (int b = 0; b < 2; ++b)
#pragma unroll
            for (int m = 0; m < 4; ++m)
#pragma unroll
                for (int n = 0; n < 2; ++n) acc[a][b][m][n] = (f32x4){0.f, 0.f, 0.f, 0.f};
    bf16x8 At[4][2], B0[2][2], B1[2][2];
    const char* cA = (const char*)g.A + (size_t)cur.pm * tstep; const char* cB = (const char*)g.Bt + (size_t)cur.pn * tstep;
    S.a_ready(cur);
    if constexpr (SP2) {
        PG8_STAGE(PG8_SB(0, 0), cB, voffB); PG8_STAGE(PG8_SB(0, 1), cB + hstep, voffB); PG8_STAGE(PG8_SA(0, 0), cA, voffA); PG8_STAGE(PG8_SA(0, 1), cA + hstep, voffA);
        if (wr == 1) PG8_BAR;
        PG8_WAIT_V(2); PG8_BAR;
        PG8_STAGE(PG8_SB(1, 0), cB + kstep, voffB); PG8_STAGE(PG8_SA(1, 0), cA + kstep, voffA); PG8_STAGE(PG8_SB(1, 1), cB + hstep + kstep, voffB);
        PG8_WAIT_V(6); PG8_BAR;
    } else {
        PG8_STAGE(PG8_SB(0, 0), cB, voffB); PG8_STAGE(PG8_SA(0, 0), cA, voffA); PG8_STAGE(PG8_SB(0, 1), cB + hstep, voffB); PG8_STAGE(PG8_SA(0, 1), cA + hstep, voffA);
        if (wr == 1) PG8_BAR;
        PG8_WAIT_V(4); PG8_BAR;
        PG8_STAGE(PG8_SB(1, 0), cB + kstep, voffB); PG8_STAGE(PG8_SA(1, 0), cA + kstep, voffA); PG8_STAGE(PG8_SB(1, 1), cB + hstep + kstep, voffB);
        PG8_WAIT_V(6); PG8_BAR;
    }
    for (;;) {
        const bool has_next = S.next(ui + 1, nxt);
        const char* nA = has_next ? (const char*)g.A + (size_t)nxt.pm * tstep : cA; const char* nB = has_next ? (const char*)g.Bt + (size_t)nxt.pn * tstep : cB;
        for (int t = 0; t < nt; t += 2) {
            const bool last = (t == nt - 2);
            const char* a1 = cA + (size_t)(t + 1) * kstep;
            const char* a2 = last ? nA : cA + (size_t)(t + 2) * kstep; const char* b2 = last ? nB : cB + (size_t)(t + 2) * kstep;
            const char* a3 = a2 + kstep; const char* b3 = b2 + kstep;
            if (last && has_next) S.a_ready(nxt);
            if constexpr (SP2) {
            PG8_LDB(B0, 0, 0); PG8_LDB(B1, 0, 1); PG8_SCHED; PG8_LDA(At, 0, 0); PG8_STAGE(PG8_SA(1, 1), a1 + hstep, voffA);
            PG8_WAIT_V(8); PG8_WAIT_L(0); PG8_BAR; PG8_MMA(0, 0, At, B0); PG8_MMA(0, 1, At, B1); PG8_BAR; PG8_SCHED;
            PG8_LDA(At, 0, 1); PG8_STAGE(PG8_SB(0, 0), b2, voffB); PG8_STAGE(PG8_SB(0, 1), b2 + hstep, voffB); PG8_STAGE(PG8_SA(0, 0), a2, voffA);
            PG8_WAIT_V(8); PG8_WAIT_L(0); PG8_BAR; PG8_MMA(1, 0, At, B0); PG8_MMA(1, 1, At, B1); PG8_BAR; PG8_SCHED;
            PG8_LDB(B0, 1, 0); PG8_LDB(B1, 1, 1); PG8_SCHED; PG8_LDA(At, 1, 0); PG8_STAGE(PG8_SA(0, 1), a2 + hstep, voffA);
            PG8_WAIT_V(8); PG8_WAIT_L(0); PG8_BAR; PG8_MMA(0, 0, At, B0); PG8_MMA(0, 1, At, B1); PG8_BAR; PG8_SCHED;
            PG8_LDA(At, 1, 1); PG8_STAGE(PG8_SB(1, 0), b3, voffB); PG8_STAGE(PG8_SB(1, 1), b3 + hstep, voffB); PG8_STAGE(PG8_SA(1, 0), a3, voffA);
            PG8_WAIT_V(8); PG8_WAIT_L(0); PG8_BAR; PG8_MMA(1, 0, At, B0); PG8_MMA(1, 1, At, B1); PG8_BAR; PG8_SCHED;
            } else {
            PG8_LDB(B0, 0, 0); PG8_SCHED; PG8_LDA(At, 0, 0); PG8_STAGE(PG8_SA(1, 1), a1 + hstep, voffA);
            PG8_WAIT_L(8); PG8_BAR; PG8_WAIT_L(0); PG8_MMA(0, 0, At, B0); PG8_BAR; PG8_SCHED;
            PG8_LDB(B1, 0, 1); PG8_STAGE(PG8_SB(0, 0), b2, voffB);
            PG8_BAR; PG8_WAIT_L(0); PG8_MMA(0, 1, At, B1); PG8_BAR;
            PG8_LDA(At, 0, 1); PG8_STAGE(PG8_SA(0, 0), a2, voffA);
            PG8_BAR; PG8_WAIT_L(0); PG8_MMA(1, 0, At, B0); PG8_BAR; PG8_SCHED;
            PG8_STAGE(PG8_SB(0, 1), b2 + hstep, voffB);
            PG8_WAIT_V(6); PG8_BAR; PG8_MMA(1, 1, At, B1); PG8_BAR;
            PG8_LDB(B0, 1, 0); PG8_SCHED; PG8_LDA(At, 1, 0); PG8_STAGE(PG8_SA(0, 1), a2 + hstep, voffA);
            PG8_WAIT_L(8); PG8_BAR; PG8_WAIT_L(0); PG8_MMA(0, 0, At, B0); PG8_BAR; PG8_SCHED;
            PG8_LDB(B1, 1, 1); PG8_STAGE(PG8_SB(1, 0), b3, voffB);
            PG8_BAR; PG8_WAIT_L(0); PG8_MMA(0, 1, At, B1); PG8_BAR;
            PG8_LDA(At, 1, 1); PG8_STAGE(PG8_SA(1, 0), a3, voffA);
            PG8_BAR; PG8_WAIT_L(0); PG8_MMA(1, 0, At, B0); PG8_BAR; PG8_SCHED;
            PG8_STAGE(PG8_SB(1, 1), b3 + hstep, voffB);
            PG8_WAIT_V(6); PG8_BAR; PG8_MMA(1, 1, At, B1); PG8_BAR;
            }
        }
        if constexpr (ALIGN_EPI) { if (wr == 0) PG8_BAR; }
        if constexpr (!Epi::AFTER_DRAIN) { E(acc, cur, wr, wc, fr, fq); S.done(cur); }
        if (!has_next) break;
#pragma unroll
        for (int a = 0; a < 2; ++a)
#pragma unroll
            for (int b = 0; b < 2; ++b)
#pragma unroll
                for (int m = 0; m < 4; ++m)
#pragma unroll
                    for (int n = 0; n < 2; ++n) acc[a][b][m][n] = (f32x4){0.f, 0.f, 0.f, 0.f};
        cur = nxt; cA = nA; cB = nB; ++ui;
        if constexpr (ALIGN_EPI) { if (wr == 1) PG8_BAR; }
    }
    PG8_WAIT_V(0);
    if constexpr (!ALIGN_EPI) { if (wr == 0) PG8_BAR; }
    PG8_BAR;
    if constexpr (Epi::AFTER_DRAIN) { E.fused(acc, cur, wr, wc, fr, fq, lds, wid, lane); S.done(cur); }
#undef PG8_SA
#undef PG8_SB
#undef PG8_STAGE
#undef PG8_LDA
#undef PG8_LDB
#undef PG8_MMA
#undef PG8_WAIT_V
#undef PG8_WAIT_L
#undef PG8_BAR
#undef PG8_SCHED
}
}

constexpr int BATCH = 8, SEQ = 4096, DM = 1024, MTOK = BATCH * SEQ, HYW = 512, NIN = 3072, DFF = 4096;
constexpr int NWAVES = 8, NTHR = 512;
constexpr float NORM_EPS = 1e-6f, SUBLN_EPS = 1e-5f;
constexpr float QSCALE = 0.125f * 1.4426950408889634f;
constexpr int HRLEN = 8224;
constexpr size_t MiB = 1u << 20;
constexpr size_t WS_WIN = 0, WS_WOUT = 6 * MiB, WS_WUP = 8 * MiB, WS_WDOWN = 16 * MiB;
constexpr size_t WS_HR = 24 * MiB;
constexpr size_t WS_ROPE = 33 * MiB;
constexpr size_t WS_CTL = 34 * MiB, CTL_BYTES = 16384 + 3 * 131072;
constexpr size_t CTL_CNT = 14336, CTL_SS = 16384;
constexpr size_t WS_XN = 40 * MiB;
constexpr size_t WS_MO = 104 * MiB;
constexpr size_t WS_YT = 168 * MiB;
constexpr size_t WS_UVT = 200 * MiB;
constexpr size_t WS_QK = 328 * MiB;
constexpr size_t WS_KT = 360 * MiB;
constexpr size_t WS_VT = 296 * MiB;
constexpr size_t WS_MIX = 392 * MiB;
constexpr size_t WS_H = 200 * MiB;
constexpr size_t WS_END = 456 * MiB;
constexpr int LDS_BYTES = 135168;

#define LAS __attribute__((address_space(3)))
typedef unsigned short bf16;
typedef unsigned u32x4 __attribute__((ext_vector_type(4)));
typedef unsigned u32x2 __attribute__((ext_vector_type(2)));
typedef float f32x4 __attribute__((ext_vector_type(4)));
typedef float f32x16 __attribute__((ext_vector_type(16)));
typedef short bf16x8 __attribute__((ext_vector_type(8)));
typedef short s16x4 __attribute__((ext_vector_type(4)));

__device__ __forceinline__ unsigned f2bf(float f) { unsigned u = __builtin_bit_cast(unsigned, f); return (u + 0x7fffu + ((u >> 16) & 1u)) >> 16; }
__device__ __forceinline__ unsigned pk2(float lo, float hi) { return f2bf(lo) | (f2bf(hi) << 16); }
typedef float f32x2_t __attribute__((ext_vector_type(2))); typedef __bf16 bf16x2_t __attribute__((ext_vector_type(2)));
__device__ __forceinline__ unsigned cvtpk(float lo, float hi) { f32x2_t v = {lo, hi}; bf16x2_t b = __builtin_convertvector(v, bf16x2_t); return __builtin_bit_cast(unsigned, b); }
__device__ __forceinline__ float bf2f(unsigned short b) { return __builtin_bit_cast(float, (unsigned)b << 16); }
__device__ __forceinline__ float bflo(unsigned w) { return __builtin_bit_cast(float, w << 16); }
__device__ __forceinline__ float bfhi(unsigned w) { return __builtin_bit_cast(float, w & 0xffff0000u); }
__device__ __forceinline__ float wave_sum(float v) {
#pragma unroll
    for (int o = 1; o < 64; o <<= 1) v += __shfl_xor(v, o);
    return v;
}
__device__ __forceinline__ float swap_hi(float v) { return __shfl_xor(v, 32); }
#define LDS_WAIT() asm volatile("s_waitcnt lgkmcnt(0)" ::: "memory")

struct Args { const float* in[25]; float* out; unsigned char* ws; int ph_lo, ph_hi; };

__device__ __forceinline__ int win_src(int n) {
    if (n < 1536) return n;
    if (n < 2048) return n + 1024;
    const int pp = n - 2048, grp = pp >> 6, p = pp & 63, g = p >> 3, e = p & 7;
    const int d = (e < 4) ? (4 * g + e) : (32 + 4 * g + (e - 4));
    return 1536 + grp * 64 + d;
}
template <bool PERMW>
__device__ __forceinline__ void p0_transpose_item(const float* W, int K, int N, bf16* WT, LAS float* scr, int item, int lane) {
    const int nblk = N / 32, kb = item / nblk, nb = item % nblk, k0 = 64 * kb, n0 = 32 * nb;
    const int sc = PERMW ? win_src(n0 + (lane & 31)) : (n0 + (lane & 31));
#pragma unroll 8
    for (int i = 0; i < 32; ++i) { const int kk = 2 * i + (lane >> 5); scr[kk * 33 + (lane & 31)] = W[(size_t)(k0 + kk) * N + sc]; }
    LDS_WAIT(); asm volatile("" ::: "memory");
    const int c = lane & 7;
#pragma unroll
    for (int j = 0; j < 4; ++j) { const int n = (lane >> 3) + 8 * j; const LAS float* s = scr + (8 * c) * 33 + n;
        u32x4 o; o.x = pk2(s[0 * 33], s[1 * 33]); o.y = pk2(s[2 * 33], s[3 * 33]); o.z = pk2(s[4 * 33], s[5 * 33]); o.w = pk2(s[6 * 33], s[7 * 33]);
        *(u32x4*)(WT + (size_t)(n0 + n) * K + k0 + 8 * c) = o; }
    LDS_WAIT(); asm volatile("" ::: "memory");
}
__device__ __forceinline__ void rms_row_to_bf16(const float* xrow, const float* gain, bf16* orow, int lane) {
    const f32x4* xr = (const f32x4*)xrow + lane; const f32x4* gr = (const f32x4*)gain + lane;
    f32x4 v[4]; float s = 0.f;
#pragma unroll
    for (int j = 0; j < 4; ++j) { v[j] = xr[64 * j]; s += (v[j].x * v[j].x + v[j].y * v[j].y) + (v[j].z * v[j].z + v[j].w * v[j].w); }
    const float r = 1.0f / sqrtf(wave_sum(s) * (1.f / DM) + NORM_EPS);
    unsigned long long* o8 = (unsigned long long*)orow + lane;
#pragma unroll
    for (int j = 0; j < 4; ++j) { const f32x4 g = gr[64 * j];
        o8[64 * j] = (unsigned long long)pk2(v[j].x * r * g.x, v[j].y * r * g.y) | ((unsigned long long)pk2(v[j].z * r * g.z, v[j].w * r * g.w) << 32); }
}

__device__ __forceinline__ void filter_item(LAS unsigned char* lds, const Args& a, bf16* HR, int pg, int tid) {
    LAS float* Z = (LAS float*)lds;
    LAS float* HA = Z + 16 * 33;
    LAS float* HB = HA + 16 * 64;
    LAS float* W1 = HB + 16 * 64;
    LAS float* W2 = W1 + 33 * 64;
    LAS float* W3 = W2 + 64 * 64;
    const float* w1 = a.in[6]; const float* b1 = a.in[7]; const float* w2 = a.in[8]; const float* b2 = a.in[9];
    const float* w3 = a.in[10]; const float* b3 = a.in[11]; const float* w4 = a.in[12]; const float* freq = a.in[13]; const float* fbias = a.in[14];
    const int t0 = 16 * pg;
    for (int i = tid; i < 33 * 64; i += NTHR) W1[i] = w1[i];
    for (int i = tid; i < 64 * 64; i += NTHR) { W2[i] = w2[i]; W3[i] = w3[i]; }
    for (int i = tid; i < 16 * 33; i += NTHR) { const int p = i / 33, f = i % 33; const int pos = t0 + p; float val;
        if (f == 0) val = (float)pos * (1.0f / (float)(SEQ - 1));
        else { const int j = (f - 1) & 15; const float fj = 1e-4f + (float)j * ((15.0f - 1e-4f) / 15.0f); const float w = (6.283185307179586f / (float)SEQ) * (float)pos; const float arg = fj * w;
            val = (f <= 16) ? cosf(arg) : -sinf(arg); }
        Z[i] = val; }
    __syncthreads();
    for (int o = tid; o < 1024; o += NTHR) { const int p = o >> 6, n = o & 63; float acc = b1[n];
#pragma unroll 3
        for (int f = 0; f < 33; ++f) acc += Z[p * 33 + f] * W1[f * 64 + n];
        HA[o] = sinf(freq[n] * acc); }
    __syncthreads();
    for (int o = tid; o < 1024; o += NTHR) { const int p = o >> 6, n = o & 63; float acc = b2[n];
#pragma unroll 4
        for (int f = 0; f < 64; ++f) acc += HA[p * 64 + f] * W2[f * 64 + n];
        HB[o] = sinf(freq[n] * acc); }
    __syncthreads();
    for (int o = tid; o < 1024; o += NTHR) { const int p = o >> 6, n = o & 63; float acc = b3[n];
#pragma unroll 4
        for (int f = 0; f < 64; ++f) acc += HB[p * 64 + f] * W3[f * 64 + n];
        HA[o] = sinf(freq[n] * acc); }
    __syncthreads();
    {   const int c = tid;
        float af[16], ab[16];
#pragma unroll
        for (int p = 0; p < 16; ++p) { af[p] = 0.f; ab[p] = 0.f; }
        for (int k0 = 0; k0 < 64; k0 += 8) { float wf[8], wb[8];
#pragma unroll
            for (int kk = 0; kk < 8; ++kk) { wf[kk] = w4[(k0 + kk) * 1024 + c]; wb[kk] = w4[(k0 + kk) * 1024 + 512 + c]; }
#pragma unroll
            for (int kk = 0; kk < 8; ++kk)
#pragma unroll
                for (int p = 0; p < 16; ++p) { const float hv = HA[p * 64 + k0 + kk]; af[p] += hv * wf[kk]; ab[p] += hv * wb[kk]; } }
        const float min_decay = -4.605170185988091f / 1.5f, max_decay = -4.605170185988091f / 0.3f;
        const float adelta = fabsf(min_decay + (float)c * ((max_decay - min_decay) / 511.0f));
        bf16* hr = HR + (size_t)c * HRLEN;
#pragma unroll
        for (int p = 0; p < 16; ++p) { const int pos = t0 + p; const float tl = (float)pos * (1.0f / (float)(SEQ - 1)); const float dec = expf(-tl * adelta);
            const float vf = af[p] * dec, vb = ab[p] * dec;
            if (pos == 0) hr[4096] = (bf16)f2bf(vf + vb + fbias[c]);
            else { hr[4096 - pos] = (bf16)f2bf(vf); hr[4096 + pos] = (bf16)f2bf(vb); } }
        if (pg == 0) { hr[0] = 0; for (int i = 8192; i < HRLEN; ++i) hr[i] = 0; }
    }
    __syncthreads();
}

namespace att {
constexpr int KP = 272, VP = 144, KBUF = 64 * KP, VBUF = 128 * VP, VOFF = 2 * KBUF;
constexpr int NT = SEQ / 64;
__device__ __forceinline__ float max3(float a, float b, float c) { return fmaxf(fmaxf(a, b), c); }
__device__ __forceinline__ float fadd_s(float a, float b) { float r; asm("v_add_f32_e32 %0, %1, %2" : "=v"(r) : "v"(a), "v"(b)); return r; }
#define SBAR() __builtin_amdgcn_sched_barrier(0)
__device__ __forceinline__ void v_load(bf16x8 (&vf)[4], const LAS unsigned char* vb, int ks) {
#pragma unroll
    for (int e = 0; e < 4; ++e) vf[e] = *(const LAS bf16x8*)(vb + e * 32 * VP + ks * 32);
}
__device__ __forceinline__ void pv_tile(f32x16 (&o)[4], const u32x4 (&P)[4], bf16x8 (&vf0)[4], const LAS unsigned char* vb) {
    bf16x8 vf1[4];
#pragma unroll
    for (int ks = 0; ks < 4; ++ks) { const bf16x8 pb = __builtin_bit_cast(bf16x8, P[ks]);
        if (ks == 0 || ks == 2) v_load(vf1, vb, ks + 1); else if (ks == 1) v_load(vf0, vb, 2);
        SBAR(); __builtin_amdgcn_s_setprio(1);
#pragma unroll
        for (int e = 0; e < 4; ++e) o[e] = __builtin_amdgcn_mfma_f32_32x32x16_bf16((ks & 1) ? vf1[e] : vf0[e], pb, o[e], 0, 0, 0);
        __builtin_amdgcn_s_setprio(0); SBAR(); }
}
__device__ __forceinline__ float xhalf_max(float v) { auto rr = __builtin_amdgcn_permlane32_swap(__float_as_uint(v), __float_as_uint(v), false, false); return fmaxf(__uint_as_float(rr[0]), __uint_as_float(rr[1])); }
__device__ __forceinline__ float xhalf_sum(float v) { auto rr = __builtin_amdgcn_permlane32_swap(__float_as_uint(v), __float_as_uint(v), false, false); return __uint_as_float(rr[0]) + __uint_as_float(rr[1]); }
constexpr int QOFF = 2 * KBUF + 3 * VBUF;
#define ATT_SLOT(T, PKW, PVW, PKL, PVL) do { const int t = (T); \
        const LAS unsigned char* kst = lds + (t & 1) * KBUF; \
        bf16x8 vf0[4]; \
        if (c == 1 && t > 0 && VAR != 5) { v_load(vf0, lds + VOFF + vprev + voff, 0); pv_tile(o, P, vf0, lds + VOFF + vprev + voff); } \
        if (t + 2 < NT && VAR != 4) { _Pragma("unroll") for (int i = 0; i < 2; ++i) { PKL[i] = *(const u32x4*)(gk[i] + (size_t)(t + 2) * 8192); PVL[i] = *(const u32x4*)(gv[i] + (size_t)(t + 2) * 8192); } } \
        SBAR(); \
        f32x16 s0, s1; \
        { const LAS unsigned char* kb = kst + r32 * KP + c * 128 + hi * 16; const LAS unsigned char* qb_ = lds + QOFF + wid * 4096 + lane * 16; \
          bf16x8 ka[4], kc2[4], qa[2], qc[2]; \
          qa[0] = *(const LAS bf16x8*)(qb_); qa[1] = *(const LAS bf16x8*)(qb_ + 1024); \
          ka[0] = *(const LAS bf16x8*)(kb); ka[1] = *(const LAS bf16x8*)(kb + 32 * KP); ka[2] = *(const LAS bf16x8*)(kb + 32); ka[3] = *(const LAS bf16x8*)(kb + 32 * KP + 32); \
          SBAR(); \
          qc[0] = *(const LAS bf16x8*)(qb_ + 2048); qc[1] = *(const LAS bf16x8*)(qb_ + 3072); \
          kc2[0] = *(const LAS bf16x8*)(kb + 64); kc2[1] = *(const LAS bf16x8*)(kb + 32 * KP + 64); kc2[2] = *(const LAS bf16x8*)(kb + 96); kc2[3] = *(const LAS bf16x8*)(kb + 32 * KP + 96); \
          __builtin_amdgcn_s_setprio(1); s0 = __builtin_amdgcn_mfma_f32_32x32x16_bf16(ka[0], qa[0], zero16, 0, 0, 0); s1 = __builtin_amdgcn_mfma_f32_32x32x16_bf16(ka[1], qa[0], zero16, 0, 0, 0); \
          s0 = __builtin_amdgcn_mfma_f32_32x32x16_bf16(ka[2], qa[1], s0, 0, 0, 0); s1 = __builtin_amdgcn_mfma_f32_32x32x16_bf16(ka[3], qa[1], s1, 0, 0, 0); \
          SBAR(); \
          s0 = __builtin_amdgcn_mfma_f32_32x32x16_bf16(kc2[0], qc[0], s0, 0, 0, 0); s1 = __builtin_amdgcn_mfma_f32_32x32x16_bf16(kc2[1], qc[0], s1, 0, 0, 0); \
          s0 = __builtin_amdgcn_mfma_f32_32x32x16_bf16(kc2[2], qc[1], s0, 0, 0, 0); s1 = __builtin_amdgcn_mfma_f32_32x32x16_bf16(kc2[3], qc[1], s1, 0, 0, 0); __builtin_amdgcn_s_setprio(0); } \
        if (c == 0 && VAR != 5) v_load(vf0, lds + VOFF + vcur + voff, 0); \
        SBAR(); \
        if (VAR != 6) { float mx = max3(s0[0], s1[0], s0[1]); \
        mx = max3(mx, s1[1], s0[2]); mx = max3(mx, s1[2], s0[3]); mx = max3(mx, s1[3], s0[4]); mx = max3(mx, s1[4], s0[5]); \
        mx = max3(mx, s1[5], s0[6]); mx = max3(mx, s1[6], s0[7]); mx = max3(mx, s1[7], s0[8]); mx = max3(mx, s1[8], s0[9]); \
        mx = max3(mx, s1[9], s0[10]); mx = max3(mx, s1[10], s0[11]); mx = max3(mx, s1[11], s0[12]); mx = max3(mx, s1[12], s0[13]); \
        mx = max3(mx, s1[13], s0[14]); mx = max3(mx, s1[14], s0[15]); mx = fmaxf(mx, s1[15]); \
        mx = xhalf_max(mx); \
        if (t == 0) { if (__any(fabsf(mx) > 8.0f)) { mref = mx; gen = true; } } \
        else if (__any(mx > mref + 8.0f)) { const float mnew = fmaxf(mx, mref); const float al = __builtin_amdgcn_exp2f(mref - mnew); \
            _Pragma("unroll") for (int e = 0; e < 4; ++e) _Pragma("unroll") for (int r = 0; r < 16; ++r) o[e][r] *= al; \
            lsum *= al; mref = mnew; gen = true; } \
        float ps0 = 0.f, ps1 = 0.f; \
        if (gen) { _Pragma("unroll") for (int r = 0; r < 16; ++r) { s0[r] = __builtin_amdgcn_exp2f(s0[r] - mref); s1[r] = __builtin_amdgcn_exp2f(s1[r] - mref); ps0 += s0[r]; ps0 += s1[r]; } } \
        else { _Pragma("unroll") for (int r = 0; r < 16; ++r) { s0[r] = __builtin_amdgcn_exp2f(s0[r]); s1[r] = __builtin_amdgcn_exp2f(s1[r]); ps0 += s0[r]; ps0 += s1[r]; } } \
        lsum += ps0 + ps1; } \
        P[0] = (u32x4){cvtpk(s0[0], s0[1]), cvtpk(s0[2], s0[3]), cvtpk(s0[4], s0[5]), cvtpk(s0[6], s0[7])}; \
        P[1] = (u32x4){cvtpk(s0[8], s0[9]), cvtpk(s0[10], s0[11]), cvtpk(s0[12], s0[13]), cvtpk(s0[14], s0[15])}; \
        P[2] = (u32x4){cvtpk(s1[0], s1[1]), cvtpk(s1[2], s1[3]), cvtpk(s1[4], s1[5]), cvtpk(s1[6], s1[7])}; \
        P[3] = (u32x4){cvtpk(s1[8], s1[9]), cvtpk(s1[10], s1[11]), cvtpk(s1[12], s1[13]), cvtpk(s1[14], s1[15])}; \
        if (c == 0 && VAR != 5) pv_tile(o, P, vf0, lds + VOFF + vcur + voff); \
        if (t + 1 < NT && VAR != 4) { LAS unsigned char* kn = lds + ((t + 1) & 1) * KBUF; LAS unsigned char* vn = lds + vnext; \
            _Pragma("unroll") for (int i = 0; i < 2; ++i) { *(LAS u32x4*)(kn + lk[i]) = PKW[i]; *(LAS u32x4*)(vn + lv[i]) = PVW[i]; } } \
        { const int tmp = vprev; vprev = vcur; vcur = vnext; vnext = tmp; } \
        if (VAR != 3) { asm volatile("s_waitcnt lgkmcnt(0)\n\ts_barrier" ::: "memory"); } \
    } while (0)
template <int VAR> __device__ __forceinline__ void unit(LAS unsigned char* lds, const bf16* QK, const bf16* KT, const bf16* VT, bf16* MIX, const float* sgain, float lam, int b, int h, int qb) {
    const int tid = threadIdx.x, lane = tid & 63, r32 = lane & 31, hi = lane >> 5; const int wid = __builtin_amdgcn_readfirstlane(tid >> 6);
    const int qsub = wid & 3, c = wid >> 2;
    const size_t rowbase = (size_t)b * SEQ; const int q0 = qb * 128 + qsub * 32;
    { const bf16* qp = QK + (rowbase + q0 + r32) * 512 + h * 128 + c * 64 + hi * 8;
#pragma unroll
      for (int ds = 0; ds < 4; ++ds) *(LAS bf16x8*)(lds + QOFF + wid * 4096 + ds * 1024 + lane * 16) = *(const bf16x8*)(qp + ds * 16); }
    const bf16* gk[2]; const bf16* gv[2]; int lk[2], lv[2];
#pragma unroll
    for (int i = 0; i < 2; ++i) { const int id = tid + NTHR * i; const int kr = id >> 4, kc = id & 15; const int ve = id >> 3, vc = id & 7;
        gk[i] = KT + (size_t)(b * 4 + h) * 64 * 8192 + id * 8; lk[i] = kr * KP + kc * 16;
        gv[i] = VT + (size_t)(b * 4 + h) * 64 * 8192 + id * 8; lv[i] = VOFF + ve * VP + vc * 16; }
    u32x4 pkA[2], pvA[2], pkB[2], pvB[2];
#pragma unroll
    for (int i = 0; i < 2; ++i) { pkA[i] = *(const u32x4*)gk[i]; pvA[i] = *(const u32x4*)gv[i]; }
#pragma unroll
    for (int i = 0; i < 2; ++i) { pkB[i] = *(const u32x4*)(gk[i] + 8192); pvB[i] = *(const u32x4*)(gv[i] + 8192); }
#pragma unroll
    for (int i = 0; i < 2; ++i) { *(LAS u32x4*)(lds + lk[i]) = pkA[i]; *(LAS u32x4*)(lds + lv[i]) = pvA[i]; }
    __syncthreads();
    f32x16 o[4];
#pragma unroll
    for (int e = 0; e < 4; ++e) o[e] = (f32x16){};
    const f32x16 zero16 = (f32x16){};
    float mref = 0.f, lsum = 0.f; bool gen = false;
    u32x4 P[4];
#pragma unroll
    for (int ks = 0; ks < 4; ++ks) P[ks] = (u32x4){0u, 0u, 0u, 0u};
    int vcur = 0, vprev = 2 * VBUF, vnext = VBUF;
    const int voff = r32 * VP + hi * 16;
    for (int tt = 0; tt < NT; tt += 2) {
        ATT_SLOT(tt, pkB, pvB, pkA, pvA);
        ATT_SLOT(tt + 1, pkA, pvA, pkB, pvB);
    }
    if (c == 1) { bf16x8 vf0[4]; v_load(vf0, lds + VOFF + vprev + voff, 0); pv_tile(o, P, vf0, lds + VOFF + vprev + voff); }
    __syncthreads();
    lsum = xhalf_sum(lsum);
    const float sc = (c == 0) ? (1.0f / lsum) : (lam / lsum);
    LAS float* X = (LAS float*)lds + qsub * (128 * 32);
    if (c == 1) {
#pragma unroll
        for (int e = 0; e < 4; ++e)
#pragma unroll
            for (int r = 0; r < 16; ++r) { const int ee = 32 * e + (r & 3) + 8 * (r >> 2) + 4 * hi; X[ee * 32 + r32] = o[e][r] * sc; } }
    __syncthreads();
    if (c == 0) { float ss = 0.f;
#pragma unroll
        for (int e = 0; e < 4; ++e)
#pragma unroll
            for (int r = 0; r < 16; ++r) { const int ee = 32 * e + (r & 3) + 8 * (r >> 2) + 4 * hi; const float v = o[e][r] * sc - X[ee * 32 + r32]; o[e][r] = v; ss += v * v; }
        ss = xhalf_sum(ss);
        const float rs = (1.0f / sqrtf(ss * (1.0f / 128.0f) + SUBLN_EPS)) * 0.8f;
        bf16* op = MIX + (rowbase + q0 + r32) * 1024 + 512 + h * 128;
#pragma unroll
        for (int e = 0; e < 4; ++e)
#pragma unroll
            for (int q4 = 0; q4 < 4; ++q4) { const int ee = 32 * e + 8 * q4 + 4 * hi; const f32x4 g = *(const f32x4*)(sgain + ee);
                u32x2 w; w.x = cvtpk(o[e][4 * q4] * rs * g.x, o[e][4 * q4 + 1] * rs * g.y); w.y = cvtpk(o[e][4 * q4 + 2] * rs * g.z, o[e][4 * q4 + 3] * rs * g.w);
                *(u32x2*)(op + ee) = w; } }
    __syncthreads();
}
}

namespace hy {
constexpr int UP = 264, UBUF = 32 * UP * 2, HRB = HRLEN * 2;
constexpr int NCH = 17;
__device__ __forceinline__ float ldbf(const bf16* p) { return bf2f(*p); }
struct StageRegs { u32x2 xa, xb, va, vb; unsigned short xm, vm; };
__device__ __forceinline__ void stage_load(StageRegs& R, const bf16* X1, const bf16* V, int j, int tid) {
    const int b = tid >> 6, tt = tid & 63; const int S0 = 256 * j + 4 * tt - 4;
    const bool okA = (S0 >= 0 && S0 < SEQ), okB = (S0 + 4 < SEQ), okM = (S0 >= 1 && S0 <= SEQ);
    const size_t ia = (size_t)b * SEQ + (okA ? S0 : 0), ib = (size_t)b * SEQ + (okB ? S0 + 4 : 0), im = (size_t)b * SEQ + (okM ? S0 - 1 : 0);
    R.xa = *(const u32x2*)(X1 + ia); R.xb = *(const u32x2*)(X1 + ib); R.xm = X1[im];
    R.va = *(const u32x2*)(V + ia); R.vb = *(const u32x2*)(V + ib); R.vm = V[im];
}
__device__ __forceinline__ void stage_write(LAS unsigned char* ub, const StageRegs& R, const float (&w1)[4], const float (&wv)[4], int j, int tid) {
    const int b = tid >> 6, tt = tid & 63; const int S0 = 256 * j + 4 * tt - 4;
    const bool okA = (S0 >= 0 && S0 < SEQ), okB = (S0 + 4 < SEQ), okM = (S0 >= 1 && S0 <= SEQ);
    float xs[9], vs[9];
    xs[0] = okM ? bf2f(R.xm) : 0.f; vs[0] = okM ? bf2f(R.vm) : 0.f;
    xs[1] = okA ? bflo(R.xa.x) : 0.f; xs[2] = okA ? bfhi(R.xa.x) : 0.f; xs[3] = okA ? bflo(R.xa.y) : 0.f; xs[4] = okA ? bfhi(R.xa.y) : 0.f;
    xs[5] = okB ? bflo(R.xb.x) : 0.f; xs[6] = okB ? bfhi(R.xb.x) : 0.f; xs[7] = okB ? bflo(R.xb.y) : 0.f; xs[8] = okB ? bfhi(R.xb.y) : 0.f;
    vs[1] = okA ? bflo(R.va.x) : 0.f; vs[2] = okA ? bfhi(R.va.x) : 0.f; vs[3] = okA ? bflo(R.va.y) : 0.f; vs[4] = okA ? bfhi(R.va.y) : 0.f;
    vs[5] = okB ? bflo(R.vb.x) : 0.f; vs[6] = okB ? bfhi(R.vb.x) : 0.f; vs[7] = okB ? bflo(R.vb.y) : 0.f; vs[8] = okB ? bfhi(R.vb.y) : 0.f;
    float g[7];
#pragma unroll
    for (int i = 0; i < 7; ++i) { const float cx = w1[0] * xs[i] + w1[1] * xs[i + 1] + w1[2] * xs[i + 2] + w1[3]; const float cv = wv[0] * vs[i] + wv[1] * vs[i + 1] + wv[2] * vs[i + 2] + wv[3];
        g[i] = ((i < 4) ? okA : okB) ? cx * cv : 0.f; }
#pragma unroll
    for (int r = 0; r < 4; ++r) { u32x2 w; w.x = pk2(g[r], g[r + 1]); w.y = pk2(g[r + 2], g[r + 3]);
        *(LAS u32x2*)(ub + ((4 * b + r) * UP + 4 * tt) * 2) = w; }
}
__device__ __forceinline__ void channel(LAS unsigned char* lds, const bf16* UVT, const bf16* HR, const float* conv_w, const float* conv_b, bf16* YT, int c) {
    const int tid = threadIdx.x, lane = tid & 63, r32 = lane & 31, hi = lane >> 5; const int wid = __builtin_amdgcn_readfirstlane(tid >> 6);
    const bf16* X0 = UVT + (size_t)c * MTOK; const bf16* X1 = UVT + (size_t)(512 + c) * MTOK; const bf16* V = UVT + (size_t)(1024 + c) * MTOK;
    float w0[4], w1[4], wv[4];
#pragma unroll
    for (int k = 0; k < 3; ++k) { w0[k] = conv_w[k * 1536 + c]; w1[k] = conv_w[k * 1536 + 512 + c]; wv[k] = conv_w[k * 1536 + 1024 + c]; }
    w0[3] = conv_b[c]; w1[3] = conv_b[512 + c]; wv[3] = conv_b[1024 + c];
    for (int i = tid; i < HRB / 16; i += NTHR) { const bf16* src = HR + (size_t)c * HRLEN + 8 * i; ((LAS u32x4*)lds)[i] = *(const u32x4*)src;
        const u32x2 lo = *(const u32x2*)(src + 4); const u32x2 hi2 = (8 * i + 8 < HRLEN) ? *(const u32x2*)(src + 8) : (u32x2){0u, 0u};
        ((LAS u32x4*)(lds + HRB))[i] = (u32x4){lo.x, lo.y, hi2.x, hi2.y}; }
    LAS unsigned char* ub0 = lds + 2 * HRB;
    StageRegs SR;
    stage_load(SR, X1, V, 0, tid); stage_write(ub0, SR, w1, wv, 0, tid);
    __syncthreads();
    f32x16 acc[4];
#pragma unroll
    for (int n = 0; n < 4; ++n) acc[n] = (f32x16){};
    const int idx0 = 4096 - 4 * (128 * wid + r32) - 4 + 8 * hi;
    const int hb0 = (r32 & 1) ? idx0 * 2 : HRB + (idx0 - 4) * 2;
    for (int j = 0; j < NCH; ++j) {
        LAS unsigned char* ucur = ub0 + (j & 1) * UBUF;
        if (j + 1 < NCH) stage_load(SR, X1, V, j + 1, tid);
        const int nks = (j < NCH - 1) ? 16 : 1;
        const LAS unsigned char* ua = ucur + r32 * (UP * 2) + hi * 16;
        const LAS unsigned char* hp = lds + hb0 + j * 512;
#pragma unroll 4
        for (int ks = 0; ks < nks; ++ks) { const bf16x8 a = *(const LAS bf16x8*)(ua + ks * 32);
#pragma unroll
            for (int n = 0; n < 4; ++n) { const bf16x8 bb = *(const LAS bf16x8*)(hp + ks * 32 - n * 256);
                acc[n] = __builtin_amdgcn_mfma_f32_32x32x16_bf16(a, bb, acc[n], 0, 0, 0); } }
        if (j + 1 < NCH) stage_write(ub0 + ((j + 1) & 1) * UBUF, SR, w1, wv, j + 1, tid);
        __syncthreads();
    }
#pragma unroll
    for (int n = 0; n < 4; ++n) { const int t = 4 * (128 * wid + 32 * n + r32);
#pragma unroll
        for (int q = 0; q < 4; ++q) { const int b = 2 * q + hi; const bf16* xp = X0 + (size_t)b * SEQ + t; const u32x2 xa = *(const u32x2*)xp; float xs[6];
            { const float xm = ldbf(xp - ((t > 0) ? 1 : 0)), xq = ldbf(xp + ((t + 4 < SEQ) ? 4 : 0)); xs[0] = (t > 0) ? xm : 0.f; xs[5] = (t + 4 < SEQ) ? xq : 0.f; }
            xs[1] = bflo(xa.x); xs[2] = bfhi(xa.x); xs[3] = bflo(xa.y); xs[4] = bfhi(xa.y);
            float y[4];
#pragma unroll
            for (int i = 0; i < 4; ++i) y[i] = acc[n][4 * q + i] * (w0[0] * xs[i] + w0[1] * xs[i + 1] + w0[2] * xs[i + 2] + w0[3]);
            u32x2 w; w.x = pk2(y[0], y[1]); w.y = pk2(y[2], y[3]);
            *(u32x2*)(YT + (size_t)c * MTOK + (size_t)b * SEQ + t) = w; } }
    __syncthreads();
}
}

#define XB_TMO      128
#define XB_XCNT(j)  (256  + 64 * (j))
#define XB_XSUB(j)  (1280 + 64 * (j))
#define XB_XGEN(j)  (2304 + 64 * (j))
#define XB_TOP      3328
#define XB_TOPGEN   3392
#define XCD_BAR_WORDS 3456
#define XB_SPIN_CAP (1u << 18)

__device__ __forceinline__ unsigned xb_ld(unsigned* p)              { return __hip_atomic_load(p, __ATOMIC_RELAXED, __HIP_MEMORY_SCOPE_AGENT); }
__device__ __forceinline__ unsigned xb_add(unsigned* p, unsigned v) { return __hip_atomic_fetch_add(p, v, __ATOMIC_RELAXED, __HIP_MEMORY_SCOPE_AGENT); }
__device__ __forceinline__ unsigned xb_xcc_id() { return (unsigned)__builtin_amdgcn_s_getreg((3 << 11) | 20) & 0xFu; }
#define XB_SPIN(cond, bar) do { unsigned _sp = 0; while (cond) { __builtin_amdgcn_s_sleep(1); \
    if ((++_sp & 255u) == 0u) { if (xb_ld(&(bar)[XB_TMO])) break; if (_sp > XB_SPIN_CAP) { atomicAdd(&(bar)[XB_TMO], 1u); break; } } } } while (0)

struct XcdBarrier {
    unsigned* bar; unsigned x;
    volatile LAS unsigned* st;
};

__device__ __forceinline__ XcdBarrier xcd_barrier_post(unsigned* bar, volatile LAS unsigned* st) {
    XcdBarrier b; b.bar = bar; b.x = xb_xcc_id(); b.st = st;
    if (threadIdx.x == 0) (void)xb_add(&bar[XB_XCNT(b.x)], 1u);
    return b;
}
__device__ __forceinline__ void xcd_barrier_complete(unsigned* bar, unsigned x, unsigned& nloc, unsigned& nx) {
    const unsigned G = gridDim.x * gridDim.y * gridDim.z;
    unsigned sum, cnt, mine, sp = 0u;
    for (;;) {
        sum = 0u; cnt = 0u; mine = 0u;
#pragma unroll
        for (unsigned j = 0; j < 16; ++j) { const unsigned c = xb_ld(&bar[XB_XCNT(j)]); sum += c; cnt += (c > 0u) ? 1u : 0u; mine = (j == x) ? c : mine; }
        if (sum == G) break;
        __builtin_amdgcn_s_sleep(1);
        if ((++sp & 255u) == 0u) { if (xb_ld(&bar[XB_TMO])) break; if (sp > XB_SPIN_CAP) { atomicAdd(&bar[XB_TMO], 1u); break; } }
    }
    nloc = mine > 0u ? mine : 1u; nx = cnt > 0u ? cnt : 1u;
}

__device__ __forceinline__ void xcd_barrier(const XcdBarrier& b) {
    asm volatile("s_waitcnt vmcnt(0)" ::: "memory");
    __syncthreads();
    if (threadIdx.x == 0) {
        unsigned* bar = b.bar;
        __builtin_amdgcn_s_waitcnt(0);
        unsigned nloc = b.st[0], nx = b.st[1];
        if (nloc == 0u) { xcd_barrier_complete(bar, b.x, nloc, nx); b.st[0] = nloc; b.st[1] = nx; }
        const unsigned old = xb_add(&bar[XB_XSUB(b.x)], 1u);
        const unsigned gen = old / nloc;
        if (old + 1u == (gen + 1u) * nloc) {
            __builtin_amdgcn_fence(__ATOMIC_RELEASE, "agent");
            asm volatile("s_waitcnt vmcnt(0)" ::: "memory");
            const unsigned og = xb_add(&bar[XB_TOP], 1u);
            const unsigned tg = og / nx;
            if (og + 1u == (tg + 1u) * nx) xb_add(&bar[XB_TOPGEN], 1u);
            else XB_SPIN(xb_ld(&bar[XB_TOPGEN]) == tg, bar);
            __builtin_amdgcn_fence(__ATOMIC_ACQUIRE, "agent");
            xb_add(&bar[XB_XGEN(b.x)], 1u);
            asm volatile("s_waitcnt vmcnt(0)" ::: "memory");
        } else {
            XB_SPIN(xb_ld(&bar[XB_XGEN(b.x)]) == gen, bar);
            __builtin_amdgcn_fence(__ATOMIC_ACQUIRE, "agent");
            asm volatile("s_waitcnt vmcnt(0)" ::: "memory");
        }
    }
    __syncthreads();
}

__global__ void __launch_bounds__(NTHR, 2) fwd_kernel(Args a) {
    extern __shared__ __attribute__((aligned(16))) unsigned char lds_raw[];
    LAS unsigned char* lds = (LAS unsigned char*)lds_raw;
    const int tid = threadIdx.x, lane = tid & 63; const int wave = __builtin_amdgcn_readfirstlane(tid >> 6);
    const int G = gridDim.x, bx = blockIdx.x;
    const int gw = bx * NWAVES + wave, NGW = G * NWAVES;
    unsigned char* ws = a.ws;
    bf16* Win_t = (bf16*)(ws + WS_WIN); bf16* Wout_t = (bf16*)(ws + WS_WOUT); bf16* Wup_t = (bf16*)(ws + WS_WUP); bf16* Wdown_t = (bf16*)(ws + WS_WDOWN);
    bf16* HR = (bf16*)(ws + WS_HR); float* ROPE = (float*)(ws + WS_ROPE);
    bf16* XN = (bf16*)(ws + WS_XN); bf16* MO = (bf16*)(ws + WS_MO); bf16* YT = (bf16*)(ws + WS_YT); bf16* UVT = (bf16*)(ws + WS_UVT);
    bf16* QK = (bf16*)(ws + WS_QK); bf16* KT = (bf16*)(ws + WS_KT); bf16* VT = (bf16*)(ws + WS_VT); bf16* MIX = (bf16*)(ws + WS_MIX); bf16* HB = (bf16*)(ws + WS_H);
    const float* x = a.in[0];
    const int lo = a.ph_lo, hi_ph = a.ph_hi;
#if MK_COOP
    cg::grid_group grid = cg::this_grid();
    volatile LAS unsigned* bst = (volatile LAS unsigned*)(lds + 131072 + 64);
    if (tid < 4) bst[tid] = 0u;
    __syncthreads();
    XcdBarrier xbar = xcd_barrier_post((unsigned*)(ws + WS_CTL), bst);
#define SEAM(k) do { if (lo <= (k) && (k) + 1 < hi_ph) { if ((k) == 0) grid.sync(); else xcd_barrier(xbar); } } while (0)
#else
#define SEAM(k) do { } while (0)
#endif
#ifndef PHMASK
#define PHMASK 0x1ff
#endif
#define IN(k) (((PHMASK >> (k)) & 1) && lo <= (k) && (k) < hi_ph)

#ifndef DUP_P0
#define DUP_P0 1
#endif
    if (IN(0)) for (int rep0 = 0; rep0 < DUP_P0; ++rep0) {
        LAS float* scr = (LAS float*)(lds + wave * 16384);
        constexpr int I_IN = (DM / 64) * (NIN / 32), I_OUT = (DM / 64) * (DM / 32), I_UP = (DM / 64) * (DFF / 32), I_DN = (DFF / 64) * (DM / 32);
        for (int it = gw; it < I_IN + I_OUT + I_UP + I_DN; it += NGW) { int r = it;
            if (r < I_IN) { p0_transpose_item<true>(a.in[3], DM, NIN, Win_t, scr, r, lane); continue; } r -= I_IN;
            if (r < I_OUT) { p0_transpose_item<false>(a.in[20], DM, DM, Wout_t, scr, r, lane); continue; } r -= I_OUT;
            if (r < I_UP) { p0_transpose_item<false>(a.in[23], DM, DFF, Wup_t, scr, r, lane); continue; } r -= I_UP;
            p0_transpose_item<false>(a.in[24], DFF, DM, Wdown_t, scr, r, lane); }
        for (int m = gw; m < MTOK; m += NGW) rms_row_to_bf16(x + (size_t)m * DM, a.in[1], XN + (size_t)m * DM, lane);
        for (int i = bx * NTHR + tid; i < SEQ * 32; i += G * NTHR) { const int pos = i >> 5, k = i & 31;
            const float inv = exp2f(-(float)(2 * k) * (13.287712379549449f / 64.0f)); const float ang = (float)pos * inv;
            ROPE[2 * i] = cosf(ang); ROPE[2 * i + 1] = sinf(ang); }
        __syncthreads();
        for (int pg = bx; pg < SEQ / 16; pg += G) filter_item(lds, a, HR, pg, tid);
    }
    SEAM(0);
#ifndef DUP_P1
#define DUP_P1 1
#endif
    if (IN(1)) {
        { pg8::Gemm g{Win_t, XN, 2048, MTOK, DM}; pg8::StaticOrder S; S.init(2048, MTOK, G, bx);
          pg8::EpiUV E{UVT, VT};
          pg8::gemm_phase<pg8::EpiUV, pg8::StaticOrder, true, true>(lds, g, S, E); }
        { pg8::Gemm g{XN, Win_t + (size_t)2048 * DM, MTOK, 1024, DM}; pg8::StaticOrder S; S.init(MTOK, 1024, G, bx);
          pg8::EpiRope E{QK, KT, ROPE, QSCALE};
          pg8::gemm_phase<pg8::EpiRope, pg8::StaticOrder, true, true>(lds, g, S, E); }
    }
#if DUP_P1 == 2
    if (IN(1)) {
        { pg8::Gemm g{Win_t, XN, 2048, MTOK, DM}; pg8::StaticOrder S; S.init(2048, MTOK, G, bx);
          pg8::EpiUV E{UVT, VT};
          pg8::gemm_phase<pg8::EpiUV, pg8::StaticOrder, true, true>(lds, g, S, E); }
        { pg8::Gemm g{XN, Win_t + (size_t)2048 * DM, MTOK, 1024, DM}; pg8::StaticOrder S; S.init(MTOK, 1024, G, bx);
          pg8::EpiRope E{QK, KT, ROPE, QSCALE};
          pg8::gemm_phase<pg8::EpiRope, pg8::StaticOrder, true, true>(lds, g, S, E); }
    }
#endif
    SEAM(1);
    if (IN(2)) {
        float lam;
        { const float p1 = a.in[15][lane] * a.in[16][lane], p2 = a.in[17][lane] * a.in[18][lane];
          lam = expf(wave_sum(p1)) - expf(wave_sum(p2)) + 0.2f; }
#ifndef DUP_ATT
#define DUP_ATT 1
#endif
#ifndef DUP_HY
#define DUP_HY 1
#endif
#ifndef ATT_VAR
#define ATT_VAR 0
#endif
        for (int u = bx; u < 1024; u += G) { const int bh = (u & 7) + 8 * (u >> 8), qb = (u >> 3) & 31;
            att::unit<0>(lds, QK, KT, VT, MIX, a.in[19], lam, bh >> 2, bh & 3, qb); }
        if (DUP_ATT > 1)
        for (int u = bx; u < 1024; u += G) { const int bh = (u & 7) + 8 * (u >> 8), qb = (u >> 3) & 31;
            att::unit<ATT_VAR>(lds, QK, KT, VT, MO, a.in[19], lam, bh >> 2, bh & 3, qb); }
        for (int rep = 0; rep < DUP_HY; ++rep)
        for (int c = bx; c < HYW; c += G) hy::channel(lds, UVT, HR, a.in[4], a.in[5], YT, c);
    }
    SEAM(2);
#ifndef DUP_P3
#define DUP_P3 1
#endif
    if (IN(3)) for (int rep3 = 0; rep3 < DUP_P3; ++rep3) {
        LAS unsigned short* scr = (LAS unsigned short*)(lds + wave * 16384);
        for (int it = gw; it < 8 * (MTOK / 64); it += NGW) { const int ct = it & 7, mt = it >> 3; const int c0 = 64 * ct, m0 = 64 * mt;
#pragma unroll
            for (int i = 0; i < 8; ++i) { const int cc = 8 * i + (lane >> 3), mch = lane & 7; const u32x4 v = *(const u32x4*)(YT + (size_t)(c0 + cc) * MTOK + m0 + 8 * mch);
                LAS unsigned* d = (LAS unsigned*)(scr + cc * 66 + 8 * mch); d[0] = v.x; d[1] = v.y; d[2] = v.z; d[3] = v.w; }
            LDS_WAIT(); asm volatile("" ::: "memory");
#pragma unroll
            for (int i = 0; i < 8; ++i) { const int mm = 8 * i + (lane >> 3), cch = lane & 7; const LAS unsigned short* s = scr + (8 * cch) * 66 + mm;
                u32x4 o; o.x = (unsigned)s[0] | ((unsigned)s[66] << 16); o.y = (unsigned)s[2 * 66] | ((unsigned)s[3 * 66] << 16);
                o.z = (unsigned)s[4 * 66] | ((unsigned)s[5 * 66] << 16); o.w = (unsigned)s[6 * 66] | ((unsigned)s[7 * 66] << 16);
                *(u32x4*)(MIX + (size_t)(m0 + mm) * 1024 + c0 + 8 * cch) = o; }
            LDS_WAIT(); asm volatile("" ::: "memory"); }
        __syncthreads();
    }
    SEAM(3);
    if (IN(4)) {
        pg8::Gemm g{MIX, Wout_t, MTOK, DM, DM}; pg8::StaticOrder S; S.init(MTOK, DM, G, bx);
        float* ssb = (float*)(ws + WS_CTL + CTL_SS); unsigned* cntb = (unsigned*)(ws + WS_CTL + CTL_CNT);
        pg8::EpiNormResNorm E{x, a.out, XN, a.in[2], a.in[21], ssb, ssb + MTOK, cntb, cntb + 128, NORM_EPS};
        pg8::gemm_phase<pg8::EpiNormResNorm, pg8::StaticOrder, true, true>(lds, g, S, E);
    }
    SEAM(4);
#ifndef DUP_P6
#define DUP_P6 1
#endif
    if (IN(6)) for (int rep6 = 0; rep6 < DUP_P6; ++rep6) {
        pg8::Gemm g{XN, Wup_t, MTOK, DFF, DM}; pg8::StaticOrder S; S.init(MTOK, DFF, G, bx);
        pg8::EpiBf16<1> E{HB, DFF};
        pg8::gemm_phase<pg8::EpiBf16<1>, pg8::StaticOrder, true, true>(lds, g, S, E);
    }
    SEAM(6);
    if (IN(7)) {
        pg8::Gemm g{HB, Wdown_t, MTOK, DM, DFF}; pg8::StaticOrder S; S.init(MTOK, DM, G, bx);
        float* ssb = (float*)(ws + WS_CTL + CTL_SS); unsigned* cntb = (unsigned*)(ws + WS_CTL + CTL_CNT);
        pg8::EpiNormRes E{a.out, a.in[22], ssb + 2 * MTOK, cntb + 256, NORM_EPS};
        pg8::gemm_phase<pg8::EpiNormRes, pg8::StaticOrder, true, true>(lds, g, S, E);
    }
#undef IN
#undef SEAM
}

constexpr int NPHASE = 9;
extern "C" void kernel_launch(void* const* d_in, const int* in_sizes, int n_in, void* d_out, int out_size, void* d_ws, size_t ws_size, hipStream_t stream) {
    static int grid = 0;
    if (grid == 0) {
        if (n_in != 25 || in_sizes[0] != MTOK * DM || out_size != MTOK * DM || ws_size < WS_END) {
            fprintf(stderr, "kernel_launch: unexpected shapes (n_in %d in0 %d out %d ws %zu)\n", n_in, n_in > 0 ? in_sizes[0] : -1, out_size, ws_size); grid = -1; return; }
        int dev = 0, cus = 0, per_cu = 0;
        hipGetDevice(&dev); hipDeviceGetAttribute(&cus, hipDeviceAttributeMultiprocessorCount, dev);
        hipFuncSetAttribute((const void*)fwd_kernel, hipFuncAttributeMaxDynamicSharedMemorySize, LDS_BYTES);
        hipOccupancyMaxActiveBlocksPerMultiprocessor(&per_cu, (const void*)fwd_kernel, NTHR, LDS_BYTES);
        if (per_cu < 1) { fprintf(stderr, "kernel_launch: occupancy query says %d blocks/CU\n", per_cu); per_cu = 1; }
        (void)hipGetLastError();
        grid = cus * 1;
    }
    if (grid < 0) return;
    Args a{};
    for (int i = 0; i < 25; ++i) a.in[i] = (const float*)d_in[i];
    a.out = (float*)d_out; a.ws = (unsigned char*)d_ws;
#if MK_COOP
    a.ph_lo = 0; a.ph_hi = NPHASE;
    if (hipMemsetAsync((unsigned char*)d_ws + WS_CTL, 0, CTL_BYTES, stream) != hipSuccess) { fprintf(stderr, "kernel_launch: memset of the barrier words failed\n"); return; }
    void* args[] = {&a};
    hipError_t e = hipLaunchCooperativeKernel((const void*)fwd_kernel, dim3(grid), dim3(NTHR), args, LDS_BYTES, stream);
    if (e != hipSuccess) fprintf(stderr, "cooperative launch failed: %s (grid %d)\n", hipGetErrorString(e), grid);
#else
    for (int p = 0; p < NPHASE; ++p) { a.ph_lo = p; a.ph_hi = p + 1; hipLaunchKernelGGL(fwd_kernel, dim3(grid), dim3(NTHR), LDS_BYTES, stream, a); }
#endif
}
```

```cpp
#include <hip/hip_runtime.h>
#include <hip/hip_cooperative_groups.h>
#include <cstdio>
#include <cstdint>
#include <cmath>
namespace cg = cooperative_groups;
#ifndef MK_COOP
#define MK_COOP 1
#endif
namespace pg8 {
#define PG8_LAS __attribute__((address_space(3)))
typedef unsigned short bf16_t;
typedef short bf16x8 __attribute__((ext_vector_type(8)));
typedef float f32x4 __attribute__((ext_vector_type(4)));
typedef unsigned u32x4 __attribute__((ext_vector_type(4)));
constexpr int BM = 256, BK = 64, HALF = 128, HTB = HALF * BK * 2  , STAGE_BYTES = 8 * HTB, NXCD = 8, WGM = 8;

__host__ __device__ __forceinline__ int lds_byte(int r, int c) { const int st = (r >> 4) * 2 + (c >> 5), rr = r & 15, cc = c & 31, ob = rr * 64 + cc * 2; return st * 1024 + (ob ^ (((ob >> 9) & 1) << 5)); }
__host__ __device__ __forceinline__ void stage_rc(int b, int& R, int& C) { const int st = b / 1024, sb = b % 1024, swz = sb ^ (((sb >> 9) & 1) << 5); R = (st >> 1) * 16 + swz / 64; C = (st & 1) * 32 + (swz % 64) / 2; }
__host__ __device__ __forceinline__ int perm32(int rho) { const int n = rho >> 4, i = rho & 15; return 8 * (i >> 2) + 4 * n + (i & 3); }

struct Unit { int pm, pn; };
struct Gemm { const bf16_t* A; const bf16_t* Bt; int M, N, K; };

struct StaticOrder {
    int nM, nN, nwg, G, c;
    __host__ __device__ void init(int M, int N, int G_, int c_) { nM = M / BM; nN = N / BM; nwg = nM * nN; G = G_; c = c_; }
    __host__ __device__ bool next(int i, Unit& u) const {
        const long L = (long)i * G + c; if (L >= nwg) return false;
        int wgid = (int)L; { const int q = nwg / NXCD, r = nwg % NXCD, xcd = wgid % NXCD, off = wgid / NXCD; wgid = (xcd < r ? xcd * (q + 1) : r * (q + 1) + (xcd - r) * q) + off; }
        const int nig = WGM * nN, gid = wgid / nig, fm = gid * WGM, gsz = (nM - fm) < WGM ? (nM - fm) : WGM;
        u.pm = fm + ((wgid % nig) % gsz); u.pn = (wgid % nig) / gsz; return true;
    }
    __device__ __forceinline__ void a_ready(const Unit&) const {}
    __device__ __forceinline__ void done(const Unit&) const {}
};

__device__ __forceinline__ unsigned cvt_pk_bf16(float lo, float hi) { unsigned r; asm volatile("v_cvt_pk_bf16_f32 %0, %1, %2" : "=v"(r) : "v"(lo), "v"(hi)); return r; }
typedef float f32x2 __attribute__((ext_vector_type(2)));
typedef float f32x2 __attribute__((ext_vector_type(2)));
typedef unsigned u32x2 __attribute__((ext_vector_type(2)));
template <int ACT> struct EpiBf16 {
    static constexpr bool PERM = true, AFTER_DRAIN = false;
    bf16_t* O; int ldc;
    __device__ __forceinline__ void operator()(const f32x4 (&acc)[2][2][4][2], const Unit& u, int wr, int wc, int fr, int fq) const {
        const int row0 = u.pm * BM + wr * 64 + fr; const int col0 = u.pn * BM + wc * 32 + 8 * fq;
#pragma unroll
        for (int ai = 0; ai < 2; ++ai)
#pragma unroll
            for (int m = 0; m < 4; ++m) { bf16_t* rowp = O + (size_t)(row0 + ai * HALF + m * 16) * ldc + col0;
#pragma unroll
                for (int bj = 0; bj < 2; ++bj) { f32x4 v0 = acc[ai][bj][m][0], v1 = acc[ai][bj][m][1];
                    if (ACT == 1) {
#pragma unroll
                        for (int j = 0; j < 4; ++j) { float a = v0[j] > 0.f ? v0[j] : 0.f; v0[j] = a * a; float b = v1[j] > 0.f ? v1[j] : 0.f; v1[j] = b * b; } }
                    u32x4 w; w.x = cvt_pk_bf16(v0[0], v0[1]); w.y = cvt_pk_bf16(v0[2], v0[3]); w.z = cvt_pk_bf16(v1[0], v1[1]); w.w = cvt_pk_bf16(v1[2], v1[3]);
                    *(u32x4*)(rowp + bj * HALF) = w; } }
    }
};
struct EpiRope {
    static constexpr bool PERM = true, AFTER_DRAIN = false;
    bf16_t* Q; bf16_t* KT; const float* rope; float qscale;
    __device__ __forceinline__ void operator()(const f32x4 (&acc)[2][2][4][2], const Unit& u, int wr, int wc, int fr, int fq) const {
        const int row0 = u.pm * BM + wr * 64 + fr; const int col0 = u.pn * BM + wc * 32 + 8 * fq;
        const int g = (wc & 1) * 4 + fq;
        const float sc = (u.pn < 2) ? qscale : 1.0f;
#pragma unroll
        for (int ai = 0; ai < 2; ++ai)
#pragma unroll
            for (int m = 0; m < 4; ++m) { const int row = row0 + ai * HALF + m * 16; const int pos = row & 4095;
                const f32x4 cs0 = *(const f32x4*)(rope + (size_t)pos * 64 + 8 * g), cs1 = *(const f32x4*)(rope + (size_t)pos * 64 + 8 * g + 4);
                const float c[4] = {cs0[0], cs0[2], cs1[0], cs1[2]}, s[4] = {cs0[1], cs0[3], cs1[1], cs1[3]};
                bf16_t* rowp;
                if (u.pn < 2) rowp = Q + (size_t)row * 512 + col0;
                else { const int ck = col0 - 512, hh = ck >> 7, cc = ck & 127; rowp = KT + ((size_t)(((row >> 12) * 4 + hh) * 64 + (pos >> 6)) * 8192 + (pos & 63) * 128 + cc); }
#pragma unroll
                for (int bj = 0; bj < 2; ++bj) { const f32x4 lo = acc[ai][bj][m][0], hi = acc[ai][bj][m][1]; float ol[4], oh[4];
#pragma unroll
                    for (int j = 0; j < 4; ++j) { ol[j] = (lo[j] * c[j] - hi[j] * s[j]) * sc; oh[j] = (hi[j] * c[j] + lo[j] * s[j]) * sc; }
                    u32x4 w; w.x = cvt_pk_bf16(ol[0], ol[1]); w.y = cvt_pk_bf16(ol[2], ol[3]); w.z = cvt_pk_bf16(oh[0], oh[1]); w.w = cvt_pk_bf16(oh[2], oh[3]);
                    *(u32x4*)(rowp + ((u.pn < 2) ? bj * HALF : bj * (64 * 8192))) = w; } }
    }
};
struct EpiUV {
    static constexpr bool PERM = true, AFTER_DRAIN = false;
    bf16_t* UT; bf16_t* VT;
    __device__ __forceinline__ void operator()(const f32x4 (&acc)[2][2][4][2], const Unit& u, int wr, int wc, int fr, int fq) const {
        const int row0 = u.pm * BM + wr * 64 + fr; const int col0 = u.pn * BM + wc * 32 + 8 * fq;
#pragma unroll
        for (int ai = 0; ai < 2; ++ai)
#pragma unroll
            for (int m = 0; m < 4; ++m) { const int row = row0 + ai * HALF + m * 16;
#pragma unroll
                for (int bj = 0; bj < 2; ++bj) { const int col = col0 + bj * HALF; bf16_t* p;
                    if (u.pm < 6) p = UT + (size_t)row * 32768 + col;
                    else { const int ev = row - 1536, hh = ev >> 7, ee = ev & 127, bb = col >> 12, pos = col & 4095;
                        p = VT + ((size_t)((bb * 4 + hh) * 64 + (pos >> 6)) * 8192 + ee * 64 + (pos & 48) + ((pos & 8) >> 1)); }
                    const f32x4 v0 = acc[ai][bj][m][0], v1 = acc[ai][bj][m][1];
                    u32x4 w; w.x = cvt_pk_bf16(v0[0], v0[1]); w.y = cvt_pk_bf16(v0[2], v0[3]); w.z = cvt_pk_bf16(v1[0], v1[1]); w.w = cvt_pk_bf16(v1[2], v1[3]);
                    if (u.pm < 6) *(u32x4*)p = w;
                    else { *(u32x2*)p = (u32x2){w.x, w.y}; *(u32x2*)(p + 8) = (u32x2){w.z, w.w}; } } }
    }
};

__device__ __forceinline__ void panel_sumsq(const f32x4 (&acc)[2][2][4][2], float* ss, unsigned* cnt, const Unit& u, int wr, int fr, int fq, int lane) {
#pragma unroll
    for (int ai = 0; ai < 2; ++ai)
#pragma unroll
        for (int m = 0; m < 4; ++m) { float s = 0.f;
#pragma unroll
            for (int bj = 0; bj < 2; ++bj)
#pragma unroll
                for (int n = 0; n < 2; ++n) { const f32x4 x = acc[ai][bj][m][n]; s += (x[0] * x[0] + x[1] * x[1]) + (x[2] * x[2] + x[3] * x[3]); }
            s += __shfl_xor(s, 16); s += __shfl_xor(s, 32);
            if (fq == 0) __hip_atomic_fetch_add(ss + u.pm * BM + ai * HALF + wr * 64 + m * 16 + fr, s, __ATOMIC_RELAXED, __HIP_MEMORY_SCOPE_AGENT); }
    asm volatile("s_waitcnt vmcnt(0)" ::: "memory");
    __syncthreads();
    if (threadIdx.x == 0) { __hip_atomic_fetch_add(cnt + u.pm, 1u, __ATOMIC_RELAXED, __HIP_MEMORY_SCOPE_AGENT);
        unsigned spins = 0;
        while (__hip_atomic_load(cnt + u.pm, __ATOMIC_RELAXED, __HIP_MEMORY_SCOPE_AGENT) < 4u) { __builtin_amdgcn_s_sleep(8); if (++spins > (1u << 20)) break; } }
    __syncthreads();
}
struct EpiNormRes {
    static constexpr bool PERM = true, AFTER_DRAIN = false;
    float* out; const float* gain; float* ss; unsigned* cnt; float eps;
    __device__ __forceinline__ void operator()(f32x4 (&acc)[2][2][4][2], const Unit& u, int wr, int wc, int fr, int fq) const {
        const int lane = fq * 16 + fr;
        panel_sumsq(acc, ss, cnt, u, wr, fr, fq, lane);
        const int row0 = u.pm * BM + wr * 64 + fr; const int col0 = u.pn * BM + wc * 32 + 8 * fq;
        f32x4 g[2][2];
#pragma unroll
        for (int bj = 0; bj < 2; ++bj) { g[bj][0] = *(const f32x4*)(gain + col0 + bj * HALF); g[bj][1] = *(const f32x4*)(gain + col0 + bj * HALF + 4); }
#pragma unroll
        for (int ai = 0; ai < 2; ++ai)
#pragma unroll
            for (int m = 0; m < 4; ++m) { const int row = row0 + ai * HALF + m * 16;
                const float r = 1.0f / sqrtf(__hip_atomic_load(ss + row, __ATOMIC_RELAXED, __HIP_MEMORY_SCOPE_AGENT) * (1.0f / 1024.0f) + eps);
                float* rowp = out + (size_t)row * 1024 + col0;
#pragma unroll
                for (int bj = 0; bj < 2; ++bj) { const f32x4 b0 = *(const f32x4*)(rowp + bj * HALF), b1 = *(const f32x4*)(rowp + bj * HALF + 4);
                    *(f32x4*)(rowp + bj * HALF) = b0 + acc[ai][bj][m][0] * r * g[bj][0]; *(f32x4*)(rowp + bj * HALF + 4) = b1 + acc[ai][bj][m][1] * r * g[bj][1]; } }
    }
};
struct EpiNormResNorm {
    static constexpr bool PERM = true, AFTER_DRAIN = false;
    const float* base; float* out; bf16_t* xn; const float* g1; const float* g2; float* ss1; float* ss2; unsigned* cnt1; unsigned* cnt2; float eps;
    __device__ __forceinline__ void operator()(f32x4 (&acc)[2][2][4][2], const Unit& u, int wr, int wc, int fr, int fq) const {
        const int lane = fq * 16 + fr;
        panel_sumsq(acc, ss1, cnt1, u, wr, fr, fq, lane);
        const int row0 = u.pm * BM + wr * 64 + fr; const int col0 = u.pn * BM + wc * 32 + 8 * fq;
        { f32x4 g[2][2];
#pragma unroll
          for (int bj = 0; bj < 2; ++bj) { g[bj][0] = *(const f32x4*)(g1 + col0 + bj * HALF); g[bj][1] = *(const f32x4*)(g1 + col0 + bj * HALF + 4); }
#pragma unroll
          for (int ai = 0; ai < 2; ++ai)
#pragma unroll
            for (int m = 0; m < 4; ++m) { const int row = row0 + ai * HALF + m * 16;
                const float r = 1.0f / sqrtf(__hip_atomic_load(ss1 + row, __ATOMIC_RELAXED, __HIP_MEMORY_SCOPE_AGENT) * (1.0f / 1024.0f) + eps);
                const float* bp = base + (size_t)row * 1024 + col0; float* rowp = out + (size_t)row * 1024 + col0;
#pragma unroll
                for (int bj = 0; bj < 2; ++bj) { const f32x4 b0 = *(const f32x4*)(bp + bj * HALF), b1 = *(const f32x4*)(bp + bj * HALF + 4);
                    const f32x4 x0 = b0 + acc[ai][bj][m][0] * r * g[bj][0], x1 = b1 + acc[ai][bj][m][1] * r * g[bj][1];
                    acc[ai][bj][m][0] = x0; acc[ai][bj][m][1] = x1;
                    *(f32x4*)(rowp + bj * HALF) = x0; *(f32x4*)(rowp + bj * HALF + 4) = x1; } } }
        panel_sumsq(acc, ss2, cnt2, u, wr, fr, fq, lane);
        { f32x4 g[2][2];
#pragma unroll
          for (int bj = 0; bj < 2; ++bj) { g[bj][0] = *(const f32x4*)(g2 + col0 + bj * HALF); g[bj][1] = *(const f32x4*)(g2 + col0 + bj * HALF + 4); }
#pragma unroll
          for (int ai = 0; ai < 2; ++ai)
#pragma unroll
            for (int m = 0; m < 4; ++m) { const int row = row0 + ai * HALF + m * 16;
                const float r = 1.0f / sqrtf(__hip_atomic_load(ss2 + row, __ATOMIC_RELAXED, __HIP_MEMORY_SCOPE_AGENT) * (1.0f / 1024.0f) + eps);
                bf16_t* xp = xn + (size_t)row * 1024 + col0;
#pragma unroll
                for (int bj = 0; bj < 2; ++bj) { const f32x4 v0 = acc[ai][bj][m][0] * r * g[bj][0], v1 = acc[ai][bj][m][1] * r * g[bj][1];
                    u32x4 w; w.x = cvt_pk_bf16(v0[0], v0[1]); w.y = cvt_pk_bf16(v0[2], v0[3]); w.z = cvt_pk_bf16(v1[0], v1[1]); w.w = cvt_pk_bf16(v1[2], v1[3]);
                    *(u32x4*)(xp + bj * HALF) = w; } } }
    }
};
template <class Epi, class Sched, bool ALIGN_EPI = false, bool SP2 = false>
__device__ __forceinline__ void gemm_phase(PG8_LAS unsigned char* lds, const Gemm g, const Sched& S, const Epi& E) {
    const int tid = threadIdx.x, wid = __builtin_amdgcn_readfirstlane(tid >> 6), lane = tid & 63, wr = wid >> 2, wc = wid & 3, fr = lane & 15, fq = lane >> 4;
    const int K = g.K, nt = K / BK;
    unsigned voffA[2], voffB[2];
#pragma unroll
    for (int i = 0; i < 2; ++i) { int R, C; stage_rc(tid * 16 + i * 8192, R, C); const int Rb = Epi::PERM ? ((R & ~31) + perm32(R & 31)) : R;
        voffA[i] = (unsigned)(R * K + C) * 2u; voffB[i] = (unsigned)(Rb * K + C) * 2u; }
    const size_t kstep = (size_t)(BK * 2);
    const size_t hstep = (size_t)HALF * K * 2;
    const size_t tstep = 2 * hstep;
    const unsigned ldsw = (unsigned)wid * 1024u;
    const int aoff = lds_byte(wr * 64 + fr, fq * 8), boff = lds_byte(wc * 32 + fr, fq * 8);
#define PG8_SA(b, h) (((b) * 2 + (h)) * HTB)
#define PG8_SB(b, h) ((4 + (b) * 2 + (h)) * HTB)
#define PG8_STAGE(bufoff, gbase, voff) do { _Pragma("unroll") for (int _i = 0; _i < 2; ++_i) \
        __builtin_amdgcn_global_load_lds((const unsigned*)((const char*)(gbase) + (voff)[_i]), (PG8_LAS unsigned*)(lds + (bufoff) + ldsw + _i * 8192), 16, 0, 0); } while (0)
#define PG8_LDA(dst, b, h) do { _Pragma("unroll") for (int m = 0; m < 4; ++m) _Pragma("unroll") for (int k = 0; k < 2; ++k) dst[m][k] = *(const PG8_LAS bf16x8*)(lds + PG8_SA(b, h) + aoff + m * 2048 + k * 1024); } while (0)
#define PG8_LDB(dst, b, h) do { _Pragma("unroll") for (int n = 0; n < 2; ++n) _Pragma("unroll") for (int k = 0; k < 2; ++k) dst[n][k] = *(const PG8_LAS bf16x8*)(lds + PG8_SB(b, h) + boff + n * 2048 + k * 1024); } while (0)
#define PG8_MMA(ai, bj, At, Bt) do { __builtin_amdgcn_s_setprio(1); _Pragma("unroll") for (int m = 0; m < 4; ++m) _Pragma("unroll") for (int n = 0; n < 2; ++n) _Pragma("unroll") for (int k = 0; k < 2; ++k) \
        acc[ai][bj][m][n] = __builtin_amdgcn_mfma_f32_16x16x32_bf16(Bt[n][k], At[m][k], acc[ai][bj][m][n], 0, 0, 0); __builtin_amdgcn_s_setprio(0); } while (0)
#define PG8_WAIT_V(n) asm volatile("s_waitcnt vmcnt(" #n ")" ::: "memory")
#define PG8_WAIT_L(n) asm volatile("s_waitcnt lgkmcnt(" #n ")" ::: "memory")
#define PG8_BAR __builtin_amdgcn_s_barrier()
#define PG8_SCHED __builtin_amdgcn_sched_barrier(0)
    Unit cur, nxt; int ui = 0;
    if (!S.next(0, cur)) return;
    f32x4 acc[2][2][4][2];
#pragma unroll
    for (int a = 0; a < 2; ++a)
#pragma unroll
        for (int b = 0; b < 2; ++b)
#pragma unroll
            for (int m = 0; m < 4; ++m)
#pragma unroll
                for (int n = 0; n < 2; ++n) acc[a][b][m][n] = (f32x4){0.f, 0.f, 0.f, 0.f};
    bf16x8 At[4][2], B0[2][2], B1[2][2];
    const char* cA = (const char*)g.A + (size_t)cur.pm * tstep; const char* cB = (const char*)g.Bt + (size_t)cur.pn * tstep;
    S.a_ready(cur);
    if constexpr (SP2) {
        PG8_STAGE(PG8_SB(0, 0), cB, voffB); PG8_STAGE(PG8_SB(0, 1), cB + hstep, voffB); PG8_STAGE(PG8_SA(0, 0), cA, voffA); PG8_STAGE(PG8_SA(0, 1), cA + hstep, voffA);
        if (wr == 1) PG8_BAR;
        PG8_WAIT_V(2); PG8_BAR;
        PG8_STAGE(PG8_SB(1, 0), cB + kstep, voffB); PG8_STAGE(PG8_SA(1, 0), cA + kstep, voffA); PG8_STAGE(PG8_SB(1, 1), cB + hstep + kstep, voffB);
        PG8_WAIT_V(6); PG8_BAR;
    } else {
        PG8_STAGE(PG8_SB(0, 0), cB, voffB); PG8_STAGE(PG8_SA(0, 0), cA, voffA); PG8_STAGE(PG8_SB(0, 1), cB + hstep, voffB); PG8_STAGE(PG8_SA(0, 1), cA + hstep, voffA);
        if (wr == 1) PG8_BAR;
        PG8_WAIT_V(4); PG8_BAR;
        PG8_STAGE(PG8_SB(1, 0), cB + kstep, voffB); PG8_STAGE(PG8_SA(1, 0), cA + kstep, voffA); PG8_STAGE(PG8_SB(1, 1), cB + hstep + kstep, voffB);
        PG8_WAIT_V(6); PG8_BAR;
    }
    for (;;) {
        const bool has_next = S.next(ui + 1, nxt);
        const char* nA = has_next ? (const char*)g.A + (size_t)nxt.pm * tstep : cA; const char* nB = has_next ? (const char*)g.Bt + (size_t)nxt.pn * tstep : cB;
        for (int t = 0; t < nt; t += 2) {
            const bool last = (t == nt - 2);
            const char* a1 = cA + (size_t)(t + 1) * kstep;
            const char* a2 = last ? nA : cA + (size_t)(t + 2) * kstep; const char* b2 = last ? nB : cB + (size_t)(t + 2) * kstep;
            const char* a3 = a2 + kstep; const char* b3 = b2 + kstep;
            if (last && has_next) S.a_ready(nxt);
            if constexpr (SP2) {
            PG8_LDB(B0, 0, 0); PG8_LDB(B1, 0, 1); PG8_SCHED; PG8_LDA(At, 0, 0); PG8_STAGE(PG8_SA(1, 1), a1 + hstep, voffA);
            PG8_WAIT_V(8); PG8_WAIT_L(0); PG8_BAR; PG8_MMA(0, 0, At, B0); PG8_MMA(0, 1, At, B1); PG8_BAR; PG8_SCHED;
            PG8_LDA(At, 0, 1); PG8_STAGE(PG8_SB(0, 0), b2, voffB); PG8_STAGE(PG8_SB(0, 1), b2 + hstep, voffB); PG8_STAGE(PG8_SA(0, 0), a2, voffA);
            PG8_WAIT_V(8); PG8_WAIT_L(0); PG8_BAR; PG8_MMA(1, 0, At, B0); PG8_MMA(1, 1, At, B1); PG8_BAR; PG8_SCHED;
            PG8_LDB(B0, 1, 0); PG8_LDB(B1, 1, 1); PG8_SCHED; PG8_LDA(At, 1, 0); PG8_STAGE(PG8_SA(0, 1), a2 + hstep, voffA);
            PG8_WAIT_V(8); PG8_WAIT_L(0); PG8_BAR; PG8_MMA(0, 0, At, B0); PG8_MMA(0, 1, At, B1); PG8_BAR; PG8_SCHED;
            PG8_LDA(At, 1, 1); PG8_STAGE(PG8_SB(1, 0), b3, voffB); PG8_STAGE(PG8_SB(1, 1), b3 + hstep, voffB); PG8_STAGE(PG8_SA(1, 0), a3, voffA);
            PG8_WAIT_V(8); PG8_WAIT_L(0); PG8_BAR; PG8_MMA(1, 0, At, B0); PG8_MMA(1, 1, At, B1); PG8_BAR; PG8_SCHED;
            } else {
            PG8_LDB(B0, 0, 0); PG8_SCHED; PG8_LDA(At, 0, 0); PG8_STAGE(PG8_SA(1, 1), a1 + hstep, voffA);
            PG8_WAIT_L(8); PG8_BAR; PG8_WAIT_L(0); PG8_MMA(0, 0, At, B0); PG8_BAR; PG8_SCHED;
            PG8_LDB(B1, 0, 1); PG8_STAGE(PG8_SB(0, 0), b2, voffB);
            PG8_BAR; PG8_WAIT_L(0); PG8_MMA(0, 1, At, B1); PG8_BAR;
            PG8_LDA(At, 0, 1); PG8_STAGE(PG8_SA(0, 0), a2, voffA);
            PG8_BAR; PG8_WAIT_L(0); PG8_MMA(1, 0, At, B0); PG8_BAR; PG8_SCHED;
            PG8_STAGE(PG8_SB(0, 1), b2 + hstep, voffB);
            PG8_WAIT_V(6); PG8_BAR; PG8_MMA(1, 1, At, B1); PG8_BAR;
            PG8_LDB(B0, 1, 0); PG8_SCHED; PG8_LDA(At, 1, 0); PG8_STAGE(PG8_SA(0, 1), a2 + hstep, voffA);
            PG8_WAIT_L(8); PG8_BAR; PG8_WAIT_L(0); PG8_MMA(0, 0, At, B0); PG8_BAR; PG8_SCHED;
            PG8_LDB(B1, 1, 1); PG8_STAGE(PG8_SB(1, 0), b3, voffB);
            PG8_BAR; PG8_WAIT_L(0); PG8_MMA(0, 1, At, B1); PG8_BAR;
            PG8_LDA(At, 1, 1); PG8_STAGE(PG8_SA(1, 0), a3, voffA);
            PG8_BAR; PG8_WAIT_L(0); PG8_MMA(1, 0, At, B0); PG8_BAR; PG8_SCHED;
            PG8_STAGE(PG8_SB(1, 1), b3 + hstep, voffB);
            PG8_WAIT_V(6); PG8_BAR; PG8_MMA(1, 1, At, B1); PG8_BAR;
            }
        }
        if constexpr (ALIGN_EPI) { if (wr == 0) PG8_BAR; }
        if constexpr (!Epi::AFTER_DRAIN) { E(acc, cur, wr, wc, fr, fq); S.done(cur); }
        if (!has_next) break;
#pragma unroll
        for (int a = 0; a < 2; ++a)
#pragma unroll
            for (int b = 0; b < 2; ++b)
#pragma unroll
                for (int m = 0; m < 4; ++m)
#pragma unroll
                    for (int n = 0; n < 2; ++n) acc[a][b][m][n] = (f32x4){0.f, 0.f, 0.f, 0.f};
        cur = nxt; cA = nA; cB = nB; ++ui;
        if constexpr (ALIGN_EPI) { if (wr == 1) PG8_BAR; }
    }
    PG8_WAIT_V(0);
    if constexpr (!ALIGN_EPI) { if (wr == 0) PG8_BAR; }
    PG8_BAR;
    if constexpr (Epi::AFTER_DRAIN) { E.fused(acc, cur, wr, wc, fr, fq, lds, wid, lane); S.done(cur); }
#undef PG8_SA
#undef PG8_SB
#undef PG8_STAGE
#undef PG8_LDA
#undef PG8_LDB
#undef PG8_MMA
#undef PG8_WAIT_V
#undef PG8_WAIT_L
#undef PG8_BAR
#undef PG8_SCHED
}
}

constexpr int BATCH = 8, SEQ = 4096, DM = 1024, MTOK = BATCH * SEQ, HYW = 512, NIN = 3072, DFF = 4096;
constexpr int NWAVES = 8, NTHR = 512;
constexpr float NORM_EPS = 1e-6f, SUBLN_EPS = 1e-5f;
constexpr float QSCALE = 0.125f * 1.4426950408889634f;
constexpr int HRLEN = 8224;
constexpr size_t MiB = 1u << 20;
constexpr size_t WS_WIN = 0, WS_WOUT = 6 * MiB, WS_WUP = 8 * MiB, WS_WDOWN = 16 * MiB;
constexpr size_t WS_HR = 24 * MiB;
constexpr size_t WS_ROPE = 33 * MiB;
constexpr size_t WS_CTL = 34 * MiB, CTL_BYTES = 16384 + 3 * 131072;
constexpr size_t CTL_CNT = 14336, CTL_SS = 16384;
constexpr size_t WS_XN = 40 * MiB;
constexpr size_t WS_MO = 104 * MiB;
constexpr size_t WS_YT = 168 * MiB;
constexpr size_t WS_UVT = 200 * MiB;
constexpr size_t WS_QK = 328 * MiB;
constexpr size_t WS_KT = 360 * MiB;
constexpr size_t WS_VT = 296 * MiB;
constexpr size_t WS_MIX = 392 * MiB;
constexpr size_t WS_H = 200 * MiB;
constexpr size_t WS_END = 456 * MiB;
constexpr int LDS_BYTES = 135168;

#define LAS __attribute__((address_space(3)))
typedef unsigned short bf16;
typedef unsigned u32x4 __attribute__((ext_vector_type(4)));
typedef unsigned u32x2 __attribute__((ext_vector_type(2)));
typedef float f32x4 __attribute__((ext_vector_type(4)));
typedef float f32x16 __attribute__((ext_vector_type(16)));
typedef short bf16x8 __attribute__((ext_vector_type(8)));
typedef short s16x4 __attribute__((ext_vector_type(4)));

__device__ __forceinline__ unsigned f2bf(float f) { unsigned u = __builtin_bit_cast(unsigned, f); return (u + 0x7fffu + ((u >> 16) & 1u)) >> 16; }
__device__ __forceinline__ unsigned pk2(float lo, float hi) { return f2bf(lo) | (f2bf(hi) << 16); }
typedef float f32x2_t __attribute__((ext_vector_type(2))); typedef __bf16 bf16x2_t __attribute__((ext_vector_type(2)));
__device__ __forceinline__ unsigned cvtpk(float lo, float hi) { f32x2_t v = {lo, hi}; bf16x2_t b = __builtin_convertvector(v, bf16x2_t); return __builtin_bit_cast(unsigned, b); }
__device__ __forceinline__ float bf2f(unsigned short b) { return __builtin_bit_cast(float, (unsigned)b << 16); }
__device__ __forceinline__ float bflo(unsigned w) { return __builtin_bit_cast(float, w << 16); }
__device__ __forceinline__ float bfhi(unsigned w) { return __builtin_bit_cast(float, w & 0xffff0000u); }
__device__ __forceinline__ float wave_sum(float v) {
#pragma unroll
    for (int o = 1; o < 64; o <<= 1) v += __shfl_xor(v, o);
    return v;
}
__device__ __forceinline__ float swap_hi(float v) { return __shfl_xor(v, 32); }
#define LDS_WAIT() asm volatile("s_waitcnt lgkmcnt(0)" ::: "memory")

struct Args { const float* in[25]; float* out; unsigned char* ws; int ph_lo, ph_hi; };

__device__ __forceinline__ int win_src(int n) {
    if (n < 1536) return n;
    if (n < 2048) return n + 1024;
    const int pp = n - 2048, grp = pp >> 6, p = pp & 63, g = p >> 3, e = p & 7;
    const int d = (e < 4) ? (4 * g + e) : (32 + 4 * g + (e - 4));
    return 1536 + grp * 64 + d;
}
template <bool PERMW>
__device__ __forceinline__ void p0_transpose_item(const float* W, int K, int N, bf16* WT, LAS float* scr, int item, int lane) {
    const int nblk = N / 32, kb = item / nblk, nb = item % nblk, k0 = 64 * kb, n0 = 32 * nb;
    const int sc = PERMW ? win_src(n0 + (lane & 31)) : (n0 + (lane & 31));
#pragma unroll 8
    for (int i = 0; i < 32; ++i) { const int kk = 2 * i + (lane >> 5); scr[kk * 33 + (lane & 31)] = W[(size_t)(k0 + kk) * N + sc]; }
    LDS_WAIT(); asm volatile("" ::: "memory");
    const int c = lane & 7;
#pragma unroll
    for (int j = 0; j < 4; ++j) { const int n = (lane >> 3) + 8 * j; const LAS float* s = scr + (8 * c) * 33 + n;
        u32x4 o; o.x = pk2(s[0 * 33], s[1 * 33]); o.y = pk2(s[2 * 33], s[3 * 33]); o.z = pk2(s[4 * 33], s[5 * 33]); o.w = pk2(s[6 * 33], s[7 * 33]);
        *(u32x4*)(WT + (size_t)(n0 + n) * K + k0 + 8 * c) = o; }
    LDS_WAIT(); asm volatile("" ::: "memory");
}
__device__ __forceinline__ void rms_row_to_bf16(const float* xrow, const float* gain, bf16* orow, int lane) {
    const f32x4* xr = (const f32x4*)xrow + lane; const f32x4* gr = (const f32x4*)gain + lane;
    f32x4 v[4]; float s = 0.f;
#pragma unroll
    for (int j = 0; j < 4; ++j) { v[j] = xr[64 * j]; s += (v[j].x * v[j].x + v[j].y * v[j].y) + (v[j].z * v[j].z + v[j].w * v[j].w); }
    const float r = 1.0f / sqrtf(wave_sum(s) * (1.f / DM) + NORM_EPS);
    unsigned long long* o8 = (unsigned long long*)orow + lane;
#pragma unroll
    for (int j = 0; j < 4; ++j) { const f32x4 g = gr[64 * j];
        o8[64 * j] = (unsigned long long)pk2(v[j].x * r * g.x, v[j].y * r * g.y) | ((unsigned long long)pk2(v[j].z * r * g.z, v[j].w * r * g.w) << 32); }
}

__device__ __forceinline__ void filter_item(LAS unsigned char* lds, const Args& a, bf16* HR, int pg, int tid) {
    LAS float* Z = (LAS float*)lds;
    LAS float* HA = Z + 16 * 33;
    LAS float* HB = HA + 16 * 64;
    LAS float* W1 = HB + 16 * 64;
    LAS float* W2 = W1 + 33 * 64;
    LAS float* W3 = W2 + 64 * 64;
    const float* w1 = a.in[6]; const float* b1 = a.in[7]; const float* w2 = a.in[8]; const float* b2 = a.in[9];
    const float* w3 = a.in[10]; const float* b3 = a.in[11]; const float* w4 = a.in[12]; const float* freq = a.in[13]; const float* fbias = a.in[14];
    const int t0 = 16 * pg;
    for (int i = tid; i < 33 * 64; i += NTHR) W1[i] = w1[i];
    for (int i = tid; i < 64 * 64; i += NTHR) { W2[i] = w2[i]; W3[i] = w3[i]; }
    for (int i = tid; i < 16 * 33; i += NTHR) { const int p = i / 33, f = i % 33; const int pos = t0 + p; float val;
        if (f == 0) val = (float)pos * (1.0f / (float)(SEQ - 1));
        else { const int j = (f - 1) & 15; const float fj = 1e-4f + (float)j * ((15.0f - 1e-4f) / 15.0f); const float w = (6.283185307179586f / (float)SEQ) * (float)pos; const float arg = fj * w;
            val = (f <= 16) ? cosf(arg) : -sinf(arg); }
        Z[i] = val; }
    __syncthreads();
    for (int o = tid; o < 1024; o += NTHR) { const int p = o >> 6, n = o & 63; float acc = b1[n];
#pragma unroll 3
        for (int f = 0; f < 33; ++f) acc += Z[p * 33 + f] * W1[f * 64 + n];
        HA[o] = sinf(freq[n] * acc); }
    __syncthreads();
    for (int o = tid; o < 1024; o += NTHR) { const int p = o >> 6, n = o & 63; float acc = b2[n];
#pragma unroll 4
        for (int f = 0; f < 64; ++f) acc += HA[p * 64 + f] * W2[f * 64 + n];
        HB[o] = sinf(freq[n] * acc); }
    __syncthreads();
    for (int o = tid; o < 1024; o += NTHR) { const int p = o >> 6, n = o & 63; float acc = b3[n];
#pragma unroll 4
        for (int f = 0; f < 64; ++f) acc += HB[p * 64 + f] * W3[f * 64 + n];
        HA[o] = sinf(freq[n] * acc); }
    __syncthreads();
    {   const int c = tid;
        float af[16], ab[16];
#pragma unroll
        for (int p = 0; p < 16; ++p) { af[p] = 0.f; ab[p] = 0.f; }
        for (int k0 = 0; k0 < 64; k0 += 8) { float wf[8], wb[8];
#pragma unroll
            for (int kk = 0; kk < 8; ++kk) { wf[kk] = w4[(k0 + kk) * 1024 + c]; wb[kk] = w4[(k0 + kk) * 1024 + 512 + c]; }
#pragma unroll
            for (int kk = 0; kk < 8; ++kk)
#pragma unroll
                for (int p = 0; p < 16; ++p) { const float hv = HA[p * 64 + k0 + kk]; af[p] += hv * wf[kk]; ab[p] += hv * wb[kk]; } }
        const float min_decay = -4.605170185988091f / 1.5f, max_decay = -4.605170185988091f / 0.3f;
        const float adelta = fabsf(min_decay + (float)c * ((max_decay - min_decay) / 511.0f));
        bf16* hr = HR + (size_t)c * HRLEN;
#pragma unroll
        for (int p = 0; p < 16; ++p) { const int pos = t0 + p; const float tl = (float)pos * (1.0f / (float)(SEQ - 1)); const float dec = expf(-tl * adelta);
            const float vf = af[p] * dec, vb = ab[p] * dec;
            if (pos == 0) hr[4096] = (bf16)f2bf(vf + vb + fbias[c]);
            else { hr[4096 - pos] = (bf16)f2bf(vf); hr[4096 + pos] = (bf16)f2bf(vb); } }
        if (pg == 0) { hr[0] = 0; for (int i = 8192; i < HRLEN; ++i) hr[i] = 0; }
    }
    __syncthreads();
}

namespace att {
constexpr int KP = 272, VP = 144, KBUF = 64 * KP, VBUF = 128 * VP, VOFF = 2 * KBUF;
constexpr int NT = SEQ / 64;
__device__ __forceinline__ float max3(float a, float b, float c) { return fmaxf(fmaxf(a, b), c); }
__device__ __forceinline__ float fadd_s(float a, float b) { float r; asm("v_add_f32_e32 %0, %1, %2" : "=v"(r) : "v"(a), "v"(b)); return r; }
#define SBAR() __builtin_amdgcn_sched_barrier(0)
__device__ __forceinline__ void v_load(bf16x8 (&vf)[4], const LAS unsigned char* vb, int ks) {
#pragma unroll
    for (int e = 0; e < 4; ++e) vf[e] = *(const LAS bf16x8*)(vb + e * 32 * VP + ks * 32);
}
__device__ __forceinline__ void pv_tile(f32x16 (&o)[4], const u32x4 (&P)[4], bf16x8 (&vf0)[4], const LAS unsigned char* vb) {
    bf16x8 vf1[4];
#pragma unroll
    for (int ks = 0; ks < 4; ++ks) { const bf16x8 pb = __builtin_bit_cast(bf16x8, P[ks]);
        if (ks == 0 || ks == 2) v_load(vf1, vb, ks + 1); else if (ks == 1) v_load(vf0, vb, 2);
        SBAR(); __builtin_amdgcn_s_setprio(1);
#pragma unroll
        for (int e = 0; e < 4; ++e) o[e] = __builtin_amdgcn_mfma_f32_32x32x16_bf16((ks & 1) ? vf1[e] : vf0[e], pb, o[e], 0, 0, 0);
        __builtin_amdgcn_s_setprio(0); SBAR(); }
}
__device__ __forceinline__ float xhalf_max(float v) { auto rr = __builtin_amdgcn_permlane32_swap(__float_as_uint(v), __float_as_uint(v), false, false); return fmaxf(__uint_as_float(rr[0]), __uint_as_float(rr[1])); }
__device__ __forceinline__ float xhalf_sum(float v) { auto rr = __builtin_amdgcn_permlane32_swap(__float_as_uint(v), __float_as_uint(v), false, false); return __uint_as_float(rr[0]) + __uint_as_float(rr[1]); }
constexpr int QOFF = 2 * KBUF + 3 * VBUF;
#define ATT_SLOT(T, PKW, PVW, PKL, PVL) do { const int t = (T); \
        const LAS unsigned char* kst = lds + (t & 1) * KBUF; \
        bf16x8 vf0[4]; \
        if (c == 1 && t > 0 && VAR != 5) { v_load(vf0, lds + VOFF + vprev + voff, 0); pv_tile(o, P, vf0, lds + VOFF + vprev + voff); } \
        if (t + 2 < NT && VAR != 4) { _Pragma("unroll") for (int i = 0; i < 2; ++i) { PKL[i] = *(const u32x4*)(gk[i] + (size_t)(t + 2) * 8192); PVL[i] = *(const u32x4*)(gv[i] + (size_t)(t + 2) * 8192); } } \
        SBAR(); \
        f32x16 s0, s1; \
        { const LAS unsigned char* kb = kst + r32 * KP + c * 128 + hi * 16; const LAS unsigned char* qb_ = lds + QOFF + wid * 4096 + lane * 16; \
          bf16x8 ka[4], kc2[4], qa[2], qc[2]; \
          qa[0] = *(const LAS bf16x8*)(qb_); qa[1] = *(const LAS bf16x8*)(qb_ + 1024); \
          ka[0] = *(const LAS bf16x8*)(kb); ka[1] = *(const LAS bf16x8*)(kb + 32 * KP); ka[2] = *(const LAS bf16x8*)(kb + 32); ka[3] = *(const LAS bf16x8*)(kb + 32 * KP + 32); \
          SBAR(); \
          qc[0] = *(const LAS bf16x8*)(qb_ + 2048); qc[1] = *(const LAS bf16x8*)(qb_ + 3072); \
          kc2[0] = *(const LAS bf16x8*)(kb + 64); kc2[1] = *(const LAS bf16x8*)(kb + 32 * KP + 64); kc2[2] = *(const LAS bf16x8*)(kb + 96); kc2[3] = *(const LAS bf16x8*)(kb + 32 * KP + 96); \
          __builtin_amdgcn_s_setprio(1); s0 = __builtin_amdgcn_mfma_f32_32x32x16_bf16(ka[0], qa[0], zero16, 0, 0, 0); s1 = __builtin_amdgcn_mfma_f32_32x32x16_bf16(ka[1], qa[0], zero16, 0, 0, 0); \
          s0 = __builtin_amdgcn_mfma_f32_32x32x16_bf16(ka[2], qa[1], s0, 0, 0, 0); s1 = __builtin_amdgcn_mfma_f32_32x32x16_bf16(ka[3], qa[1], s1, 0, 0, 0); \
          SBAR(); \
          s0 = __builtin_amdgcn_mfma_f32_32x32x16_bf16(kc2[0], qc[0], s0, 0, 0, 0); s1 = __builtin_amdgcn_mfma_f32_32x32x16_bf16(kc2[1], qc[0], s1, 0, 0, 0); \
          s0 = __builtin_amdgcn_mfma_f32_32x32x16_bf16(kc2[2], qc[1], s0, 0, 0, 0); s1 = __builtin_amdgcn_mfma_f32_32x32x16_bf16(kc2[3], qc[1], s1, 0, 0, 0); __builtin_amdgcn_s_setprio(0); } \
        if (c == 0 && VAR != 5) v_load(vf0, lds + VOFF + vcur + voff, 0); \
        SBAR(); \
        if (VAR != 6) { float mx = max3(s0[0], s1[0], s0[1]); \
        mx = max3(mx, s1[1], s0[2]); mx = max3(mx, s1[2], s0[3]); mx = max3(mx, s1[3], s0[4]); mx = max3(mx, s1[4], s0[5]); \
        mx = max3(mx, s1[5], s0[6]); mx = max3(mx, s1[6], s0[7]); mx = max3(mx, s1[7], s0[8]); mx = max3(mx, s1[8], s0[9]); \
        mx = max3(mx, s1[9], s0[10]); mx = max3(mx, s1[10], s0[11]); mx = max3(mx, s1[11], s0[12]); mx = max3(mx, s1[12], s0[13]); \
        mx = max3(mx, s1[13], s0[14]); mx = max3(mx, s1[14], s0[15]); mx = fmaxf(mx, s1[15]); \
        mx = xhalf_max(mx); \
        if (t == 0) { if (__any(fabsf(mx) > 8.0f)) { mref = mx; gen = true; } } \
        else if (__any(mx > mref + 8.0f)) { const float mnew = fmaxf(mx, mref); const float al = __builtin_amdgcn_exp2f(mref - mnew); \
            _Pragma("unroll") for (int e = 0; e < 4; ++e) _Pragma("unroll") for (int r = 0; r < 16; ++r) o[e][r] *= al; \
            lsum *= al; mref = mnew; gen = true; } \
        float ps0 = 0.f, ps1 = 0.f; \
        if (gen) { _Pragma("unroll") for (int r = 0; r < 16; ++r) { s0[r] = __builtin_amdgcn_exp2f(s0[r] - mref); s1[r] = __builtin_amdgcn_exp2f(s1[r] - mref); ps0 += s0[r]; ps0 += s1[r]; } } \
        else { _Pragma("unroll") for (int r = 0; r < 16; ++r) { s0[r] = __builtin_amdgcn_exp2f(s0[r]); s1[r] = __builtin_amdgcn_exp2f(s1[r]); ps0 += s0[r]; ps0 += s1[r]; } } \
        lsum += ps0 + ps1; } \
        P[0] = (u32x4){cvtpk(s0[0], s0[1]), cvtpk(s0[2], s0[3]), cvtpk(s0[4], s0[5]), cvtpk(s0[6], s0[7])}; \
        P[1] = (u32x4){cvtpk(s0[8], s0[9]), cvtpk(s0[10], s0[11]), cvtpk(s0[12], s0[13]), cvtpk(s0[14], s0[15])}; \
        P[2] = (u32x4){cvtpk(s1[0], s1[1]), cvtpk(s1[2], s1[3]), cvtpk(s1[4], s1[5]), cvtpk(s1[6], s1[7])}; \
        P[3] = (u32x4){cvtpk(s1[8], s1[9]), cvtpk(s1[10], s1[11]), cvtpk(s1[12], s1[13]), cvtpk(s1[14], s1[15])}; \
        if (c == 0 && VAR != 5) pv_tile(o, P, vf0, lds + VOFF + vcur + voff); \
        if (t + 1 < NT && VAR != 4) { LAS unsigned char* kn = lds + ((t + 1) & 1) * KBUF; LAS unsigned char* vn = lds + vnext; \
            _Pragma("unroll") for (int i = 0; i < 2; ++i) { *(LAS u32x4*)(kn + lk[i]) = PKW[i]; *(LAS u32x4*)(vn + lv[i]) = PVW[i]; } } \
        { const int tmp = vprev; vprev = vcur; vcur = vnext; vnext = tmp; } \
        if (VAR != 3) { asm volatile("s_waitcnt lgkmcnt(0)\n\ts_barrier" ::: "memory"); } \
    } while (0)
template <int VAR> __device__ __forceinline__ void unit(LAS unsigned char* lds, const bf16* QK, const bf16* KT, const bf16* VT, bf16* MIX, const float* sgain, float lam, int b, int h, int qb) {
    const int tid = threadIdx.x, lane = tid & 63, r32 = lane & 31, hi = lane >> 5; const int wid = __builtin_amdgcn_readfirstlane(tid >> 6);
    const int qsub = wid & 3, c = wid >> 2;
    const size_t rowbase = (size_t)b * SEQ; const int q0 = qb * 128 + qsub * 32;
    { const bf16* qp = QK + (rowbase + q0 + r32) * 512 + h * 128 + c * 64 + hi * 8;
#pragma unroll
      for (int ds = 0; ds < 4; ++ds) *(LAS bf16x8*)(lds + QOFF + wid * 4096 + ds * 1024 + lane * 16) = *(const bf16x8*)(qp + ds * 16); }
    const bf16* gk[2]; const bf16* gv[2]; int lk[2], lv[2];
#pragma unroll
    for (int i = 0; i < 2; ++i) { const int id = tid + NTHR * i; const int kr = id >> 4, kc = id & 15; const int ve = id >> 3, vc = id & 7;
        gk[i] = KT + (size_t)(b * 4 + h) * 64 * 8192 + id * 8; lk[i] = kr * KP + kc * 16;
        gv[i] = VT + (size_t)(b * 4 + h) * 64 * 8192 + id * 8; lv[i] = VOFF + ve * VP + vc * 16; }
    u32x4 pkA[2], pvA[2], pkB[2], pvB[2];
#pragma unroll
    for (int i = 0; i < 2; ++i) { pkA[i] = *(const u32x4*)gk[i]; pvA[i] = *(const u32x4*)gv[i]; }
#pragma unroll
    for (int i = 0; i < 2; ++i) { pkB[i] = *(const u32x4*)(gk[i] + 8192); pvB[i] = *(const u32x4*)(gv[i] + 8192); }
#pragma unroll
    for (int i = 0; i < 2; ++i) { *(LAS u32x4*)(lds + lk[i]) = pkA[i]; *(LAS u32x4*)(lds + lv[i]) = pvA[i]; }
    __syncthreads();
    f32x16 o[4];
#pragma unroll
    for (int e = 0; e < 4; ++e) o[e] = (f32x16){};
    const f32x16 zero16 = (f32x16){};
    float mref = 0.f, lsum = 0.f; bool gen = false;
    u32x4 P[4];
#pragma unroll
    for (int ks = 0; ks < 4; ++ks) P[ks] = (u32x4){0u, 0u, 0u, 0u};
    int vcur = 0, vprev = 2 * VBUF, vnext = VBUF;
    const int voff = r32 * VP + hi * 16;
    for (int tt = 0; tt < NT; tt += 2) {
        ATT_SLOT(tt, pkB, pvB, pkA, pvA);
        ATT_SLOT(tt + 1, pkA, pvA, pkB, pvB);
    }
    if (c == 1) { bf16x8 vf0[4]; v_load(vf0, lds + VOFF + vprev + voff, 0); pv_tile(o, P, vf0, lds + VOFF + vprev + voff); }
    __syncthreads();
    lsum = xhalf_sum(lsum);
    const float sc = (c == 0) ? (1.0f / lsum) : (lam / lsum);
    LAS float* X = (LAS float*)lds + qsub * (128 * 32);
    if (c == 1) {
#pragma unroll
        for (int e = 0; e < 4; ++e)
#pragma unroll
            for (int r = 0; r < 16; ++r) { const int ee = 32 * e + (r & 3) + 8 * (r >> 2) + 4 * hi; X[ee * 32 + r32] = o[e][r] * sc; } }
    __syncthreads();
    if (c == 0) { float ss = 0.f;
#pragma unroll
        for (int e = 0; e < 4; ++e)
#pragma unroll
            for (int r = 0; r < 16; ++r) { const int ee = 32 * e + (r & 3) + 8 * (r >> 2) + 4 * hi; const float v = o[e][r] * sc - X[ee * 32 + r32]; o[e][r] = v; ss += v * v; }
        ss = xhalf_sum(ss);
        const float rs = (1.0f / sqrtf(ss * (1.0f / 128.0f) + SUBLN_EPS)) * 0.8f;
        bf16* op = MIX + (rowbase + q0 + r32) * 1024 + 512 + h * 128;
#pragma unroll
        for (int e = 0; e < 4; ++e)
#pragma unroll
            for (int q4 = 0; q4 < 4; ++q4) { const int ee = 32 * e + 8 * q4 + 4 * hi; const f32x4 g = *(const f32x4*)(sgain + ee);
                u32x2 w; w.x = cvtpk(o[e][4 * q4] * rs * g.x, o[e][4 * q4 + 1] * rs * g.y); w.y = cvtpk(o[e][4 * q4 + 2] * rs * g.z, o[e][4 * q4 + 3] * rs * g.w);
                *(u32x2*)(op + ee) = w; } }
    __syncthreads();
}
}

namespace hy {
constexpr int UP = 264, UBUF = 32 * UP * 2, HRB = HRLEN * 2;
constexpr int NCH = 17;
__device__ __forceinline__ float ldbf(const bf16* p) { return bf2f(*p); }
struct StageRegs { u32x2 xa, xb, va, vb; unsigned short xm, vm; };
__device__ __forceinline__ void stage_load(StageRegs& R, const bf16* X1, const bf16* V, int j, int tid) {
    const int b = tid >> 6, tt = tid & 63; const int S0 = 256 * j + 4 * tt - 4;
    const bool okA = (S0 >= 0 && S0 < SEQ), okB = (S0 + 4 < SEQ), okM = (S0 >= 1 && S0 <= SEQ);
    const size_t ia = (size_t)b * SEQ + (okA ? S0 : 0), ib = (size_t)b * SEQ + (okB ? S0 + 4 : 0), im = (size_t)b * SEQ + (okM ? S0 - 1 : 0);
    R.xa = *(const u32x2*)(X1 + ia); R.xb = *(const u32x2*)(X1 + ib); R.xm = X1[im];
    R.va = *(const u32x2*)(V + ia); R.vb = *(const u32x2*)(V + ib); R.vm = V[im];
}
__device__ __forceinline__ void stage_write(LAS unsigned char* ub, const StageRegs& R, const float (&w1)[4], const float (&wv)[4], int j, int tid) {
    const int b = tid >> 6, tt = tid & 63; const int S0 = 256 * j + 4 * tt - 4;
    const bool okA = (S0 >= 0 && S0 < SEQ), okB = (S0 + 4 < SEQ), okM = (S0 >= 1 && S0 <= SEQ);
    float xs[9], vs[9];
    xs[0] = okM ? bf2f(R.xm) : 0.f; vs[0] = okM ? bf2f(R.vm) : 0.f;
    xs[1] = okA ? bflo(R.xa.x) : 0.f; xs[2] = okA ? bfhi(R.xa.x) : 0.f; xs[3] = okA ? bflo(R.xa.y) : 0.f; xs[4] = okA ? bfhi(R.xa.y) : 0.f;
    xs[5] = okB ? bflo(R.xb.x) : 0.f; xs[6] = okB ? bfhi(R.xb.x) : 0.f; xs[7] = okB ? bflo(R.xb.y) : 0.f; xs[8] = okB ? bfhi(R.xb.y) : 0.f;
    vs[1] = okA ? bflo(R.va.x) : 0.f; vs[2] = okA ? bfhi(R.va.x) : 0.f; vs[3] = okA ? bflo(R.va.y) : 0.f; vs[4] = okA ? bfhi(R.va.y) : 0.f;
    vs[5] = okB ? bflo(R.vb.x) : 0.f; vs[6] = okB ? bfhi(R.vb.x) : 0.f; vs[7] = okB ? bflo(R.vb.y) : 0.f; vs[8] = okB ? bfhi(R.vb.y) : 0.f;
    float g[7];
#pragma unroll
    for (int i = 0; i < 7; ++i) { const float cx = w1[0] * xs[i] + w1[1] * xs[i + 1] + w1[2] * xs[i + 2] + w1[3]; const float cv = wv[0] * vs[i] + wv[1] * vs[i + 1] + wv[2] * vs[i + 2] + wv[3];
        g[i] = ((i < 4) ? okA : okB) ? cx * cv : 0.f; }
#pragma unroll
    for (int r = 0; r < 4; ++r) { u32x2 w; w.x = pk2(g[r], g[r + 1]); w.y = pk2(g[r + 2], g[r + 3]);
        *(LAS u32x2*)(ub + ((4 * b + r) * UP + 4 * tt) * 2) = w; }
}
__device__ __forceinline__ void channel(LAS unsigned char* lds, const bf16* UVT, const bf16* HR, const float* conv_w, const float* conv_b, bf16* YT, int c) {
    const int tid = threadIdx.x, lane = tid & 63, r32 = lane & 31, hi = lane >> 5; const int wid = __builtin_amdgcn_readfirstlane(tid >> 6);
    const bf16* X0 = UVT + (size_t)c * MTOK; const bf16* X1 = UVT + (size_t)(512 + c) * MTOK; const bf16* V = UVT + (size_t)(1024 + c) * MTOK;
    float w0[4], w1[4], wv[4];
#pragma unroll
    for (int k = 0; k < 3; ++k) { w0[k] = conv_w[k * 1536 + c]; w1[k] = conv_w[k * 1536 + 512 + c]; wv[k] = conv_w[k * 1536 + 1024 + c]; }
    w0[3] = conv_b[c]; w1[3] = conv_b[512 + c]; wv[3] = conv_b[1024 + c];
    for (int i = tid; i < HRB / 16; i += NTHR) { const bf16* src = HR + (size_t)c * HRLEN + 8 * i; ((LAS u32x4*)lds)[i] = *(const u32x4*)src;
        const u32x2 lo = *(const u32x2*)(src + 4); const u32x2 hi2 = (8 * i + 8 < HRLEN) ? *(const u32x2*)(src + 8) : (u32x2){0u, 0u};
        ((LAS u32x4*)(lds + HRB))[i] = (u32x4){lo.x, lo.y, hi2.x, hi2.y}; }
    LAS unsigned char* ub0 = lds + 2 * HRB;
    StageRegs SR;
    stage_load(SR, X1, V, 0, tid); stage_write(ub0, SR, w1, wv, 0, tid);
    __syncthreads();
    f32x16 acc[4];
#pragma unroll
    for (int n = 0; n < 4; ++n) acc[n] = (f32x16){};
    const int idx0 = 4096 - 4 * (128 * wid + r32) - 4 + 8 * hi;
    const int hb0 = (r32 & 1) ? idx0 * 2 : HRB + (idx0 - 4) * 2;
    for (int j = 0; j < NCH; ++j) {
        LAS unsigned char* ucur = ub0 + (j & 1) * UBUF;
        if (j + 1 < NCH) stage_load(SR, X1, V, j + 1, tid);
        const int nks = (j < NCH - 1) ? 16 : 1;
        const LAS unsigned char* ua = ucur + r32 * (UP * 2) + hi * 16;
        const LAS unsigned char* hp = lds + hb0 + j * 512;
        if (nks == 16) {
            bf16x8 a0, b0[4], a1, b1[4];
            a0 = *(const LAS bf16x8*)(ua);
#pragma unroll
            for (int n = 0; n < 4; ++n) b0[n] = *(const LAS bf16x8*)(hp - n * 256);
#pragma unroll
            for (int ks = 0; ks < 16; ks += 2) {
                a1 = *(const LAS bf16x8*)(ua + (ks + 1) * 32);
#pragma unroll
                for (int n = 0; n < 4; ++n) b1[n] = *(const LAS bf16x8*)(hp + (ks + 1) * 32 - n * 256);
                __builtin_amdgcn_sched_barrier(0);
#pragma unroll
                for (int n = 0; n < 4; ++n) acc[n] = __builtin_amdgcn_mfma_f32_32x32x16_bf16(a0, b0[n], acc[n], 0, 0, 0);
                __builtin_amdgcn_sched_barrier(0);
                if (ks + 2 < 16) { a0 = *(const LAS bf16x8*)(ua + (ks + 2) * 32);
#pragma unroll
                    for (int n = 0; n < 4; ++n) b0[n] = *(const LAS bf16x8*)(hp + (ks + 2) * 32 - n * 256); }
                __builtin_amdgcn_sched_barrier(0);
#pragma unroll
                for (int n = 0; n < 4; ++n) acc[n] = __builtin_amdgcn_mfma_f32_32x32x16_bf16(a1, b1[n], acc[n], 0, 0, 0);
                __builtin_amdgcn_sched_barrier(0);
            }
        } else {
            const bf16x8 a = *(const LAS bf16x8*)(ua);
#pragma unroll
            for (int n = 0; n < 4; ++n) { const bf16x8 bb = *(const LAS bf16x8*)(hp - n * 256);
                acc[n] = __builtin_amdgcn_mfma_f32_32x32x16_bf16(a, bb, acc[n], 0, 0, 0); }
        }
        if (j + 1 < NCH) stage_write(ub0 + ((j + 1) & 1) * UBUF, SR, w1, wv, j + 1, tid);
        __syncthreads();
    }
#pragma unroll
    for (int n = 0; n < 4; ++n) { const int t = 4 * (128 * wid + 32 * n + r32);
#pragma unroll
        for (int q = 0; q < 4; ++q) { const int b = 2 * q + hi; const bf16* xp = X0 + (size_t)b * SEQ + t; const u32x2 xa = *(const u32x2*)xp; float xs[6];
            { const float xm = ldbf(xp - ((t > 0) ? 1 : 0)), xq = ldbf(xp + ((t + 4 < SEQ) ? 4 : 0)); xs[0] = (t > 0) ? xm : 0.f; xs[5] = (t + 4 < SEQ) ? xq : 0.f; }
            xs[1] = bflo(xa.x); xs[2] = bfhi(xa.x); xs[3] = bflo(xa.y); xs[4] = bfhi(xa.y);
            float y[4];
#pragma unroll
            for (int i = 0; i < 4; ++i) y[i] = acc[n][4 * q + i] * (w0[0] * xs[i] + w0[1] * xs[i + 1] + w0[2] * xs[i + 2] + w0[3]);
            u32x2 w; w.x = pk2(y[0], y[1]); w.y = pk2(y[2], y[3]);
            *(u32x2*)(YT + (size_t)c * MTOK + (size_t)b * SEQ + t) = w; } }
    __syncthreads();
}
}

#define XB_TMO      128
#define XB_XCNT(j)  (256  + 64 * (j))
#define XB_XSUB(j)  (1280 + 64 * (j))
#define XB_XGEN(j)  (2304 + 64 * (j))
#define XB_TOP      3328
#define XB_TOPGEN   3392
#define XCD_BAR_WORDS 3456
#define XB_SPIN_CAP (1u << 18)

__device__ __forceinline__ unsigned xb_ld(unsigned* p)              { return __hip_atomic_load(p, __ATOMIC_RELAXED, __HIP_MEMORY_SCOPE_AGENT); }
__device__ __forceinline__ unsigned xb_add(unsigned* p, unsigned v) { return __hip_atomic_fetch_add(p, v, __ATOMIC_RELAXED, __HIP_MEMORY_SCOPE_AGENT); }
__device__ __forceinline__ unsigned xb_xcc_id() { return (unsigned)__builtin_amdgcn_s_getreg((3 << 11) | 20) & 0xFu; }
#define XB_SPIN(cond, bar) do { unsigned _sp = 0; while (cond) { __builtin_amdgcn_s_sleep(1); \
    if ((++_sp & 255u) == 0u) { if (xb_ld(&(bar)[XB_TMO])) break; if (_sp > XB_SPIN_CAP) { atomicAdd(&(bar)[XB_TMO], 1u); break; } } } } while (0)

struct XcdBarrier {
    unsigned* bar; unsigned x;
    volatile LAS unsigned* st;
};

__device__ __forceinline__ XcdBarrier xcd_barrier_post(unsigned* bar, volatile LAS unsigned* st) {
    XcdBarrier b; b.bar = bar; b.x = xb_xcc_id(); b.st = st;
    if (threadIdx.x == 0) (void)xb_add(&bar[XB_XCNT(b.x)], 1u);
    return b;
}
__device__ __forceinline__ void xcd_barrier_complete(unsigned* bar, unsigned x, unsigned& nloc, unsigned& nx) {
    const unsigned G = gridDim.x * gridDim.y * gridDim.z;
    unsigned sum, cnt, mine, sp = 0u;
    for (;;) {
        sum = 0u; cnt = 0u; mine = 0u;
#pragma unroll
        for (unsigned j = 0; j < 16; ++j) { const unsigned c = xb_ld(&bar[XB_XCNT(j)]); sum += c; cnt += (c > 0u) ? 1u : 0u; mine = (j == x) ? c : mine; }
        if (sum == G) break;
        __builtin_amdgcn_s_sleep(1);
        if ((++sp & 255u) == 0u) { if (xb_ld(&bar[XB_TMO])) break; if (sp > XB_SPIN_CAP) { atomicAdd(&bar[XB_TMO], 1u); break; } }
    }
    nloc = mine > 0u ? mine : 1u; nx = cnt > 0u ? cnt : 1u;
}

__device__ __forceinline__ void xcd_barrier(const XcdBarrier& b) {
    asm volatile("s_waitcnt vmcnt(0)" ::: "memory");
    __syncthreads();
    if (threadIdx.x == 0) {
        unsigned* bar = b.bar;
        __builtin_amdgcn_s_waitcnt(0);
        unsigned nloc = b.st[0], nx = b.st[1];
        if (nloc == 0u) { xcd_barrier_complete(bar, b.x, nloc, nx); b.st[0] = nloc; b.st[1] = nx; }
        const unsigned old = xb_add(&bar[XB_XSUB(b.x)], 1u);
        const unsigned gen = old / nloc;
        if (old + 1u == (gen + 1u) * nloc) {
            __builtin_amdgcn_fence(__ATOMIC_RELEASE, "agent");
            asm volatile("s_waitcnt vmcnt(0)" ::: "memory");
            const unsigned og = xb_add(&bar[XB_TOP], 1u);
            const unsigned tg = og / nx;
            if (og + 1u == (tg + 1u) * nx) xb_add(&bar[XB_TOPGEN], 1u);
            else XB_SPIN(xb_ld(&bar[XB_TOPGEN]) == tg, bar);
            __builtin_amdgcn_fence(__ATOMIC_ACQUIRE, "agent");
            xb_add(&bar[XB_XGEN(b.x)], 1u);
            asm volatile("s_waitcnt vmcnt(0)" ::: "memory");
        } else {
            XB_SPIN(xb_ld(&bar[XB_XGEN(b.x)]) == gen, bar);
            __builtin_amdgcn_fence(__ATOMIC_ACQUIRE, "agent");
            asm volatile("s_waitcnt vmcnt(0)" ::: "memory");
        }
    }
    __syncthreads();
}

__global__ void __launch_bounds__(NTHR, 2) fwd_kernel(Args a) {
    extern __shared__ __attribute__((aligned(16))) unsigned char lds_raw[];
    LAS unsigned char* lds = (LAS unsigned char*)lds_raw;
    const int tid = threadIdx.x, lane = tid & 63; const int wave = __builtin_amdgcn_readfirstlane(tid >> 6);
    const int G = gridDim.x, bx = blockIdx.x;
    const int gw = bx * NWAVES + wave, NGW = G * NWAVES;
    unsigned char* ws = a.ws;
    bf16* Win_t = (bf16*)(ws + WS_WIN); bf16* Wout_t = (bf16*)(ws + WS_WOUT); bf16* Wup_t = (bf16*)(ws + WS_WUP); bf16* Wdown_t = (bf16*)(ws + WS_WDOWN);
    bf16* HR = (bf16*)(ws + WS_HR); float* ROPE = (float*)(ws + WS_ROPE);
    bf16* XN = (bf16*)(ws + WS_XN); bf16* MO = (bf16*)(ws + WS_MO); bf16* YT = (bf16*)(ws + WS_YT); bf16* UVT = (bf16*)(ws + WS_UVT);
    bf16* QK = (bf16*)(ws + WS_QK); bf16* KT = (bf16*)(ws + WS_KT); bf16* VT = (bf16*)(ws + WS_VT); bf16* MIX = (bf16*)(ws + WS_MIX); bf16* HB = (bf16*)(ws + WS_H);
    const float* x = a.in[0];
    const int lo = a.ph_lo, hi_ph = a.ph_hi;
#if MK_COOP
    cg::grid_group grid = cg::this_grid();
    volatile LAS unsigned* bst = (volatile LAS unsigned*)(lds + 131072 + 64);
    if (tid < 4) bst[tid] = 0u;
    __syncthreads();
    XcdBarrier xbar = xcd_barrier_post((unsigned*)(ws + WS_CTL), bst);
#define SEAM(k) do { if (lo <= (k) && (k) + 1 < hi_ph) { if ((k) == 0) grid.sync(); else xcd_barrier(xbar); } } while (0)
#else
#define SEAM(k) do { } while (0)
#endif
#ifndef PHMASK
#define PHMASK 0x1ff
#endif
#define IN(k) (((PHMASK >> (k)) & 1) && lo <= (k) && (k) < hi_ph)

#ifndef DUP_P0
#define DUP_P0 1
#endif
    if (IN(0)) for (int rep0 = 0; rep0 < DUP_P0; ++rep0) {
        LAS float* scr = (LAS float*)(lds + wave * 16384);
        constexpr int I_IN = (DM / 64) * (NIN / 32), I_OUT = (DM / 64) * (DM / 32), I_UP = (DM / 64) * (DFF / 32), I_DN = (DFF / 64) * (DM / 32);
        for (int it = gw; it < I_IN + I_OUT + I_UP + I_DN; it += NGW) { int r = it;
            if (r < I_IN) { p0_transpose_item<true>(a.in[3], DM, NIN, Win_t, scr, r, lane); continue; } r -= I_IN;
            if (r < I_OUT) { p0_transpose_item<false>(a.in[20], DM, DM, Wout_t, scr, r, lane); continue; } r -= I_OUT;
            if (r < I_UP) { p0_transpose_item<false>(a.in[23], DM, DFF, Wup_t, scr, r, lane); continue; } r -= I_UP;
            p0_transpose_item<false>(a.in[24], DFF, DM, Wdown_t, scr, r, lane); }
        for (int m = gw; m < MTOK; m += NGW) rms_row_to_bf16(x + (size_t)m * DM, a.in[1], XN + (size_t)m * DM, lane);
        for (int i = bx * NTHR + tid; i < SEQ * 32; i += G * NTHR) { const int pos = i >> 5, k = i & 31;
            const float inv = exp2f(-(float)(2 * k) * (13.287712379549449f / 64.0f)); const float ang = (float)pos * inv;
            ROPE[2 * i] = cosf(ang); ROPE[2 * i + 1] = sinf(ang); }
        __syncthreads();
        for (int pg = bx; pg < SEQ / 16; pg += G) filter_item(lds, a, HR, pg, tid);
    }
    SEAM(0);
#ifndef DUP_P1
#define DUP_P1 1
#endif
    if (IN(1)) {
        { pg8::Gemm g{Win_t, XN, 2048, MTOK, DM}; pg8::StaticOrder S; S.init(2048, MTOK, G, bx);
          pg8::EpiUV E{UVT, VT};
          pg8::gemm_phase<pg8::EpiUV, pg8::StaticOrder, true, true>(lds, g, S, E); }
        { pg8::Gemm g{XN, Win_t + (size_t)2048 * DM, MTOK, 1024, DM}; pg8::StaticOrder S; S.init(MTOK, 1024, G, bx);
          pg8::EpiRope E{QK, KT, ROPE, QSCALE};
          pg8::gemm_phase<pg8::EpiRope, pg8::StaticOrder, true, true>(lds, g, S, E); }
    }
#if DUP_P1 == 2
    if (IN(1)) {
        { pg8::Gemm g{Win_t, XN, 2048, MTOK, DM}; pg8::StaticOrder S; S.init(2048, MTOK, G, bx);
          pg8::EpiUV E{UVT, VT};
          pg8::gemm_phase<pg8::EpiUV, pg8::StaticOrder, true, true>(lds, g, S, E); }
        { pg8::Gemm g{XN, Win_t + (size_t)2048 * DM, MTOK, 1024, DM}; pg8::StaticOrder S; S.init(MTOK, 1024, G, bx);
          pg8::EpiRope E{QK, KT, ROPE, QSCALE};
          pg8::gemm_phase<pg8::EpiRope, pg8::StaticOrder, true, true>(lds, g, S, E); }
    }
#endif
    SEAM(1);
    if (IN(2)) {
        float lam;
        { const float p1 = a.in[15][lane] * a.in[16][lane], p2 = a.in[17][lane] * a.in[18][lane];
          lam = expf(wave_sum(p1)) - expf(wave_sum(p2)) + 0.2f; }
#ifndef DUP_ATT
#define DUP_ATT 1
#endif
#ifndef DUP_HY
#define DUP_HY 1
#endif
#ifndef ATT_VAR
#define ATT_VAR 0
#endif
        for (int u = bx; u < 1024; u += G) { const int bh = (u & 7) + 8 * (u >> 8), qb = (u >> 3) & 31;
            att::unit<0>(lds, QK, KT, VT, MIX, a.in[19], lam, bh >> 2, bh & 3, qb); }
        if (DUP_ATT > 1)
        for (int u = bx; u < 1024; u += G) { const int bh = (u & 7) + 8 * (u >> 8), qb = (u >> 3) & 31;
            att::unit<ATT_VAR>(lds, QK, KT, VT, MO, a.in[19], lam, bh >> 2, bh & 3, qb); }
        for (int rep = 0; rep < DUP_HY; ++rep)
        for (int c = bx; c < HYW; c += G) hy::channel(lds, UVT, HR, a.in[4], a.in[5], YT, c);
    }
    SEAM(2);
#ifndef DUP_P3
#define DUP_P3 1
#endif
    if (IN(3)) for (int rep3 = 0; rep3 < DUP_P3; ++rep3) {
        LAS unsigned short* scr = (LAS unsigned short*)(lds + wave * 16384);
        for (int it = gw; it < 8 * (MTOK / 64); it += NGW) { const int ct = it & 7, mt = it >> 3; const int c0 = 64 * ct, m0 = 64 * mt;
#pragma unroll
            for (int i = 0; i < 8; ++i) { const int cc = 8 * i + (lane >> 3), mch = lane & 7; const u32x4 v = *(const u32x4*)(YT + (size_t)(c0 + cc) * MTOK + m0 + 8 * mch);
                LAS unsigned* d = (LAS unsigned*)(scr + cc * 66 + 8 * mch); d[0] = v.x; d[1] = v.y; d[2] = v.z; d[3] = v.w; }
            LDS_WAIT(); asm volatile("" ::: "memory");
#pragma unroll
            for (int i = 0; i < 8; ++i) { const int mm = 8 * i + (lane >> 3), cch = lane & 7; const LAS unsigned short* s = scr + (8 * cch) * 66 + mm;
                u32x4 o; o.x = (unsigned)s[0] | ((unsigned)s[66] << 16); o.y = (unsigned)s[2 * 66] | ((unsigned)s[3 * 66] << 16);
                o.z = (unsigned)s[4 * 66] | ((unsigned)s[5 * 66] << 16); o.w = (unsigned)s[6 * 66] | ((unsigned)s[7 * 66] << 16);
                *(u32x4*)(MIX + (size_t)(m0 + mm) * 1024 + c0 + 8 * cch) = o; }
            LDS_WAIT(); asm volatile("" ::: "memory"); }
        __syncthreads();
    }
    SEAM(3);
    if (IN(4)) {
        pg8::Gemm g{MIX, Wout_t, MTOK, DM, DM}; pg8::StaticOrder S; S.init(MTOK, DM, G, bx);
        float* ssb = (float*)(ws + WS_CTL + CTL_SS); unsigned* cntb = (unsigned*)(ws + WS_CTL + CTL_CNT);
        pg8::EpiNormResNorm E{x, a.out, XN, a.in[2], a.in[21], ssb, ssb + MTOK, cntb, cntb + 128, NORM_EPS};
        pg8::gemm_phase<pg8::EpiNormResNorm, pg8::StaticOrder, true, true>(lds, g, S, E);
    }
    SEAM(4);
#ifndef DUP_P6
#define DUP_P6 1
#endif
    if (IN(6)) for (int rep6 = 0; rep6 < DUP_P6; ++rep6) {
        pg8::Gemm g{XN, Wup_t, MTOK, DFF, DM}; pg8::StaticOrder S; S.init(MTOK, DFF, G, bx);
        pg8::EpiBf16<1> E{HB, DFF};
        pg8::gemm_phase<pg8::EpiBf16<1>, pg8::StaticOrder, true, true>(lds, g, S, E);
    }
    SEAM(6);
    if (IN(7)) {
        pg8::Gemm g{HB, Wdown_t, MTOK, DM, DFF}; pg8::StaticOrder S; S.init(MTOK, DM, G, bx);
        float* ssb = (float*)(ws + WS_CTL + CTL_SS); unsigned* cntb = (unsigned*)(ws + WS_CTL + CTL_CNT);
        pg8::EpiNormRes E{a.out, a.in[22], ssb + 2 * MTOK, cntb + 256, NORM_EPS};
        pg8::gemm_phase<pg8::EpiNormRes, pg8::StaticOrder, true, true>(lds, g, S, E);
    }
#undef IN
#undef SEAM
}

constexpr int NPHASE = 9;
extern "C" void kernel_launch(void* const* d_in, const int* in_sizes, int n_in, void* d_out, int out_size, void* d_ws, size_t ws_size, hipStream_t stream) {
    static int grid = 0;
    if (grid == 0) {
        if (n_in != 25 || in_sizes[0] != MTOK * DM || out_size != MTOK * DM || ws_size < WS_END) {
            fprintf(stderr, "kernel_launch: unexpected shapes (n_in %d in0 %d out %d ws %zu)\n", n_in, n_in > 0 ? in_sizes[0] : -1, out_size, ws_size); grid = -1; return; }
        int dev = 0, cus = 0, per_cu = 0;
        hipGetDevice(&dev); hipDeviceGetAttribute(&cus, hipDeviceAttributeMultiprocessorCount, dev);
        hipFuncSetAttribute((const void*)fwd_kernel, hipFuncAttributeMaxDynamicSharedMemorySize, LDS_BYTES);
        hipOccupancyMaxActiveBlocksPerMultiprocessor(&per_cu, (const void*)fwd_kernel, NTHR, LDS_BYTES);
        if (per_cu < 1) { fprintf(stderr, "kernel_launch: occupancy query says %d blocks/CU\n", per_cu); per_cu = 1; }
        (void)hipGetLastError();
        grid = cus * 1;
    }
    if (grid < 0) return;
    Args a{};
    for (int i = 0; i < 25; ++i) a.in[i] = (const float*)d_in[i];
    a.out = (float*)d_out; a.ws = (unsigned char*)d_ws;
#if MK_COOP
    a.ph_lo = 0; a.ph_hi = NPHASE;
    if (hipMemsetAsync((unsigned char*)d_ws + WS_CTL, 0, CTL_BYTES, stream) != hipSuccess) { fprintf(stderr, "kernel_launch: memset of the barrier words failed\n"); return; }
    void* args[] = {&a};
    hipError_t e = hipLaunchCooperativeKernel((const void*)fwd_kernel, dim3(grid), dim3(NTHR), args, LDS_BYTES, stream);
    if (e != hipSuccess) fprintf(stderr, "cooperative launch failed: %s (grid %d)\n", hipGetErrorString(e), grid);
#else
    for (int p = 0; p < NPHASE; ++p) { a.ph_lo = p; a.ph_hi = p + 1; hipLaunchKernelGGL(fwd_kernel, dim3(grid), dim3(NTHR), LDS_BYTES, stream, a); }
#endif
}
```

```cpp
#include <hip/hip_runtime.h>
#include <hip/hip_cooperative_groups.h>
#include <cstdio>
#include <cstdint>
#include <cmath>
namespace cg = cooperative_groups;
#ifndef MK_COOP
#define MK_COOP 1
#endif
namespace pg8 {
#define PG8_LAS __attribute__((address_space(3)))
typedef unsigned short bf16_t;
typedef short bf16x8 __attribute__((ext_vector_type(8)));
typedef float f32x4 __attribute__((ext_vector_type(4)));
typedef unsigned u32x4 __attribute__((ext_vector_type(4)));
constexpr int BM = 256, BK = 64, HALF = 128, HTB = HALF * BK * 2  , STAGE_BYTES = 8 * HTB, NXCD = 8, WGM = 8;

__host__ __device__ __forceinline__ int lds_byte(int r, int c) { const int st = (r >> 4) * 2 + (c >> 5), rr = r & 15, cc = c & 31, ob = rr * 64 + cc * 2; return st * 1024 + (ob ^ (((ob >> 9) & 1) << 5)); }
__host__ __device__ __forceinline__ void stage_rc(int b, int& R, int& C) { const int st = b / 1024, sb = b % 1024, swz = sb ^ (((sb >> 9) & 1) << 5); R = (st >> 1) * 16 + swz / 64; C = (st & 1) * 32 + (swz % 64) / 2; }
__host__ __device__ __forceinline__ int perm32(int rho) { const int n = rho >> 4, i = rho & 15; return 8 * (i >> 2) + 4 * n + (i & 3); }

struct Unit { int pm, pn; };
struct Gemm { const bf16_t* A; const bf16_t* Bt; int M, N, K; };

struct StaticOrder {
    int nM, nN, nwg, G, c;
    __host__ __device__ void init(int M, int N, int G_, int c_) { nM = M / BM; nN = N / BM; nwg = nM * nN; G = G_; c = c_; }
    __host__ __device__ bool next(int i, Unit& u) const {
        const long L = (long)i * G + c; if (L >= nwg) return false;
        int wgid = (int)L; { const int q = nwg / NXCD, r = nwg % NXCD, xcd = wgid % NXCD, off = wgid / NXCD; wgid = (xcd < r ? xcd * (q + 1) : r * (q + 1) + (xcd - r) * q) + off; }
        const int nig = WGM * nN, gid = wgid / nig, fm = gid * WGM, gsz = (nM - fm) < WGM ? (nM - fm) : WGM;
        u.pm = fm + ((wgid % nig) % gsz); u.pn = (wgid % nig) / gsz; return true;
    }
    __device__ __forceinline__ void a_ready(const Unit&) const {}
    __device__ __forceinline__ void done(const Unit&) const {}
};

__device__ __forceinline__ unsigned cvt_pk_bf16(float lo, float hi) { unsigned r; asm volatile("v_cvt_pk_bf16_f32 %0, %1, %2" : "=v"(r) : "v"(lo), "v"(hi)); return r; }
typedef float f32x2 __attribute__((ext_vector_type(2)));
typedef float f32x2 __attribute__((ext_vector_type(2)));
typedef unsigned u32x2 __attribute__((ext_vector_type(2)));
template <int ACT> struct EpiBf16 {
    static constexpr bool PERM = true, AFTER_DRAIN = false;
    bf16_t* O; int ldc;
    __device__ __forceinline__ void operator()(const f32x4 (&acc)[2][2][4][2], const Unit& u, int wr, int wc, int fr, int fq) const {
        const int row0 = u.pm * BM + wr * 64 + fr; const int col0 = u.pn * BM + wc * 32 + 8 * fq;
#pragma unroll
        for (int ai = 0; ai < 2; ++ai)
#pragma unroll
            for (int m = 0; m < 4; ++m) { bf16_t* rowp = O + (size_t)(row0 + ai * HALF + m * 16) * ldc + col0;
#pragma unroll
                for (int bj = 0; bj < 2; ++bj) { f32x4 v0 = acc[ai][bj][m][0], v1 = acc[ai][bj][m][1];
                    if (ACT == 1) {
#pragma unroll
                        for (int j = 0; j < 4; ++j) { float a = v0[j] > 0.f ? v0[j] : 0.f; v0[j] = a * a; float b = v1[j] > 0.f ? v1[j] : 0.f; v1[j] = b * b; } }
                    u32x4 w; w.x = cvt_pk_bf16(v0[0], v0[1]); w.y = cvt_pk_bf16(v0[2], v0[3]); w.z = cvt_pk_bf16(v1[0], v1[1]); w.w = cvt_pk_bf16(v1[2], v1[3]);
                    *(u32x4*)(rowp + bj * HALF) = w; } }
    }
};
struct EpiRope {
    static constexpr bool PERM = true, AFTER_DRAIN = false;
    bf16_t* Q; bf16_t* KT; const float* rope; float qscale;
    __device__ __forceinline__ void operator()(const f32x4 (&acc)[2][2][4][2], const Unit& u, int wr, int wc, int fr, int fq) const {
        const int row0 = u.pm * BM + wr * 64 + fr; const int col0 = u.pn * BM + wc * 32 + 8 * fq;
        const int g = (wc & 1) * 4 + fq;
        const float sc = (u.pn < 2) ? qscale : 1.0f;
#pragma unroll
        for (int ai = 0; ai < 2; ++ai)
#pragma unroll
            for (int m = 0; m < 4; ++m) { const int row = row0 + ai * HALF + m * 16; const int pos = row & 4095;
                const f32x4 cs0 = *(const f32x4*)(rope + (size_t)pos * 64 + 8 * g), cs1 = *(const f32x4*)(rope + (size_t)pos * 64 + 8 * g + 4);
                const float c[4] = {cs0[0], cs0[2], cs1[0], cs1[2]}, s[4] = {cs0[1], cs0[3], cs1[1], cs1[3]};
                bf16_t* rowp;
                if (u.pn < 2) rowp = Q + (size_t)row * 512 + col0;
                else { const int ck = col0 - 512, hh = ck >> 7, cc = ck & 127; rowp = KT + ((size_t)(((row >> 12) * 4 + hh) * 64 + (pos >> 6)) * 8192 + (pos & 63) * 128 + cc); }
#pragma unroll
                for (int bj = 0; bj < 2; ++bj) { const f32x4 lo = acc[ai][bj][m][0], hi = acc[ai][bj][m][1]; float ol[4], oh[4];
#pragma unroll
                    for (int j = 0; j < 4; ++j) { ol[j] = (lo[j] * c[j] - hi[j] * s[j]) * sc; oh[j] = (hi[j] * c[j] + lo[j] * s[j]) * sc; }
                    u32x4 w; w.x = cvt_pk_bf16(ol[0], ol[1]); w.y = cvt_pk_bf16(ol[2], ol[3]); w.z = cvt_pk_bf16(oh[0], oh[1]); w.w = cvt_pk_bf16(oh[2], oh[3]);
                    *(u32x4*)(rowp + ((u.pn < 2) ? bj * HALF : bj * (64 * 8192))) = w; } }
    }
};
struct EpiUV {
    static constexpr bool PERM = true, AFTER_DRAIN = false;
    bf16_t* UT; bf16_t* VT;
    __device__ __forceinline__ void operator()(const f32x4 (&acc)[2][2][4][2], const Unit& u, int wr, int wc, int fr, int fq) const {
        const int row0 = u.pm * BM + wr * 64 + fr; const int col0 = u.pn * BM + wc * 32 + 8 * fq;
#pragma unroll
        for (int ai = 0; ai < 2; ++ai)
#pragma unroll
            for (int m = 0; m < 4; ++m) { const int row = row0 + ai * HALF + m * 16;
#pragma unroll
                for (int bj = 0; bj < 2; ++bj) { const int col = col0 + bj * HALF; bf16_t* p;
                    if (u.pm < 6) p = UT + (size_t)row * 32768 + col;
                    else { const int ev = row - 1536, hh = ev >> 7, ee = ev & 127, bb = col >> 12, pos = col & 4095;
                        p = VT + ((size_t)((bb * 4 + hh) * 64 + (pos >> 6)) * 8192 + ee * 64 + (pos & 48) + ((pos & 8) >> 1)); }
                    const f32x4 v0 = acc[ai][bj][m][0], v1 = acc[ai][bj][m][1];
                    u32x4 w; w.x = cvt_pk_bf16(v0[0], v0[1]); w.y = cvt_pk_bf16(v0[2], v0[3]); w.z = cvt_pk_bf16(v1[0], v1[1]); w.w = cvt_pk_bf16(v1[2], v1[3]);
                    if (u.pm < 6) *(u32x4*)p = w;
                    else { *(u32x2*)p = (u32x2){w.x, w.y}; *(u32x2*)(p + 8) = (u32x2){w.z, w.w}; } } }
    }
};

__device__ __forceinline__ void panel_sumsq(const f32x4 (&acc)[2][2][4][2], float* ss, unsigned* cnt, const Unit& u, int wr, int fr, int fq, int lane) {
#pragma unroll
    for (int ai = 0; ai < 2; ++ai)
#pragma unroll
        for (int m = 0; m < 4; ++m) { float s = 0.f;
#pragma unroll
            for (int bj = 0; bj < 2; ++bj)
#pragma unroll
                for (int n = 0; n < 2; ++n) { const f32x4 x = acc[ai][bj][m][n]; s += (x[0] * x[0] + x[1] * x[1]) + (x[2] * x[2] + x[3] * x[3]); }
            s += __shfl_xor(s, 16); s += __shfl_xor(s, 32);
            if (fq == 0) __hip_atomic_fetch_add(ss + u.pm * BM + ai * HALF + wr * 64 + m * 16 + fr, s, __ATOMIC_RELAXED, __HIP_MEMORY_SCOPE_AGENT); }
    asm volatile("s_waitcnt vmcnt(0)" ::: "memory");
    __syncthreads();
    if (threadIdx.x == 0) { __hip_atomic_fetch_add(cnt + u.pm, 1u, __ATOMIC_RELAXED, __HIP_MEMORY_SCOPE_AGENT);
        unsigned spins = 0;
        while (__hip_atomic_load(cnt + u.pm, __ATOMIC_RELAXED, __HIP_MEMORY_SCOPE_AGENT) < 4u) { __builtin_amdgcn_s_sleep(8); if (++spins > (1u << 20)) break; } }
    __syncthreads();
}
struct EpiNormRes {
    static constexpr bool PERM = true, AFTER_DRAIN = false;
    float* out; const float* gain; float* ss; unsigned* cnt; float eps;
    __device__ __forceinline__ void operator()(f32x4 (&acc)[2][2][4][2], const Unit& u, int wr, int wc, int fr, int fq) const {
        const int lane = fq * 16 + fr;
        panel_sumsq(acc, ss, cnt, u, wr, fr, fq, lane);
        const int row0 = u.pm * BM + wr * 64 + fr; const int col0 = u.pn * BM + wc * 32 + 8 * fq;
        f32x4 g[2][2];
#pragma unroll
        for (int bj = 0; bj < 2; ++bj) { g[bj][0] = *(const f32x4*)(gain + col0 + bj * HALF); g[bj][1] = *(const f32x4*)(gain + col0 + bj * HALF + 4); }
#pragma unroll
        for (int ai = 0; ai < 2; ++ai)
#pragma unroll
            for (int m = 0; m < 4; ++m) { const int row = row0 + ai * HALF + m * 16;
                const float r = 1.0f / sqrtf(__hip_atomic_load(ss + row, __ATOMIC_RELAXED, __HIP_MEMORY_SCOPE_AGENT) * (1.0f / 1024.0f) + eps);
                float* rowp = out + (size_t)row * 1024 + col0;
#pragma unroll
                for (int bj = 0; bj < 2; ++bj) { const f32x4 b0 = *(const f32x4*)(rowp + bj * HALF), b1 = *(const f32x4*)(rowp + bj * HALF + 4);
                    *(f32x4*)(rowp + bj * HALF) = b0 + acc[ai][bj][m][0] * r * g[bj][0]; *(f32x4*)(rowp + bj * HALF + 4) = b1 + acc[ai][bj][m][1] * r * g[bj][1]; } }
    }
};
struct EpiNormResNorm {
    static constexpr bool PERM = true, AFTER_DRAIN = false;
    const float* base; float* out; bf16_t* xn; const float* g1; const float* g2; float* ss1; float* ss2; unsigned* cnt1; unsigned* cnt2; float eps;
    __device__ __forceinline__ void operator()(f32x4 (&acc)[2][2][4][2], const Unit& u, int wr, int wc, int fr, int fq) const {
        const int lane = fq * 16 + fr;
        panel_sumsq(acc, ss1, cnt1, u, wr, fr, fq, lane);
        const int row0 = u.pm * BM + wr * 64 + fr; const int col0 = u.pn * BM + wc * 32 + 8 * fq;
        { f32x4 g[2][2];
#pragma unroll
          for (int bj = 0; bj < 2; ++bj) { g[bj][0] = *(const f32x4*)(g1 + col0 + bj * HALF); g[bj][1] = *(const f32x4*)(g1 + col0 + bj * HALF + 4); }
#pragma unroll
          for (int ai = 0; ai < 2; ++ai)
#pragma unroll
            for (int m = 0; m < 4; ++m) { const int row = row0 + ai * HALF + m * 16;
                const float r = 1.0f / sqrtf(__hip_atomic_load(ss1 + row, __ATOMIC_RELAXED, __HIP_MEMORY_SCOPE_AGENT) * (1.0f / 1024.0f) + eps);
                const float* bp = base + (size_t)row * 1024 + col0; float* rowp = out + (size_t)row * 1024 + col0;
#pragma unroll
                for (int bj = 0; bj < 2; ++bj) { const f32x4 b0 = *(const f32x4*)(bp + bj * HALF), b1 = *(const f32x4*)(bp + bj * HALF + 4);
                    const f32x4 x0 = b0 + acc[ai][bj][m][0] * r * g[bj][0], x1 = b1 + acc[ai][bj][m][1] * r * g[bj][1];
                    acc[ai][bj][m][0] = x0; acc[ai][bj][m][1] = x1;
                    *(f32x4*)(rowp + bj * HALF) = x0; *(f32x4*)(rowp + bj * HALF + 4) = x1; } } }
        panel_sumsq(acc, ss2, cnt2, u, wr, fr, fq, lane);
        { f32x4 g[2][2];
#pragma unroll
          for (int bj = 0; bj < 2; ++bj) { g[bj][0] = *(const f32x4*)(g2 + col0 + bj * HALF); g[bj][1] = *(const f32x4*)(g2 + col0 + bj * HALF + 4); }
#pragma unroll
          for (int ai = 0; ai < 2; ++ai)
#pragma unroll
            for (int m = 0; m < 4; ++m) { const int row = row0 + ai * HALF + m * 16;
                const float r = 1.0f / sqrtf(__hip_atomic_load(ss2 + row, __ATOMIC_RELAXED, __HIP_MEMORY_SCOPE_AGENT) * (1.0f / 1024.0f) + eps);
                bf16_t* xp = xn + (size_t)row * 1024 + col0;
#pragma unroll
                for (int bj = 0; bj < 2; ++bj) { const f32x4 v0 = acc[ai][bj][m][0] * r * g[bj][0], v1 = acc[ai][bj][m][1] * r * g[bj][1];
                    u32x4 w; w.x = cvt_pk_bf16(v0[0], v0[1]); w.y = cvt_pk_bf16(v0[2], v0[3]); w.z = cvt_pk_bf16(v1[0], v1[1]); w.w = cvt_pk_bf16(v1[2], v1[3]);
                    *(u32x4*)(xp + bj * HALF) = w; } } }
    }
};
template <class Epi, class Sched, bool ALIGN_EPI = false, bool SP2 = false>
__device__ __forceinline__ void gemm_phase(PG8_LAS unsigned char* lds, const Gemm g, const Sched& S, const Epi& E) {
    const int tid = threadIdx.x, wid = __builtin_amdgcn_readfirstlane(tid >> 6), lane = tid & 63, wr = wid >> 2, wc = wid & 3, fr = lane & 15, fq = lane >> 4;
    const int K = g.K, nt = K / BK;
    unsigned voffA[2], voffB[2];
#pragma unroll
    for (int i = 0; i < 2; ++i) { int R, C; stage_rc(tid * 16 + i * 8192, R, C); const int Rb = Epi::PERM ? ((R & ~31) + perm32(R & 31)) : R;
        voffA[i] = (unsigned)(R * K + C) * 2u; voffB[i] = (unsigned)(Rb * K + C) * 2u; }
    const size_t kstep = (size_t)(BK * 2);
    const size_t hstep = (size_t)HALF * K * 2;
    const size_t tstep = 2 * hstep;
    const unsigned ldsw = (unsigned)wid * 1024u;
    const int aoff = lds_byte(wr * 64 + fr, fq * 8), boff = lds_byte(wc * 32 + fr, fq * 8);
#define PG8_SA(b, h) (((b) * 2 + (h)) * HTB)
#define PG8_SB(b, h) ((4 + (b) * 2 + (h)) * HTB)
#define PG8_STAGE(bufoff, gbase, voff) do { _Pragma("unroll") for (int _i = 0; _i < 2; ++_i) \
        __builtin_amdgcn_global_load_lds((const unsigned*)((const char*)(gbase) + (voff)[_i]), (PG8_LAS unsigned*)(lds + (bufoff) + ldsw + _i * 8192), 16, 0, 0); } while (0)
#define PG8_LDA(dst, b, h) do { _Pragma("unroll") for (int m = 0; m < 4; ++m) _Pragma("unroll") for (int k = 0; k < 2; ++k) dst[m][k] = *(const PG8_LAS bf16x8*)(lds + PG8_SA(b, h) + aoff + m * 2048 + k * 1024); } while (0)
#define PG8_LDB(dst, b, h) do { _Pragma("unroll") for (int n = 0; n < 2; ++n) _Pragma("unroll") for (int k = 0; k < 2; ++k) dst[n][k] = *(const PG8_LAS bf16x8*)(lds + PG8_SB(b, h) + boff + n * 2048 + k * 1024); } while (0)
#define PG8_MMA(ai, bj, At, Bt) do { __builtin_amdgcn_s_setprio(1); _Pragma("unroll") for (int m = 0; m < 4; ++m) _Pragma("unroll") for (int n = 0; n < 2; ++n) _Pragma("unroll") for (int k = 0; k < 2; ++k) \
        acc[ai][bj][m][n] = __builtin_amdgcn_mfma_f32_16x16x32_bf16(Bt[n][k], At[m][k], acc[ai][bj][m][n], 0, 0, 0); __builtin_amdgcn_s_setprio(0); } while (0)
#define PG8_WAIT_V(n) asm volatile("s_waitcnt vmcnt(" #n ")" ::: "memory")
#define PG8_WAIT_L(n) asm volatile("s_waitcnt lgkmcnt(" #n ")" ::: "memory")
#define PG8_BAR __builtin_amdgcn_s_barrier()
#define PG8_SCHED __builtin_amdgcn_sched_barrier(0)
    Unit cur, nxt; int ui = 0;
    if (!S.next(0, cur)) return;
    f32x4 acc[2][2][4][2];
#pragma unroll
    for (int a = 0; a < 2; ++a)
#pragma unroll
        for (int b = 0; b < 2; ++b)
#pragma unroll
            for (int m = 0; m < 4; ++m)
#pragma unroll
                for (int n = 0; n < 2; ++n) acc[a][b][m][n] = (f32x4){0.f, 0.f, 0.f, 0.f};
    bf16x8 At[4][2], B0[2][2], B1[2][2];
    const char* cA = (const char*)g.A + (size_t)cur.pm * tstep; const char* cB = (const char*)g.Bt + (size_t)cur.pn * tstep;
    S.a_ready(cur);
    if constexpr (SP2) {
        PG8_STAGE(PG8_SB(0, 0), cB, voffB); PG8_STAGE(PG8_SB(0, 1), cB + hstep, voffB); PG8_STAGE(PG8_SA(0, 0), cA, voffA); PG8_STAGE(PG8_SA(0, 1), cA + hstep, voffA);
        if (wr == 1) PG8_BAR;
        PG8_WAIT_V(2); PG8_BAR;
        PG8_STAGE(PG8_SB(1, 0), cB + kstep, voffB); PG8_STAGE(PG8_SA(1, 0), cA + kstep, voffA); PG8_STAGE(PG8_SB(1, 1), cB + hstep + kstep, voffB);
        PG8_WAIT_V(6); PG8_BAR;
    } else {
        PG8_STAGE(PG8_SB(0, 0), cB, voffB); PG8_STAGE(PG8_SA(0, 0), cA, voffA); PG8_STAGE(PG8_SB(0, 1), cB + hstep, voffB); PG8_STAGE(PG8_SA(0, 1), cA + hstep, voffA);
        if (wr == 1) PG8_BAR;
        PG8_WAIT_V(4); PG8_BAR;
        PG8_STAGE(PG8_SB(1, 0), cB + kstep, voffB); PG8_STAGE(PG8_SA(1, 0), cA + kstep, voffA); PG8_STAGE(PG8_SB(1, 1), cB + hstep + kstep, voffB);
        PG8_WAIT_V(6); PG8_BAR;
    }
    for (;;) {
        const bool has_next = S.next(ui + 1, nxt);
        const char* nA = has_next ? (const char*)g.A + (size_t)nxt.pm * tstep : cA; const char* nB = has_next ? (const char*)g.Bt + (size_t)nxt.pn * tstep : cB;
        for (int t = 0; t < nt; t += 2) {
            const bool last = (t == nt - 2);
            const char* a1 = cA + (size_t)(t + 1) * kstep;
            const char* a2 = last ? nA : cA + (size_t)(t + 2) * kstep; const char* b2 = last ? nB : cB + (size_t)(t + 2) * kstep;
            const char* a3 = a2 + kstep; const char* b3 = b2 + kstep;
            if (last && has_next) S.a_ready(nxt);
            if constexpr (SP2) {
            PG8_LDB(B0, 0, 0); PG8_LDB(B1, 0, 1); PG8_SCHED; PG8_LDA(At, 0, 0); PG8_STAGE(PG8_SA(1, 1), a1 + hstep, voffA);
            PG8_WAIT_V(8); PG8_WAIT_L(0); PG8_BAR; PG8_MMA(0, 0, At, B0); PG8_MMA(0, 1, At, B1); PG8_BAR; PG8_SCHED;
            PG8_LDA(At, 0, 1); PG8_STAGE(PG8_SB(0, 0), b2, voffB); PG8_STAGE(PG8_SB(0, 1), b2 + hstep, voffB); PG8_STAGE(PG8_SA(0, 0), a2, voffA);
            PG8_WAIT_V(8); PG8_WAIT_L(0); PG8_BAR; PG8_MMA(1, 0, At, B0); PG8_MMA(1, 1, At, B1); PG8_BAR; PG8_SCHED;
            PG8_LDB(B0, 1, 0); PG8_LDB(B1, 1, 1); PG8_SCHED; PG8_LDA(At, 1, 0); PG8_STAGE(PG8_SA(0, 1), a2 + hstep, voffA);
            PG8_WAIT_V(8); PG8_WAIT_L(0); PG8_BAR; PG8_MMA(0, 0, At, B0); PG8_MMA(0, 1, At, B1); PG8_BAR; PG8_SCHED;
            PG8_LDA(At, 1, 1); PG8_STAGE(PG8_SB(1, 0), b3, voffB); PG8_STAGE(PG8_SB(1, 1), b3 + hstep, voffB); PG8_STAGE(PG8_SA(1, 0), a3, voffA);
            PG8_WAIT_V(8); PG8_WAIT_L(0); PG8_BAR; PG8_MMA(1, 0, At, B0); PG8_MMA(1, 1, At, B1); PG8_BAR; PG8_SCHED;
            } else {
            PG8_LDB(B0, 0, 0); PG8_SCHED; PG8_LDA(At, 0, 0); PG8_STAGE(PG8_SA(1, 1), a1 + hstep, voffA);
            PG8_WAIT_L(8); PG8_BAR; PG8_WAIT_L(0); PG8_MMA(0, 0, At, B0); PG8_BAR; PG8_SCHED;
            PG8_LDB(B1, 0, 1); PG8_STAGE(PG8_SB(0, 0), b2, voffB);
            PG8_BAR; PG8_WAIT_L(0); PG8_MMA(0, 1, At, B1); PG8_BAR;
            PG8_LDA(At, 0, 1); PG8_STAGE(PG8_SA(0, 0), a2, voffA);
            PG8_BAR; PG8_WAIT_L(0); PG8_MMA(1, 0, At, B0); PG8_BAR; PG8_SCHED;
            PG8_STAGE(PG8_SB(0, 1), b2 + hstep, voffB);
            PG8_WAIT_V(6); PG8_BAR; PG8_MMA(1, 1, At, B1); PG8_BAR;
            PG8_LDB(B0, 1, 0); PG8_SCHED; PG8_LDA(At, 1, 0); PG8_STAGE(PG8_SA(0, 1), a2 + hstep, voffA);
            PG8_WAIT_L(8); PG8_BAR; PG8_WAIT_L(0); PG8_MMA(0, 0, At, B0); PG8_BAR; PG8_SCHED;
            PG8_LDB(B1, 1, 1); PG8_STAGE(PG8_SB(1, 0), b3, voffB);
            PG8_BAR; PG8_WAIT_L(0); PG8_MMA(0, 1, At, B1); PG8_BAR;
            PG8_LDA(At, 1, 1); PG8_STAGE(PG8_SA(1, 0), a3, voffA);
            PG8_BAR; PG8_WAIT_L(0); PG8_MMA(1, 0, At, B0); PG8_BAR; PG8_SCHED;
            PG8_STAGE(PG8_SB(1, 1), b3 + hstep, voffB);
            PG8_WAIT_V(6); PG8_BAR; PG8_MMA(1, 1, At, B1); PG8_BAR;
            }
        }
        if constexpr (ALIGN_EPI) { if (wr == 0) PG8_BAR; }
        if constexpr (!Epi::AFTER_DRAIN) { E(acc, cur, wr, wc, fr, fq); S.done(cur); }
        if (!has_next) break;
#pragma unroll
        for (int a = 0; a < 2; ++a)
#pragma unroll
            for (int b = 0; b < 2; ++b)
#pragma unroll
                for (int m = 0; m < 4; ++m)
#pragma unroll
                    for (int n = 0; n < 2; ++n) acc[a][b][m][n] = (f32x4){0.f, 0.f, 0.f, 0.f};
        cur = nxt; cA = nA; cB = nB; ++ui;
        if constexpr (ALIGN_EPI) { if (wr == 1) PG8_BAR; }
    }
    PG8_WAIT_V(0);
    if constexpr (!ALIGN_EPI) { if (wr == 0) PG8_BAR; }
    PG8_BAR;
    if constexpr (Epi::AFTER_DRAIN) { E.fused(acc, cur, wr, wc, fr, fq, lds, wid, lane); S.done(cur); }
#undef PG8_SA
#undef PG8_SB
#undef PG8_STAGE
#undef PG8_LDA
#undef PG8_LDB
#undef PG8_MMA
#undef PG8_WAIT_V
#undef PG8_WAIT_L
#undef PG8_BAR
#undef PG8_SCHED
}
}

constexpr int BATCH = 8, SEQ = 4096, DM = 1024, MTOK = BATCH * SEQ, HYW = 512, NIN = 3072, DFF = 4096;
constexpr int NWAVES = 8, NTHR = 512;
constexpr float NORM_EPS = 1e-6f, SUBLN_EPS = 1e-5f;
constexpr float QSCALE = 0.125f * 1.4426950408889634f;
constexpr int HRLEN = 8224;
constexpr size_t MiB = 1u << 20;
constexpr size_t WS_WIN = 0, WS_WOUT = 6 * MiB, WS_WUP = 8 * MiB, WS_WDOWN = 16 * MiB;
constexpr size_t WS_HR = 24 * MiB;
constexpr size_t WS_ROPE = 33 * MiB;
constexpr size_t WS_CTL = 34 * MiB, CTL_BYTES = 16384 + 3 * 131072;
constexpr size_t CTL_CNT = 14336, CTL_SS = 16384;
constexpr size_t WS_XN = 40 * MiB;
constexpr size_t WS_MO = 104 * MiB;
constexpr size_t WS_YT = 168 * MiB;
constexpr size_t WS_UVT = 200 * MiB;
constexpr size_t WS_QK = 328 * MiB;
constexpr size_t WS_KT = 360 * MiB;
constexpr size_t WS_VT = 296 * MiB;
constexpr size_t WS_MIX = 392 * MiB;
constexpr size_t WS_H = 200 * MiB;
constexpr size_t WS_END = 456 * MiB;
constexpr int LDS_BYTES = 135168;

#define LAS __attribute__((address_space(3)))
typedef unsigned short bf16;
typedef unsigned u32x4 __attribute__((ext_vector_type(4)));
typedef unsigned u32x2 __attribute__((ext_vector_type(2)));
typedef float f32x4 __attribute__((ext_vector_type(4)));
typedef float f32x16 __attribute__((ext_vector_type(16)));
typedef short bf16x8 __attribute__((ext_vector_type(8)));
typedef short s16x4 __attribute__((ext_vector_type(4)));

__device__ __forceinline__ unsigned f2bf(float f) { unsigned u = __builtin_bit_cast(unsigned, f); return (u + 0x7fffu + ((u >> 16) & 1u)) >> 16; }
__device__ __forceinline__ unsigned pk2(float lo, float hi) { return f2bf(lo) | (f2bf(hi) << 16); }
typedef float f32x2_t __attribute__((ext_vector_type(2))); typedef __bf16 bf16x2_t __attribute__((ext_vector_type(2)));
__device__ __forceinline__ unsigned cvtpk(float lo, float hi) { f32x2_t v = {lo, hi}; bf16x2_t b = __builtin_convertvector(v, bf16x2_t); return __builtin_bit_cast(unsigned, b); }
__device__ __forceinline__ float bf2f(unsigned short b) { return __builtin_bit_cast(float, (unsigned)b << 16); }
__device__ __forceinline__ float bflo(unsigned w) { return __builtin_bit_cast(float, w << 16); }
__device__ __forceinline__ float bfhi(unsigned w) { return __builtin_bit_cast(float, w & 0xffff0000u); }
__device__ __forceinline__ float wave_sum(float v) {
#pragma unroll
    for (int o = 1; o < 64; o <<= 1) v += __shfl_xor(v, o);
    return v;
}
__device__ __forceinline__ float swap_hi(float v) { return __shfl_xor(v, 32); }
#define LDS_WAIT() asm volatile("s_waitcnt lgkmcnt(0)" ::: "memory")

struct Args { const float* in[25]; float* out; unsigned char* ws; int ph_lo, ph_hi; };

__device__ __forceinline__ int win_src(int n) {
    if (n < 1536) return n;
    if (n < 2048) return n + 1024;
    const int pp = n - 2048, grp = pp >> 6, p = pp & 63, g = p >> 3, e = p & 7;
    const int d = (e < 4) ? (4 * g + e) : (32 + 4 * g + (e - 4));
    return 1536 + grp * 64 + d;
}
template <bool PERMW>
__device__ __forceinline__ void p0_transpose_item(const float* W, int K, int N, bf16* WT, LAS float* scr, int item, int lane) {
    const int nblk = N / 32, kb = item / nblk, nb = item % nblk, k0 = 64 * kb, n0 = 32 * nb;
    const int sc = PERMW ? win_src(n0 + (lane & 31)) : (n0 + (lane & 31));
#pragma unroll 8
    for (int i = 0; i < 32; ++i) { const int kk = 2 * i + (lane >> 5); scr[kk * 33 + (lane & 31)] = W[(size_t)(k0 + kk) * N + sc]; }
    LDS_WAIT(); asm volatile("" ::: "memory");
    const int c = lane & 7;
#pragma unroll
    for (int j = 0; j < 4; ++j) { const int n = (lane >> 3) + 8 * j; const LAS float* s = scr + (8 * c) * 33 + n;
        u32x4 o; o.x = pk2(s[0 * 33], s[1 * 33]); o.y = pk2(s[2 * 33], s[3 * 33]); o.z = pk2(s[4 * 33], s[5 * 33]); o.w = pk2(s[6 * 33], s[7 * 33]);
        *(u32x4*)(WT + (size_t)(n0 + n) * K + k0 + 8 * c) = o; }
    LDS_WAIT(); asm volatile("" ::: "memory");
}
__device__ __forceinline__ void rms_row_to_bf16(const float* xrow, const float* gain, bf16* orow, int lane) {
    const f32x4* xr = (const f32x4*)xrow + lane; const f32x4* gr = (const f32x4*)gain + lane;
    f32x4 v[4]; float s = 0.f;
#pragma unroll
    for (int j = 0; j < 4; ++j) { v[j] = xr[64 * j]; s += (v[j].x * v[j].x + v[j].y * v[j].y) + (v[j].z * v[j].z + v[j].w * v[j].w); }
    const float r = 1.0f / sqrtf(wave_sum(s) * (1.f / DM) + NORM_EPS);
    unsigned long long* o8 = (unsigned long long*)orow + lane;
#pragma unroll
    for (int j = 0; j < 4; ++j) { const f32x4 g = gr[64 * j];
        o8[64 * j] = (unsigned long long)pk2(v[j].x * r * g.x, v[j].y * r * g.y) | ((unsigned long long)pk2(v[j].z * r * g.z, v[j].w * r * g.w) << 32); }
}

__device__ __forceinline__ void filter_item(LAS unsigned char* lds, const Args& a, bf16* HR, int pg, int tid) {
    LAS float* Z = (LAS float*)lds;
    LAS float* HA = Z + 16 * 33;
    LAS float* HB = HA + 16 * 64;
    LAS float* W1 = HB + 16 * 64;
    LAS float* W2 = W1 + 33 * 64;
    LAS float* W3 = W2 + 64 * 64;
    const float* w1 = a.in[6]; const float* b1 = a.in[7]; const float* w2 = a.in[8]; const float* b2 = a.in[9];
    const float* w3 = a.in[10]; const float* b3 = a.in[11]; const float* w4 = a.in[12]; const float* freq = a.in[13]; const float* fbias = a.in[14];
    const int t0 = 16 * pg;
    for (int i = tid; i < 33 * 64; i += NTHR) W1[i] = w1[i];
    for (int i = tid; i < 64 * 64; i += NTHR) { W2[i] = w2[i]; W3[i] = w3[i]; }
    for (int i = tid; i < 16 * 33; i += NTHR) { const int p = i / 33, f = i % 33; const int pos = t0 + p; float val;
        if (f == 0) val = (float)pos * (1.0f / (float)(SEQ - 1));
        else { const int j = (f - 1) & 15; const float fj = 1e-4f + (float)j * ((15.0f - 1e-4f) / 15.0f); const float w = (6.283185307179586f / (float)SEQ) * (float)pos; const float arg = fj * w;
            val = (f <= 16) ? cosf(arg) : -sinf(arg); }
        Z[i] = val; }
    __syncthreads();
    for (int o = tid; o < 1024; o += NTHR) { const int p = o >> 6, n = o & 63; float acc = b1[n];
#pragma unroll 3
        for (int f = 0; f < 33; ++f) acc += Z[p * 33 + f] * W1[f * 64 + n];
        HA[o] = sinf(freq[n] * acc); }
    __syncthreads();
    for (int o = tid; o < 1024; o += NTHR) { const int p = o >> 6, n = o & 63; float acc = b2[n];
#pragma unroll 4
        for (int f = 0; f < 64; ++f) acc += HA[p * 64 + f] * W2[f * 64 + n];
        HB[o] = sinf(freq[n] * acc); }
    __syncthreads();
    for (int o = tid; o < 1024; o += NTHR) { const int p = o >> 6, n = o & 63; float acc = b3[n];
#pragma unroll 4
        for (int f = 0; f < 64; ++f) acc += HB[p * 64 + f] * W3[f * 64 + n];
        HA[o] = sinf(freq[n] * acc); }
    __syncthreads();
    {   const int c = tid;
        float af[16], ab[16];
#pragma unroll
        for (int p = 0; p < 16; ++p) { af[p] = 0.f; ab[p] = 0.f; }
        for (int k0 = 0; k0 < 64; k0 += 8) { float wf[8], wb[8];
#pragma unroll
            for (int kk = 0; kk < 8; ++kk) { wf[kk] = w4[(k0 + kk) * 1024 + c]; wb[kk] = w4[(k0 + kk) * 1024 + 512 + c]; }
#pragma unroll
            for (int kk = 0; kk < 8; ++kk)
#pragma unroll
                for (int p = 0; p < 16; ++p) { const float hv = HA[p * 64 + k0 + kk]; af[p] += hv * wf[kk]; ab[p] += hv * wb[kk]; } }
        const float min_decay = -4.605170185988091f / 1.5f, max_decay = -4.605170185988091f / 0.3f;
        const float adelta = fabsf(min_decay + (float)c * ((max_decay - min_decay) / 511.0f));
        bf16* hr = HR + (size_t)c * HRLEN;
#pragma unroll
        for (int p = 0; p < 16; ++p) { const int pos = t0 + p; const float tl = (float)pos * (1.0f / (float)(SEQ - 1)); const float dec = expf(-tl * adelta);
            const float vf = af[p] * dec, vb = ab[p] * dec;
            if (pos == 0) hr[4096] = (bf16)f2bf(vf + vb + fbias[c]);
            else { hr[4096 - pos] = (bf16)f2bf(vf); hr[4096 + pos] = (bf16)f2bf(vb); } }
        if (pg == 0) { hr[0] = 0; for (int i = 8192; i < HRLEN; ++i) hr[i] = 0; }
    }
    __syncthreads();
}

namespace att {
constexpr int KP = 272, VP = 144, KBUF = 64 * KP, VBUF = 128 * VP, VOFF = 2 * KBUF;
constexpr int NT = SEQ / 64;
__device__ __forceinline__ float max3(float a, float b, float c) { return fmaxf(fmaxf(a, b), c); }
__device__ __forceinline__ float fadd_s(float a, float b) { float r; asm("v_add_f32_e32 %0, %1, %2" : "=v"(r) : "v"(a), "v"(b)); return r; }
#define SBAR() __builtin_amdgcn_sched_barrier(0)
__device__ __forceinline__ void v_load(bf16x8 (&vf)[4], const LAS unsigned char* vb, int ks) {
#pragma unroll
    for (int e = 0; e < 4; ++e) vf[e] = *(const LAS bf16x8*)(vb + e * 32 * VP + ks * 32);
}
__device__ __forceinline__ void pv_tile(f32x16 (&o)[4], const u32x4 (&P)[4], bf16x8 (&vf0)[4], const LAS unsigned char* vb) {
    bf16x8 vf1[4];
#pragma unroll
    for (int ks = 0; ks < 4; ++ks) { const bf16x8 pb = __builtin_bit_cast(bf16x8, P[ks]);
        if (ks == 0 || ks == 2) v_load(vf1, vb, ks + 1); else if (ks == 1) v_load(vf0, vb, 2);
        SBAR(); __builtin_amdgcn_s_setprio(1);
#pragma unroll
        for (int e = 0; e < 4; ++e) o[e] = __builtin_amdgcn_mfma_f32_32x32x16_bf16((ks & 1) ? vf1[e] : vf0[e], pb, o[e], 0, 0, 0);
        __builtin_amdgcn_s_setprio(0); SBAR(); }
}
__device__ __forceinline__ float xhalf_max(float v) { auto rr = __builtin_amdgcn_permlane32_swap(__float_as_uint(v), __float_as_uint(v), false, false); return fmaxf(__uint_as_float(rr[0]), __uint_as_float(rr[1])); }
__device__ __forceinline__ float xhalf_sum(float v) { auto rr = __builtin_amdgcn_permlane32_swap(__float_as_uint(v), __float_as_uint(v), false, false); return __uint_as_float(rr[0]) + __uint_as_float(rr[1]); }
constexpr int QOFF = 2 * KBUF + 3 * VBUF;
#define ATT_SLOT(T, PKW, PVW, PKL, PVL) do { const int t = (T); \
        const LAS unsigned char* kst = lds + (t & 1) * KBUF; \
        bf16x8 vf0[4]; \
        if (c == 1 && t > 0 && VAR != 5) { v_load(vf0, lds + VOFF + vprev + voff, 0); pv_tile(o, P, vf0, lds + VOFF + vprev + voff); } \
        if (t + 2 < NT && VAR != 4) { _Pragma("unroll") for (int i = 0; i < 2; ++i) { PKL[i] = *(const u32x4*)(gk[i] + (size_t)(t + 2) * 8192); PVL[i] = *(const u32x4*)(gv[i] + (size_t)(t + 2) * 8192); } } \
        SBAR(); \
        f32x16 s0, s1; \
        { const LAS unsigned char* kb = kst + r32 * KP + c * 128 + hi * 16; const LAS unsigned char* qb_ = lds + QOFF + wid * 4096 + lane * 16; \
          bf16x8 ka[4], kc2[4], qa[2], qc[2]; \
          qa[0] = *(const LAS bf16x8*)(qb_); qa[1] = *(const LAS bf16x8*)(qb_ + 1024); \
          ka[0] = *(const LAS bf16x8*)(kb); ka[1] = *(const LAS bf16x8*)(kb + 32 * KP); ka[2] = *(const LAS bf16x8*)(kb + 32); ka[3] = *(const LAS bf16x8*)(kb + 32 * KP + 32); \
          SBAR(); \
          qc[0] = *(const LAS bf16x8*)(qb_ + 2048); qc[1] = *(const LAS bf16x8*)(qb_ + 3072); \
          kc2[0] = *(const LAS bf16x8*)(kb + 64); kc2[1] = *(const LAS bf16x8*)(kb + 32 * KP + 64); kc2[2] = *(const LAS bf16x8*)(kb + 96); kc2[3] = *(const LAS bf16x8*)(kb + 32 * KP + 96); \
          __builtin_amdgcn_s_setprio(1); s0 = __builtin_amdgcn_mfma_f32_32x32x16_bf16(ka[0], qa[0], zero16, 0, 0, 0); s1 = __builtin_amdgcn_mfma_f32_32x32x16_bf16(ka[1], qa[0], zero16, 0, 0, 0); \
          s0 = __builtin_amdgcn_mfma_f32_32x32x16_bf16(ka[2], qa[1], s0, 0, 0, 0); s1 = __builtin_amdgcn_mfma_f32_32x32x16_bf16(ka[3], qa[1], s1, 0, 0, 0); \
          SBAR(); \
          s0 = __builtin_amdgcn_mfma_f32_32x32x16_bf16(kc2[0], qc[0], s0, 0, 0, 0); s1 = __builtin_amdgcn_mfma_f32_32x32x16_bf16(kc2[1], qc[0], s1, 0, 0, 0); \
          s0 = __builtin_amdgcn_mfma_f32_32x32x16_bf16(kc2[2], qc[1], s0, 0, 0, 0); s1 = __builtin_amdgcn_mfma_f32_32x32x16_bf16(kc2[3], qc[1], s1, 0, 0, 0); __builtin_amdgcn_s_setprio(0); } \
        if (c == 0 && VAR != 5) v_load(vf0, lds + VOFF + vcur + voff, 0); \
        SBAR(); \
        if (VAR != 6) { float mx = max3(s0[0], s1[0], s0[1]); \
        mx = max3(mx, s1[1], s0[2]); mx = max3(mx, s1[2], s0[3]); mx = max3(mx, s1[3], s0[4]); mx = max3(mx, s1[4], s0[5]); \
        mx = max3(mx, s1[5], s0[6]); mx = max3(mx, s1[6], s0[7]); mx = max3(mx, s1[7], s0[8]); mx = max3(mx, s1[8], s0[9]); \
        mx = max3(mx, s1[9], s0[10]); mx = max3(mx, s1[10], s0[11]); mx = max3(mx, s1[11], s0[12]); mx = max3(mx, s1[12], s0[13]); \
        mx = max3(mx, s1[13], s0[14]); mx = max3(mx, s1[14], s0[15]); mx = fmaxf(mx, s1[15]); \
        mx = xhalf_max(mx); \
        if (t == 0) { if (__any(fabsf(mx) > 8.0f)) { mref = mx; gen = true; } } \
        else if (__any(mx > mref + 8.0f)) { const float mnew = fmaxf(mx, mref); const float al = __builtin_amdgcn_exp2f(mref - mnew); \
            _Pragma("unroll") for (int e = 0; e < 4; ++e) _Pragma("unroll") for (int r = 0; r < 16; ++r) o[e][r] *= al; \
            lsum *= al; mref = mnew; gen = true; } \
        float ps0 = 0.f, ps1 = 0.f; \
        if (gen) { _Pragma("unroll") for (int r = 0; r < 16; ++r) { s0[r] = __builtin_amdgcn_exp2f(s0[r] - mref); s1[r] = __builtin_amdgcn_exp2f(s1[r] - mref); ps0 += s0[r]; ps0 += s1[r]; } } \
        else { _Pragma("unroll") for (int r = 0; r < 16; ++r) { s0[r] = __builtin_amdgcn_exp2f(s0[r]); s1[r] = __builtin_amdgcn_exp2f(s1[r]); ps0 += s0[r]; ps0 += s1[r]; } } \
        lsum += ps0 + ps1; } \
        P[0] = (u32x4){cvtpk(s0[0], s0[1]), cvtpk(s0[2], s0[3]), cvtpk(s0[4], s0[5]), cvtpk(s0[6], s0[7])}; \
        P[1] = (u32x4){cvtpk(s0[8], s0[9]), cvtpk(s0[10], s0[11]), cvtpk(s0[12], s0[13]), cvtpk(s0[14], s0[15])}; \
        P[2] = (u32x4){cvtpk(s1[0], s1[1]), cvtpk(s1[2], s1[3]), cvtpk(s1[4], s1[5]), cvtpk(s1[6], s1[7])}; \
        P[3] = (u32x4){cvtpk(s1[8], s1[9]), cvtpk(s1[10], s1[11]), cvtpk(s1[12], s1[13]), cvtpk(s1[14], s1[15])}; \
        if (c == 0 && VAR != 5) pv_tile(o, P, vf0, lds + VOFF + vcur + voff); \
        if (t + 1 < NT && VAR != 4) { LAS unsigned char* kn = lds + ((t + 1) & 1) * KBUF; LAS unsigned char* vn = lds + vnext; \
            _Pragma("unroll") for (int i = 0; i < 2; ++i) { *(LAS u32x4*)(kn + lk[i]) = PKW[i]; *(LAS u32x4*)(vn + lv[i]) = PVW[i]; } } \
        { const int tmp = vprev; vprev = vcur; vcur = vnext; vnext = tmp; } \
        if (VAR != 3) { asm volatile("s_waitcnt lgkmcnt(0)\n\ts_barrier" ::: "memory"); } \
    } while (0)
template <int VAR> __device__ __forceinline__ void unit(LAS unsigned char* lds, const bf16* QK, const bf16* KT, const bf16* VT, bf16* MIX, const float* sgain, float lam, int b, int h, int qb) {
    const int tid = threadIdx.x, lane = tid & 63, r32 = lane & 31, hi = lane >> 5; const int wid = __builtin_amdgcn_readfirstlane(tid >> 6);
    const int qsub = wid & 3, c = wid >> 2;
    const size_t rowbase = (size_t)b * SEQ; const int q0 = qb * 128 + qsub * 32;
    { const bf16* qp = QK + (rowbase + q0 + r32) * 512 + h * 128 + c * 64 + hi * 8;
#pragma unroll
      for (int ds = 0; ds < 4; ++ds) *(LAS bf16x8*)(lds + QOFF + wid * 4096 + ds * 1024 + lane * 16) = *(const bf16x8*)(qp + ds * 16); }
    const bf16* gk[2]; const bf16* gv[2]; int lk[2], lv[2];
#pragma unroll
    for (int i = 0; i < 2; ++i) { const int id = tid + NTHR * i; const int kr = id >> 4, kc = id & 15; const int ve = id >> 3, vc = id & 7;
        gk[i] = KT + (size_t)(b * 4 + h) * 64 * 8192 + id * 8; lk[i] = kr * KP + kc * 16;
        gv[i] = VT + (size_t)(b * 4 + h) * 64 * 8192 + id * 8; lv[i] = VOFF + ve * VP + vc * 16; }
    u32x4 pkA[2], pvA[2], pkB[2], pvB[2];
#pragma unroll
    for (int i = 0; i < 2; ++i) { pkA[i] = *(const u32x4*)gk[i]; pvA[i] = *(const u32x4*)gv[i]; }
#pragma unroll
    for (int i = 0; i < 2; ++i) { pkB[i] = *(const u32x4*)(gk[i] + 8192); pvB[i] = *(const u32x4*)(gv[i] + 8192); }
#pragma unroll
    for (int i = 0; i < 2; ++i) { *(LAS u32x4*)(lds + lk[i]) = pkA[i]; *(LAS u32x4*)(lds + lv[i]) = pvA[i]; }
    __syncthreads();
    f32x16 o[4];
#pragma unroll
    for (int e = 0; e < 4; ++e) o[e] = (f32x16){};
    const f32x16 zero16 = (f32x16){};
    float mref = 0.f, lsum = 0.f; bool gen = false;
    u32x4 P[4];
#pragma unroll
    for (int ks = 0; ks < 4; ++ks) P[ks] = (u32x4){0u, 0u, 0u, 0u};
    int vcur = 0, vprev = 2 * VBUF, vnext = VBUF;
    const int voff = r32 * VP + hi * 16;
    for (int tt = 0; tt < NT; tt += 2) {
        ATT_SLOT(tt, pkB, pvB, pkA, pvA);
        ATT_SLOT(tt + 1, pkA, pvA, pkB, pvB);
    }
    if (c == 1) { bf16x8 vf0[4]; v_load(vf0, lds + VOFF + vprev + voff, 0); pv_tile(o, P, vf0, lds + VOFF + vprev + voff); }
    __syncthreads();
    lsum = xhalf_sum(lsum);
    const float sc = (c == 0) ? (1.0f / lsum) : (lam / lsum);
    LAS float* X = (LAS float*)lds + qsub * (128 * 32);
    if (c == 1) {
#pragma unroll
        for (int e = 0; e < 4; ++e)
#pragma unroll
            for (int r = 0; r < 16; ++r) { const int ee = 32 * e + (r & 3) + 8 * (r >> 2) + 4 * hi; X[ee * 32 + r32] = o[e][r] * sc; } }
    __syncthreads();
    if (c == 0) { float ss = 0.f;
#pragma unroll
        for (int e = 0; e < 4; ++e)
#pragma unroll
            for (int r = 0; r < 16; ++r) { const int ee = 32 * e + (r & 3) + 8 * (r >> 2) + 4 * hi; const float v = o[e][r] * sc - X[ee * 32 + r32]; o[e][r] = v; ss += v * v; }
        ss = xhalf_sum(ss);
        const float rs = (1.0f / sqrtf(ss * (1.0f / 128.0f) + SUBLN_EPS)) * 0.8f;
        bf16* op = MIX + (rowbase + q0 + r32) * 1024 + 512 + h * 128;
#pragma unroll
        for (int e = 0; e < 4; ++e)
#pragma unroll
            for (int q4 = 0; q4 < 4; ++q4) { const int ee = 32 * e + 8 * q4 + 4 * hi; const f32x4 g = *(const f32x4*)(sgain + ee);
                u32x2 w; w.x = cvtpk(o[e][4 * q4] * rs * g.x, o[e][4 * q4 + 1] * rs * g.y); w.y = cvtpk(o[e][4 * q4 + 2] * rs * g.z, o[e][4 * q4 + 3] * rs * g.w);
                *(u32x2*)(op + ee) = w; } }
    __syncthreads();
}
}

namespace hy {
constexpr int UP = 264, UBUF = 32 * UP * 2, HRB = HRLEN * 2;
constexpr int NCH = 17;
__device__ __forceinline__ float ldbf(const bf16* p) { return bf2f(*p); }
struct StageRegs { u32x2 xa, xb, va, vb; unsigned short xm, vm; };
__device__ __forceinline__ void stage_load(StageRegs& R, const bf16* X1, const bf16* V, int j, int tid) {
    const int b = tid >> 6, tt = tid & 63; const int S0 = 256 * j + 4 * tt - 4;
    const bool okA = (S0 >= 0 && S0 < SEQ), okB = (S0 + 4 < SEQ), okM = (S0 >= 1 && S0 <= SEQ);
    const size_t ia = (size_t)b * SEQ + (okA ? S0 : 0), ib = (size_t)b * SEQ + (okB ? S0 + 4 : 0), im = (size_t)b * SEQ + (okM ? S0 - 1 : 0);
    R.xa = *(const u32x2*)(X1 + ia); R.xb = *(const u32x2*)(X1 + ib); R.xm = X1[im];
    R.va = *(const u32x2*)(V + ia); R.vb = *(const u32x2*)(V + ib); R.vm = V[im];
}
__device__ __forceinline__ void stage_write(LAS unsigned char* ub, const StageRegs& R, const float (&w1)[4], const float (&wv)[4], int j, int tid) {
    const int b = tid >> 6, tt = tid & 63; const int S0 = 256 * j + 4 * tt - 4;
    const bool okA = (S0 >= 0 && S0 < SEQ), okB = (S0 + 4 < SEQ), okM = (S0 >= 1 && S0 <= SEQ);
    float xs[9], vs[9];
    xs[0] = okM ? bf2f(R.xm) : 0.f; vs[0] = okM ? bf2f(R.vm) : 0.f;
    xs[1] = okA ? bflo(R.xa.x) : 0.f; xs[2] = okA ? bfhi(R.xa.x) : 0.f; xs[3] = okA ? bflo(R.xa.y) : 0.f; xs[4] = okA ? bfhi(R.xa.y) : 0.f;
    xs[5] = okB ? bflo(R.xb.x) : 0.f; xs[6] = okB ? bfhi(R.xb.x) : 0.f; xs[7] = okB ? bflo(R.xb.y) : 0.f; xs[8] = okB ? bfhi(R.xb.y) : 0.f;
    vs[1] = okA ? bflo(R.va.x) : 0.f; vs[2] = okA ? bfhi(R.va.x) : 0.f; vs[3] = okA ? bflo(R.va.y) : 0.f; vs[4] = okA ? bfhi(R.va.y) : 0.f;
    vs[5] = okB ? bflo(R.vb.x) : 0.f; vs[6] = okB ? bfhi(R.vb.x) : 0.f; vs[7] = okB ? bflo(R.vb.y) : 0.f; vs[8] = okB ? bfhi(R.vb.y) : 0.f;
    float g[7];
#pragma unroll
    for (int i = 0; i < 7; ++i) { const float cx = w1[0] * xs[i] + w1[1] * xs[i + 1] + w1[2] * xs[i + 2] + w1[3]; const float cv = wv[0] * vs[i] + wv[1] * vs[i + 1] + wv[2] * vs[i + 2] + wv[3];
        g[i] = ((i < 4) ? okA : okB) ? cx * cv : 0.f; }
#pragma unroll
    for (int r = 0; r < 4; ++r) { u32x2 w; w.x = pk2(g[r], g[r + 1]); w.y = pk2(g[r + 2], g[r + 3]);
        *(LAS u32x2*)(ub + ((4 * b + r) * UP + 4 * tt) * 2) = w; }
}
__device__ __forceinline__ void channel(LAS unsigned char* lds, const bf16* UVT, const bf16* HR, const float* conv_w, const float* conv_b, bf16* YT, int c) {
    const int tid = threadIdx.x, lane = tid & 63, r32 = lane & 31, hi = lane >> 5; const int wid = __builtin_amdgcn_readfirstlane(tid >> 6);
    const bf16* X0 = UVT + (size_t)c * MTOK; const bf16* X1 = UVT + (size_t)(512 + c) * MTOK; const bf16* V = UVT + (size_t)(1024 + c) * MTOK;
    float w0[4], w1[4], wv[4];
#pragma unroll
    for (int k = 0; k < 3; ++k) { w0[k] = conv_w[k * 1536 + c]; w1[k] = conv_w[k * 1536 + 512 + c]; wv[k] = conv_w[k * 1536 + 1024 + c]; }
    w0[3] = conv_b[c]; w1[3] = conv_b[512 + c]; wv[3] = conv_b[1024 + c];
    for (int i = tid; i < HRB / 16; i += NTHR) { const bf16* src = HR + (size_t)c * HRLEN + 8 * i; ((LAS u32x4*)lds)[i] = *(const u32x4*)src;
        const u32x2 lo = *(const u32x2*)(src + 4); const u32x2 hi2 = (8 * i + 8 < HRLEN) ? *(const u32x2*)(src + 8) : (u32x2){0u, 0u};
        ((LAS u32x4*)(lds + HRB))[i] = (u32x4){lo.x, lo.y, hi2.x, hi2.y}; }
    LAS unsigned char* ub0 = lds + 2 * HRB;
    StageRegs SR;
    stage_load(SR, X1, V, 0, tid); stage_write(ub0, SR, w1, wv, 0, tid);
    __syncthreads();
    f32x16 acc[4];
#pragma unroll
    for (int n = 0; n < 4; ++n) acc[n] = (f32x16){};
    const int idx0 = 4096 - 4 * (128 * wid + r32) - 4 + 8 * hi;
    const int hb0 = (r32 & 1) ? idx0 * 2 : HRB + (idx0 - 4) * 2;
    for (int j = 0; j < NCH; ++j) {
        LAS unsigned char* ucur = ub0 + (j & 1) * UBUF;
        if (j + 1 < NCH) stage_load(SR, X1, V, j + 1, tid);
        const int nks = (j < NCH - 1) ? 16 : 1;
        const LAS unsigned char* ua = ucur + r32 * (UP * 2) + hi * 16;
        const LAS unsigned char* hp = lds + hb0 + j * 512;
        if (nks == 16) {
            bf16x8 a0, b0[4], a1, b1[4];
            a0 = *(const LAS bf16x8*)(ua);
#pragma unroll
            for (int n = 0; n < 4; ++n) b0[n] = *(const LAS bf16x8*)(hp - n * 256);
#pragma unroll
            for (int ks = 0; ks < 16; ks += 2) {
                a1 = *(const LAS bf16x8*)(ua + (ks + 1) * 32);
#pragma unroll
                for (int n = 0; n < 4; ++n) b1[n] = *(const LAS bf16x8*)(hp + (ks + 1) * 32 - n * 256);
                __builtin_amdgcn_sched_barrier(0);
#pragma unroll
                for (int n = 0; n < 4; ++n) acc[n] = __builtin_amdgcn_mfma_f32_32x32x16_bf16(a0, b0[n], acc[n], 0, 0, 0);
                __builtin_amdgcn_sched_barrier(0);
                if (ks + 2 < 16) { a0 = *(const LAS bf16x8*)(ua + (ks + 2) * 32);
#pragma unroll
                    for (int n = 0; n < 4; ++n) b0[n] = *(const LAS bf16x8*)(hp + (ks + 2) * 32 - n * 256); }
                __builtin_amdgcn_sched_barrier(0);
#pragma unroll
                for (int n = 0; n < 4; ++n) acc[n] = __builtin_amdgcn_mfma_f32_32x32x16_bf16(a1, b1[n], acc[n], 0, 0, 0);
                __builtin_amdgcn_sched_barrier(0);
            }
        } else {
            const bf16x8 a = *(const LAS bf16x8*)(ua);
#pragma unroll
            for (int n = 0; n < 4; ++n) { const bf16x8 bb = *(const LAS bf16x8*)(hp - n * 256);
                acc[n] = __builtin_amdgcn_mfma_f32_32x32x16_bf16(a, bb, acc[n], 0, 0, 0); }
        }
        if (j + 1 < NCH) stage_write(ub0 + ((j + 1) & 1) * UBUF, SR, w1, wv, j + 1, tid);
        __syncthreads();
    }
#pragma unroll
    for (int n = 0; n < 4; ++n) { const int t = 4 * (128 * wid + 32 * n + r32);
#pragma unroll
        for (int q = 0; q < 4; ++q) { const int b = 2 * q + hi; const bf16* xp = X0 + (size_t)b * SEQ + t; const u32x2 xa = *(const u32x2*)xp; float xs[6];
            { const float xm = ldbf(xp - ((t > 0) ? 1 : 0)), xq = ldbf(xp + ((t + 4 < SEQ) ? 4 : 0)); xs[0] = (t > 0) ? xm : 0.f; xs[5] = (t + 4 < SEQ) ? xq : 0.f; }
            xs[1] = bflo(xa.x); xs[2] = bfhi(xa.x); xs[3] = bflo(xa.y); xs[4] = bfhi(xa.y);
            float y[4];
#pragma unroll
            for (int i = 0; i < 4; ++i) y[i] = acc[n][4 * q + i] * (w0[0] * xs[i] + w0[1] * xs[i + 1] + w0[2] * xs[i + 2] + w0[3]);
            u32x2 w; w.x = pk2(y[0], y[1]); w.y = pk2(y[2], y[3]);
            *(u32x2*)(YT + (size_t)c * MTOK + (size_t)b * SEQ + t) = w; } }
    __syncthreads();
}
}

#define XB_TMO      128
#define XB_XCNT(j)  (256  + 64 * (j))
#define XB_XSUB(j)  (1280 + 64 * (j))
#define XB_XGEN(j)  (2304 + 64 * (j))
#define XB_TOP      3328
#define XB_TOPGEN   3392
#define XCD_BAR_WORDS 3456
#define XB_SPIN_CAP (1u << 18)

__device__ __forceinline__ unsigned xb_ld(unsigned* p)              { return __hip_atomic_load(p, __ATOMIC_RELAXED, __HIP_MEMORY_SCOPE_AGENT); }
__device__ __forceinline__ unsigned xb_add(unsigned* p, unsigned v) { return __hip_atomic_fetch_add(p, v, __ATOMIC_RELAXED, __HIP_MEMORY_SCOPE_AGENT); }
__device__ __forceinline__ unsigned xb_xcc_id() { return (unsigned)__builtin_amdgcn_s_getreg((3 << 11) | 20) & 0xFu; }
#define XB_SPIN(cond, bar) do { unsigned _sp = 0; while (cond) { __builtin_amdgcn_s_sleep(1); \
    if ((++_sp & 255u) == 0u) { if (xb_ld(&(bar)[XB_TMO])) break; if (_sp > XB_SPIN_CAP) { atomicAdd(&(bar)[XB_TMO], 1u); break; } } } } while (0)

struct XcdBarrier {
    unsigned* bar; unsigned x;
    volatile LAS unsigned* st;
};

__device__ __forceinline__ XcdBarrier xcd_barrier_post(unsigned* bar, volatile LAS unsigned* st) {
    XcdBarrier b; b.bar = bar; b.x = xb_xcc_id(); b.st = st;
    if (threadIdx.x == 0) (void)xb_add(&bar[XB_XCNT(b.x)], 1u);
    return b;
}
__device__ __forceinline__ void xcd_barrier_complete(unsigned* bar, unsigned x, unsigned& nloc, unsigned& nx) {
    const unsigned G = gridDim.x * gridDim.y * gridDim.z;
    unsigned sum, cnt, mine, sp = 0u;
    for (;;) {
        sum = 0u; cnt = 0u; mine = 0u;
#pragma unroll
        for (unsigned j = 0; j < 16; ++j) { const unsigned c = xb_ld(&bar[XB_XCNT(j)]); sum += c; cnt += (c > 0u) ? 1u : 0u; mine = (j == x) ? c : mine; }
        if (sum == G) break;
        __builtin_amdgcn_s_sleep(1);
        if ((++sp & 255u) == 0u) { if (xb_ld(&bar[XB_TMO])) break; if (sp > XB_SPIN_CAP) { atomicAdd(&bar[XB_TMO], 1u); break; } }
    }
    nloc = mine > 0u ? mine : 1u; nx = cnt > 0u ? cnt : 1u;
}

__device__ __forceinline__ void xcd_barrier(const XcdBarrier& b) {
    asm volatile("s_waitcnt vmcnt(0)" ::: "memory");
    __syncthreads();
    if (threadIdx.x == 0) {
        unsigned* bar = b.bar;
        __builtin_amdgcn_s_waitcnt(0);
        unsigned nloc = b.st[0], nx = b.st[1];
        if (nloc == 0u) { xcd_barrier_complete(bar, b.x, nloc, nx); b.st[0] = nloc; b.st[1] = nx; }
        const unsigned old = xb_add(&bar[XB_XSUB(b.x)], 1u);
        const unsigned gen = old / nloc;
        if (old + 1u == (gen + 1u) * nloc) {
            __builtin_amdgcn_fence(__ATOMIC_RELEASE, "agent");
            asm volatile("s_waitcnt vmcnt(0)" ::: "memory");
            const unsigned og = xb_add(&bar[XB_TOP], 1u);
            const unsigned tg = og / nx;
            if (og + 1u == (tg + 1u) * nx) xb_add(&bar[XB_TOPGEN], 1u);
            else XB_SPIN(xb_ld(&bar[XB_TOPGEN]) == tg, bar);
            __builtin_amdgcn_fence(__ATOMIC_ACQUIRE, "agent");
            xb_add(&bar[XB_XGEN(b.x)], 1u);
            asm volatile("s_waitcnt vmcnt(0)" ::: "memory");
        } else {
            XB_SPIN(xb_ld(&bar[XB_XGEN(b.x)]) == gen, bar);
            __builtin_amdgcn_fence(__ATOMIC_ACQUIRE, "agent");
            asm volatile("s_waitcnt vmcnt(0)" ::: "memory");
        }
    }
    __syncthreads();
}

__global__ void __launch_bounds__(NTHR, 2) fwd_kernel(Args a) {
    extern __shared__ __attribute__((aligned(16))) unsigned char lds_raw[];
    LAS unsigned char* lds = (LAS unsigned char*)lds_raw;
    const int tid = threadIdx.x, lane = tid & 63; const int wave = __builtin_amdgcn_readfirstlane(tid >> 6);
    const int G = gridDim.x, bx = blockIdx.x;
    const int gw = bx * NWAVES + wave, NGW = G * NWAVES;
    unsigned char* ws = a.ws;
    bf16* Win_t = (bf16*)(ws + WS_WIN); bf16* Wout_t = (bf16*)(ws + WS_WOUT); bf16* Wup_t = (bf16*)(ws + WS_WUP); bf16* Wdown_t = (bf16*)(ws + WS_WDOWN);
    bf16* HR = (bf16*)(ws + WS_HR); float* ROPE = (float*)(ws + WS_ROPE);
    bf16* XN = (bf16*)(ws + WS_XN); bf16* MO = (bf16*)(ws + WS_MO); bf16* YT = (bf16*)(ws + WS_YT); bf16* UVT = (bf16*)(ws + WS_UVT);
    bf16* QK = (bf16*)(ws + WS_QK); bf16* KT = (bf16*)(ws + WS_KT); bf16* VT = (bf16*)(ws + WS_VT); bf16* MIX = (bf16*)(ws + WS_MIX); bf16* HB = (bf16*)(ws + WS_H);
    const float* x = a.in[0];
    const int lo = a.ph_lo, hi_ph = a.ph_hi;
#if MK_COOP
    cg::grid_group grid = cg::this_grid();
    volatile LAS unsigned* bst = (volatile LAS unsigned*)(lds + 131072 + 64);
    if (tid < 4) bst[tid] = 0u;
    __syncthreads();
    XcdBarrier xbar = xcd_barrier_post((unsigned*)(ws + WS_CTL), bst);
#define SEAM(k) do { if (lo <= (k) && (k) + 1 < hi_ph) { if ((k) == 0) grid.sync(); else xcd_barrier(xbar); } } while (0)
#else
#define SEAM(k) do { } while (0)
#endif
#ifndef PHMASK
#define PHMASK 0x1ff
#endif
#define IN(k) (((PHMASK >> (k)) & 1) && lo <= (k) && (k) < hi_ph)

#ifndef DUP_P0
#define DUP_P0 1
#endif
    if (IN(0)) for (int rep0 = 0; rep0 < DUP_P0; ++rep0) {
        LAS float* scr = (LAS float*)(lds + wave * 16384);
        constexpr int I_IN = (DM / 64) * (NIN / 32), I_OUT = (DM / 64) * (DM / 32), I_UP = (DM / 64) * (DFF / 32), I_DN = (DFF / 64) * (DM / 32);
        for (int it = gw; it < I_IN + I_OUT + I_UP + I_DN; it += NGW) { int r = it;
            if (r < I_IN) { p0_transpose_item<true>(a.in[3], DM, NIN, Win_t, scr, r, lane); continue; } r -= I_IN;
            if (r < I_OUT) { p0_transpose_item<false>(a.in[20], DM, DM, Wout_t, scr, r, lane); continue; } r -= I_OUT;
            if (r < I_UP) { p0_transpose_item<false>(a.in[23], DM, DFF, Wup_t, scr, r, lane); continue; } r -= I_UP;
            p0_transpose_item<false>(a.in[24], DFF, DM, Wdown_t, scr, r, lane); }
        for (int m = gw; m < MTOK; m += NGW) rms_row_to_bf16(x + (size_t)m * DM, a.in[1], XN + (size_t)m * DM, lane);
        for (int i = bx * NTHR + tid; i < SEQ * 32; i += G * NTHR) { const int pos = i >> 5, k = i & 31;
            const float inv = exp2f(-(float)(2 * k) * (13.287712379549449f / 64.0f)); const float ang = (float)pos * inv;
            ROPE[2 * i] = cosf(ang); ROPE[2 * i + 1] = sinf(ang); }
        __syncthreads();
        for (int pg = bx; pg < SEQ / 16; pg += G) filter_item(lds, a, HR, pg, tid);
    }
    SEAM(0);
#ifndef DUP_P1
#define DUP_P1 1
#endif
    if (IN(1)) {
        { pg8::Gemm g{Win_t, XN, 2048, MTOK, DM}; pg8::StaticOrder S; S.init(2048, MTOK, G, bx);
          pg8::EpiUV E{UVT, VT};
          pg8::gemm_phase<pg8::EpiUV, pg8::StaticOrder, true, true>(lds, g, S, E); }
        { pg8::Gemm g{XN, Win_t + (size_t)2048 * DM, MTOK, 1024, DM}; pg8::StaticOrder S; S.init(MTOK, 1024, G, bx);
          pg8::EpiRope E{QK, KT, ROPE, QSCALE};
          pg8::gemm_phase<pg8::EpiRope, pg8::StaticOrder, true, true>(lds, g, S, E); }
    }
#if DUP_P1 == 2
    if (IN(1)) {
        { pg8::Gemm g{Win_t, XN, 2048, MTOK, DM}; pg8::StaticOrder S; S.init(2048, MTOK, G, bx);
          pg8::EpiUV E{UVT, VT};
          pg8::gemm_phase<pg8::EpiUV, pg8::StaticOrder, true, true>(lds, g, S, E); }
        { pg8::Gemm g{XN, Win_t + (size_t)2048 * DM, MTOK, 1024, DM}; pg8::StaticOrder S; S.init(MTOK, 1024, G, bx);
          pg8::EpiRope E{QK, KT, ROPE, QSCALE};
          pg8::gemm_phase<pg8::EpiRope, pg8::StaticOrder, true, true>(lds, g, S, E); }
    }
#endif
    SEAM(1);
    if (IN(2)) {
        float lam;
        { const float p1 = a.in[15][lane] * a.in[16][lane], p2 = a.in[17][lane] * a.in[18][lane];
          lam = expf(wave_sum(p1)) - expf(wave_sum(p2)) + 0.2f; }
#ifndef DUP_ATT
#define DUP_ATT 1
#endif
#ifndef DUP_HY
#define DUP_HY 1
#endif
#ifndef ATT_VAR
#define ATT_VAR 0
#endif
        for (int u = bx; u < 1024; u += G) { const int bh = (u & 7) + 8 * (u >> 8), qb = (u >> 3) & 31;
            att::unit<0>(lds, QK, KT, VT, MIX, a.in[19], lam, bh >> 2, bh & 3, qb); }
        if (DUP_ATT > 1)
        for (int u = bx; u < 1024; u += G) { const int bh = (u & 7) + 8 * (u >> 8), qb = (u >> 3) & 31;
            att::unit<ATT_VAR>(lds, QK, KT, VT, MO, a.in[19], lam, bh >> 2, bh & 3, qb); }
        for (int rep = 0; rep < DUP_HY; ++rep)
        for (int c = bx; c < HYW; c += G) hy::channel(lds, UVT, HR, a.in[4], a.in[5], YT, c);
    }
    SEAM(2);
#ifndef DUP_P3
#define DUP_P3 1
#endif
    if (IN(3)) for (int rep3 = 0; rep3 < DUP_P3; ++rep3) {
        LAS unsigned short* scr = (LAS unsigned short*)(lds + wave * 16384);
        for (int it = gw; it < 8 * (MTOK / 64); it += NGW) { const int ct = it & 7, mt = it >> 3; const int c0 = 64 * ct, m0 = 64 * mt;
#pragma unroll
            for (int i = 0; i < 8; ++i) { const int cc = 8 * i + (lane >> 3), mch = lane & 7; const u32x4 v = *(const u32x4*)(YT + (size_t)(c0 + cc) * MTOK + m0 + 8 * mch);
                LAS unsigned* d = (LAS unsigned*)(scr + cc * 66 + 8 * mch); d[0] = v.x; d[1] = v.y; d[2] = v.z; d[3] = v.w; }
            LDS_WAIT(); asm volatile("" ::: "memory");
#pragma unroll
            for (int i = 0; i < 8; ++i) { const int mm = 8 * i + (lane >> 3), cch = lane & 7; const LAS unsigned short* s = scr + (8 * cch) * 66 + mm;
                u32x4 o; o.x = (unsigned)s[0] | ((unsigned)s[66] << 16); o.y = (unsigned)s[2 * 66] | ((unsigned)s[3 * 66] << 16);
                o.z = (unsigned)s[4 * 66] | ((unsigned)s[5 * 66] << 16); o.w = (unsigned)s[6 * 66] | ((unsigned)s[7 * 66] << 16);
                *(u32x4*)(MIX + (size_t)(m0 + mm) * 1024 + c0 + 8 * cch) = o; }
            LDS_WAIT(); asm volatile("" ::: "memory"); }
        __syncthreads();
    }
    SEAM(3);
    if (IN(4)) {
        pg8::Gemm g{MIX, Wout_t, MTOK, DM, DM}; pg8::StaticOrder S; S.init(MTOK, DM, G, bx);
        float* ssb = (float*)(ws + WS_CTL + CTL_SS); unsigned* cntb = (unsigned*)(ws + WS_CTL + CTL_CNT);
        pg8::EpiNormResNorm E{x, a.out, XN, a.in[2], a.in[21], ssb, ssb + MTOK, cntb, cntb + 128, NORM_EPS};
        pg8::gemm_phase<pg8::EpiNormResNorm, pg8::StaticOrder, true, true>(lds, g, S, E);
    }
    SEAM(4);
#ifndef DUP_P6
#define DUP_P6 1
#endif
    if (IN(6)) for (int rep6 = 0; rep6 < DUP_P6; ++rep6) {
        pg8::Gemm g{XN, Wup_t, MTOK, DFF, DM}; pg8::StaticOrder S; S.init(MTOK, DFF, G, bx);
        pg8::EpiBf16<1> E{HB, DFF};
        pg8::gemm_phase<pg8::EpiBf16<1>, pg8::StaticOrder, true, true>(lds, g, S, E);
    }
    SEAM(6);
    if (IN(7)) {
        pg8::Gemm g{HB, Wdown_t, MTOK, DM, DFF}; pg8::StaticOrder S; S.init(MTOK, DM, G, bx);
        float* ssb = (float*)(ws + WS_CTL + CTL_SS); unsigned* cntb = (unsigned*)(ws + WS_CTL + CTL_CNT);
        pg8::EpiNormRes E{a.out, a.in[22], ssb + 2 * MTOK, cntb + 256, NORM_EPS};
        pg8::gemm_phase<pg8::EpiNormRes, pg8::StaticOrder, true, true>(lds, g, S, E);
    }
#undef IN
#undef SEAM
}

constexpr int NPHASE = 9;
extern "C" void kernel_launch(void* const* d_in, const int* in_sizes, int n_in, void* d_out, int out_size, void* d_ws, size_t ws_size, hipStream_t stream) {
    static int grid = 0;
    if (grid == 0) {
        if (n_in != 25 || in_sizes[0] != MTOK * DM || out_size != MTOK * DM || ws_size < WS_END) {
            fprintf(stderr, "kernel_launch: unexpected shapes (n_in %d in0 %d out %d ws %zu)\n", n_in, n_in > 0 ? in_sizes[0] : -1, out_size, ws_size); grid = -1; return; }
        int dev = 0, cus = 0, per_cu = 0;
        hipGetDevice(&dev); hipDeviceGetAttribute(&cus, hipDeviceAttributeMultiprocessorCount, dev);
        hipFuncSetAttribute((const void*)fwd_kernel, hipFuncAttributeMaxDynamicSharedMemorySize, LDS_BYTES);
        hipOccupancyMaxActiveBlocksPerMultiprocessor(&per_cu, (const void*)fwd_kernel, NTHR, LDS_BYTES);
        if (per_cu < 1) { fprintf(stderr, "kernel_launch: occupancy query says %d blocks/CU\n", per_cu); per_cu = 1; }
        (void)hipGetLastError();
        grid = cus >= 256 ? 256 : cus;
    }
    if (grid < 0) return;
    Args a{};
    for (int i = 0; i < 25; ++i) a.in[i] = (const float*)d_in[i];
    a.out = (float*)d_out; a.ws = (unsigned char*)d_ws;
#if MK_COOP
    a.ph_lo = 0; a.ph_hi = NPHASE;
    if (hipMemsetAsync((unsigned char*)d_ws + WS_CTL, 0, CTL_BYTES, stream) != hipSuccess) { fprintf(stderr, "kernel_launch: memset of the barrier words failed\n"); return; }
    void* args[] = {&a};
    hipError_t e = hipLaunchCooperativeKernel((const void*)fwd_kernel, dim3(grid), dim3(NTHR), args, LDS_BYTES, stream);
    if (e != hipSuccess) fprintf(stderr, "cooperative launch failed: %s (grid %d)\n", hipGetErrorString(e), grid);
#else
    for (int p = 0; p < NPHASE; ++p) { a.ph_lo = p; a.ph_hi = p + 1; hipLaunchKernelGGL(fwd_kernel, dim3(grid), dim3(NTHR), LDS_BYTES, stream, a); }
#endif
}
```

```cpp
#include <hip/hip_runtime.h>
#include <hip/hip_cooperative_groups.h>
#include <cstdio>
#include <cstdint>
#include <cmath>
namespace cg = cooperative_groups;
#ifndef MK_COOP
#define MK_COOP 1
#endif
namespace pg8 {
#define PG8_LAS __attribute__((address_space(3)))
typedef unsigned short bf16_t;
typedef short bf16x8 __attribute__((ext_vector_type(8)));
typedef float f32x4 __attribute__((ext_vector_type(4)));
typedef unsigned u32x4 __attribute__((ext_vector_type(4)));
constexpr int BM = 256, BK = 64, HALF = 128, HTB = HALF * BK * 2  , STAGE_BYTES = 8 * HTB, NXCD = 8, WGM = 8;

__host__ __device__ __forceinline__ int lds_byte(int r, int c) { const int st = (r >> 4) * 2 + (c >> 5), rr = r & 15, cc = c & 31, ob = rr * 64 + cc * 2; return st * 1024 + (ob ^ (((ob >> 9) & 1) << 5)); }
__host__ __device__ __forceinline__ void stage_rc(int b, int& R, int& C) { const int st = b / 1024, sb = b % 1024, swz = sb ^ (((sb >> 9) & 1) << 5); R = (st >> 1) * 16 + swz / 64; C = (st & 1) * 32 + (swz % 64) / 2; }
__host__ __device__ __forceinline__ int perm32(int rho) { const int n = rho >> 4, i = rho & 15; return 8 * (i >> 2) + 4 * n + (i & 3); }

struct Unit { int pm, pn; };
struct Gemm { const bf16_t* A; const bf16_t* Bt; int M, N, K; };

struct StaticOrder {
    int nM, nN, nwg, G, c;
    __host__ __device__ void init(int M, int N, int G_, int c_) { nM = M / BM; nN = N / BM; nwg = nM * nN; G = G_; c = c_; }
    __host__ __device__ bool next(int i, Unit& u) const {
        const long L = (long)i * G + c; if (L >= nwg) return false;
        int wgid = (int)L; { const int q = nwg / NXCD, r = nwg % NXCD, xcd = wgid % NXCD, off = wgid / NXCD; wgid = (xcd < r ? xcd * (q + 1) : r * (q + 1) + (xcd - r) * q) + off; }
        const int nig = WGM * nN, gid = wgid / nig, fm = gid * WGM, gsz = (nM - fm) < WGM ? (nM - fm) : WGM;
        u.pm = fm + ((wgid % nig) % gsz); u.pn = (wgid % nig) / gsz; return true;
    }
    __device__ __forceinline__ void a_ready(const Unit&) const {}
    __device__ __forceinline__ void done(const Unit&) const {}
};

__device__ __forceinline__ unsigned cvt_pk_bf16(float lo, float hi) { unsigned r; asm volatile("v_cvt_pk_bf16_f32 %0, %1, %2" : "=v"(r) : "v"(lo), "v"(hi)); return r; }
typedef float f32x2 __attribute__((ext_vector_type(2)));
typedef float f32x2 __attribute__((ext_vector_type(2)));
typedef unsigned u32x2 __attribute__((ext_vector_type(2)));
template <int ACT> struct EpiBf16 {
    static constexpr bool PERM = true, AFTER_DRAIN = false;
    bf16_t* O; int ldc;
    __device__ __forceinline__ void operator()(const f32x4 (&acc)[2][2][4][2], const Unit& u, int wr, int wc, int fr, int fq) const {
        const int row0 = u.pm * BM + wr * 64 + fr; const int col0 = u.pn * BM + wc * 32 + 8 * fq;
#pragma unroll
        for (int ai = 0; ai < 2; ++ai)
#pragma unroll
            for (int m = 0; m < 4; ++m) { bf16_t* rowp = O + (size_t)(row0 + ai * HALF + m * 16) * ldc + col0;
#pragma unroll
                for (int bj = 0; bj < 2; ++bj) { f32x4 v0 = acc[ai][bj][m][0], v1 = acc[ai][bj][m][1];
                    if (ACT == 1) {
#pragma unroll
                        for (int j = 0; j < 4; ++j) { float a = v0[j] > 0.f ? v0[j] : 0.f; v0[j] = a * a; float b = v1[j] > 0.f ? v1[j] : 0.f; v1[j] = b * b; } }
                    u32x4 w; w.x = cvt_pk_bf16(v0[0], v0[1]); w.y = cvt_pk_bf16(v0[2], v0[3]); w.z = cvt_pk_bf16(v1[0], v1[1]); w.w = cvt_pk_bf16(v1[2], v1[3]);
                    *(u32x4*)(rowp + bj * HALF) = w; } }
    }
};
struct EpiRope {
    static constexpr bool PERM = true, AFTER_DRAIN = false;
    bf16_t* Q; bf16_t* KT; const float* rope; float qscale;
    __device__ __forceinline__ void operator()(const f32x4 (&acc)[2][2][4][2], const Unit& u, int wr, int wc, int fr, int fq) const {
        const int row0 = u.pm * BM + wr * 64 + fr; const int col0 = u.pn * BM + wc * 32 + 8 * fq;
        const int g = (wc & 1) * 4 + fq;
        const float sc = (u.pn < 2) ? qscale : 1.0f;
#pragma unroll
        for (int ai = 0; ai < 2; ++ai)
#pragma unroll
            for (int m = 0; m < 4; ++m) { const int row = row0 + ai * HALF + m * 16; const int pos = row & 4095;
                const f32x4 cs0 = *(const f32x4*)(rope + (size_t)pos * 64 + 8 * g), cs1 = *(const f32x4*)(rope + (size_t)pos * 64 + 8 * g + 4);
                const float c[4] = {cs0[0], cs0[2], cs1[0], cs1[2]}, s[4] = {cs0[1], cs0[3], cs1[1], cs1[3]};
                bf16_t* rowp;
                if (u.pn < 2) rowp = Q + (size_t)row * 512 + col0;
                else { const int ck = col0 - 512, hh = ck >> 7, cc = ck & 127; rowp = KT + ((size_t)(((row >> 12) * 4 + hh) * 64 + (pos >> 6)) * 8192 + (pos & 63) * 128 + cc); }
#pragma unroll
                for (int bj = 0; bj < 2; ++bj) { const f32x4 lo = acc[ai][bj][m][0], hi = acc[ai][bj][m][1]; float ol[4], oh[4];
#pragma unroll
                    for (int j = 0; j < 4; ++j) { ol[j] = (lo[j] * c[j] - hi[j] * s[j]) * sc; oh[j] = (hi[j] * c[j] + lo[j] * s[j]) * sc; }
                    u32x4 w; w.x = cvt_pk_bf16(ol[0], ol[1]); w.y = cvt_pk_bf16(ol[2], ol[3]); w.z = cvt_pk_bf16(oh[0], oh[1]); w.w = cvt_pk_bf16(oh[2], oh[3]);
                    *(u32x4*)(rowp + ((u.pn < 2) ? bj * HALF : bj * (64 * 8192))) = w; } }
    }
};
struct EpiUV {
    static constexpr bool PERM = true, AFTER_DRAIN = false;
    bf16_t* UT; bf16_t* VT;
    __device__ __forceinline__ void operator()(const f32x4 (&acc)[2][2][4][2], const Unit& u, int wr, int wc, int fr, int fq) const {
        const int row0 = u.pm * BM + wr * 64 + fr; const int col0 = u.pn * BM + wc * 32 + 8 * fq;
#pragma unroll
        for (int ai = 0; ai < 2; ++ai)
#pragma unroll
            for (int m = 0; m < 4; ++m) { const int row = row0 + ai * HALF + m * 16;
#pragma unroll
                for (int bj = 0; bj < 2; ++bj) { const int col = col0 + bj * HALF; bf16_t* p;
                    if (u.pm < 6) p = UT + (size_t)row * 32768 + col;
                    else { const int ev = row - 1536, hh = ev >> 7, ee = ev & 127, bb = col >> 12, pos = col & 4095;
                        p = VT + ((size_t)((bb * 4 + hh) * 64 + (pos >> 6)) * 8192 + ee * 64 + (pos & 48) + ((pos & 8) >> 1)); }
                    const f32x4 v0 = acc[ai][bj][m][0], v1 = acc[ai][bj][m][1];
                    u32x4 w; w.x = cvt_pk_bf16(v0[0], v0[1]); w.y = cvt_pk_bf16(v0[2], v0[3]); w.z = cvt_pk_bf16(v1[0], v1[1]); w.w = cvt_pk_bf16(v1[2], v1[3]);
                    if (u.pm < 6) *(u32x4*)p = w;
                    else { *(u32x2*)p = (u32x2){w.x, w.y}; *(u32x2*)(p + 8) = (u32x2){w.z, w.w}; } } }
    }
};

__device__ __forceinline__ void panel_sumsq(const f32x4 (&acc)[2][2][4][2], float* ss, unsigned* cnt, const Unit& u, int wr, int fr, int fq, int lane) {
#pragma unroll
    for (int ai = 0; ai < 2; ++ai)
#pragma unroll
        for (int m = 0; m < 4; ++m) { float s = 0.f;
#pragma unroll
            for (int bj = 0; bj < 2; ++bj)
#pragma unroll
                for (int n = 0; n < 2; ++n) { const f32x4 x = acc[ai][bj][m][n]; s += (x[0] * x[0] + x[1] * x[1]) + (x[2] * x[2] + x[3] * x[3]); }
            s += __shfl_xor(s, 16); s += __shfl_xor(s, 32);
            if (fq == 0) __hip_atomic_fetch_add(ss + u.pm * BM + ai * HALF + wr * 64 + m * 16 + fr, s, __ATOMIC_RELAXED, __HIP_MEMORY_SCOPE_AGENT); }
    asm volatile("s_waitcnt vmcnt(0)" ::: "memory");
    __syncthreads();
    if (threadIdx.x == 0) { __hip_atomic_fetch_add(cnt + u.pm, 1u, __ATOMIC_RELAXED, __HIP_MEMORY_SCOPE_AGENT);
        unsigned spins = 0;
        while (__hip_atomic_load(cnt + u.pm, __ATOMIC_RELAXED, __HIP_MEMORY_SCOPE_AGENT) < 4u) { __builtin_amdgcn_s_sleep(8); if (++spins > (1u << 20)) break; } }
    __syncthreads();
}
struct EpiNormRes {
    static constexpr bool PERM = true, AFTER_DRAIN = false;
    const bf16_t* x1b; float* out; const float* gain; float* ss; unsigned* cnt; float eps;
    __device__ __forceinline__ void operator()(f32x4 (&acc)[2][2][4][2], const Unit& u, int wr, int wc, int fr, int fq) const {
        const int lane = fq * 16 + fr;
        panel_sumsq(acc, ss, cnt, u, wr, fr, fq, lane);
        const int row0 = u.pm * BM + wr * 64 + fr; const int col0 = u.pn * BM + wc * 32 + 8 * fq;
        f32x4 g[2][2];
#pragma unroll
        for (int bj = 0; bj < 2; ++bj) { g[bj][0] = *(const f32x4*)(gain + col0 + bj * HALF); g[bj][1] = *(const f32x4*)(gain + col0 + bj * HALF + 4); }
#pragma unroll
        for (int ai = 0; ai < 2; ++ai)
#pragma unroll
            for (int m = 0; m < 4; ++m) { const int row = row0 + ai * HALF + m * 16;
                const float r = 1.0f / sqrtf(__hip_atomic_load(ss + row, __ATOMIC_RELAXED, __HIP_MEMORY_SCOPE_AGENT) * (1.0f / 1024.0f) + eps);
                float* rowp = out + (size_t)row * 1024 + col0; const bf16_t* xp = x1b + (size_t)row * 1024 + col0;
#pragma unroll
                for (int bj = 0; bj < 2; ++bj) { const u32x4 xb = *(const u32x4*)(xp + bj * HALF);
                    const f32x4 b0 = (f32x4){__builtin_bit_cast(float, xb.x << 16), __builtin_bit_cast(float, xb.x & 0xffff0000u), __builtin_bit_cast(float, xb.y << 16), __builtin_bit_cast(float, xb.y & 0xffff0000u)};
                    const f32x4 b1 = (f32x4){__builtin_bit_cast(float, xb.z << 16), __builtin_bit_cast(float, xb.z & 0xffff0000u), __builtin_bit_cast(float, xb.w << 16), __builtin_bit_cast(float, xb.w & 0xffff0000u)};
                    *(f32x4*)(rowp + bj * HALF) = b0 + acc[ai][bj][m][0] * r * g[bj][0]; *(f32x4*)(rowp + bj * HALF + 4) = b1 + acc[ai][bj][m][1] * r * g[bj][1]; } }
    }
};
struct EpiNormResNorm {
    static constexpr bool PERM = true, AFTER_DRAIN = false;
    const float* base; bf16_t* x1b; bf16_t* xn; const float* g1; const float* g2; float* ss1; float* ss2; unsigned* cnt1; unsigned* cnt2; float eps;
    __device__ __forceinline__ void operator()(f32x4 (&acc)[2][2][4][2], const Unit& u, int wr, int wc, int fr, int fq) const {
        const int lane = fq * 16 + fr;
        panel_sumsq(acc, ss1, cnt1, u, wr, fr, fq, lane);
        const int row0 = u.pm * BM + wr * 64 + fr; const int col0 = u.pn * BM + wc * 32 + 8 * fq;
        { f32x4 g[2][2];
#pragma unroll
          for (int bj = 0; bj < 2; ++bj) { g[bj][0] = *(const f32x4*)(g1 + col0 + bj * HALF); g[bj][1] = *(const f32x4*)(g1 + col0 + bj * HALF + 4); }
#pragma unroll
          for (int ai = 0; ai < 2; ++ai)
#pragma unroll
            for (int m = 0; m < 4; ++m) { const int row = row0 + ai * HALF + m * 16;
                const float r = 1.0f / sqrtf(__hip_atomic_load(ss1 + row, __ATOMIC_RELAXED, __HIP_MEMORY_SCOPE_AGENT) * (1.0f / 1024.0f) + eps);
                const float* bp = base + (size_t)row * 1024 + col0; bf16_t* rowp = x1b + (size_t)row * 1024 + col0;
#pragma unroll
                for (int bj = 0; bj < 2; ++bj) { const f32x4 b0 = *(const f32x4*)(bp + bj * HALF), b1 = *(const f32x4*)(bp + bj * HALF + 4);
                    const f32x4 x0 = b0 + acc[ai][bj][m][0] * r * g[bj][0], x1 = b1 + acc[ai][bj][m][1] * r * g[bj][1];
                    acc[ai][bj][m][0] = x0; acc[ai][bj][m][1] = x1;
                    u32x4 w; w.x = cvt_pk_bf16(x0[0], x0[1]); w.y = cvt_pk_bf16(x0[2], x0[3]); w.z = cvt_pk_bf16(x1[0], x1[1]); w.w = cvt_pk_bf16(x1[2], x1[3]);
                    *(u32x4*)(rowp + bj * HALF) = w; } } }
        panel_sumsq(acc, ss2, cnt2, u, wr, fr, fq, lane);
        { f32x4 g[2][2];
#pragma unroll
          for (int bj = 0; bj < 2; ++bj) { g[bj][0] = *(const f32x4*)(g2 + col0 + bj * HALF); g[bj][1] = *(const f32x4*)(g2 + col0 + bj * HALF + 4); }
#pragma unroll
          for (int ai = 0; ai < 2; ++ai)
#pragma unroll
            for (int m = 0; m < 4; ++m) { const int row = row0 + ai * HALF + m * 16;
                const float r = 1.0f / sqrtf(__hip_atomic_load(ss2 + row, __ATOMIC_RELAXED, __HIP_MEMORY_SCOPE_AGENT) * (1.0f / 1024.0f) + eps);
                bf16_t* xp = xn + (size_t)row * 1024 + col0;
#pragma unroll
                for (int bj = 0; bj < 2; ++bj) { const f32x4 v0 = acc[ai][bj][m][0] * r * g[bj][0], v1 = acc[ai][bj][m][1] * r * g[bj][1];
                    u32x4 w; w.x = cvt_pk_bf16(v0[0], v0[1]); w.y = cvt_pk_bf16(v0[2], v0[3]); w.z = cvt_pk_bf16(v1[0], v1[1]); w.w = cvt_pk_bf16(v1[2], v1[3]);
                    *(u32x4*)(xp + bj * HALF) = w; } } }
    }
};
template <class Epi, class Sched, bool ALIGN_EPI = false, bool SP2 = false>
__device__ __forceinline__ void gemm_phase(PG8_LAS unsigned char* lds, const Gemm g, const Sched& S, const Epi& E) {
    const int tid = threadIdx.x, wid = __builtin_amdgcn_readfirstlane(tid >> 6), lane = tid & 63, wr = wid >> 2, wc = wid & 3, fr = lane & 15, fq = lane >> 4;
    const int K = g.K, nt = K / BK;
    unsigned voffA[2], voffB[2];
#pragma unroll
    for (int i = 0; i < 2; ++i) { int R, C; stage_rc(tid * 16 + i * 8192, R, C); const int Rb = Epi::PERM ? ((R & ~31) + perm32(R & 31)) : R;
        voffA[i] = (unsigned)(R * K + C) * 2u; voffB[i] = (unsigned)(Rb * K + C) * 2u; }
    const size_t kstep = (size_t)(BK * 2);
    const size_t hstep = (size_t)HALF * K * 2;
    const size_t tstep = 2 * hstep;
    const unsigned ldsw = (unsigned)wid * 1024u;
    const int aoff = lds_byte(wr * 64 + fr, fq * 8), boff = lds_byte(wc * 32 + fr, fq * 8);
#define PG8_SA(b, h) (((b) * 2 + (h)) * HTB)
#define PG8_SB(b, h) ((4 + (b) * 2 + (h)) * HTB)
#define PG8_STAGE(bufoff, gbase, voff) do { _Pragma("unroll") for (int _i = 0; _i < 2; ++_i) \
        __builtin_amdgcn_global_load_lds((const unsigned*)((const char*)(gbase) + (voff)[_i]), (PG8_LAS unsigned*)(lds + (bufoff) + ldsw + _i * 8192), 16, 0, 0); } while (0)
#define PG8_LDA(dst, b, h) do { _Pragma("unroll") for (int m = 0; m < 4; ++m) _Pragma("unroll") for (int k = 0; k < 2; ++k) dst[m][k] = *(const PG8_LAS bf16x8*)(lds + PG8_SA(b, h) + aoff + m * 2048 + k * 1024); } while (0)
#define PG8_LDB(dst, b, h) do { _Pragma("unroll") for (int n = 0; n < 2; ++n) _Pragma("unroll") for (int k = 0; k < 2; ++k) dst[n][k] = *(const PG8_LAS bf16x8*)(lds + PG8_SB(b, h) + boff + n * 2048 + k * 1024); } while (0)
#define PG8_MMA(ai, bj, At, Bt) do { __builtin_amdgcn_s_setprio(1); _Pragma("unroll") for (int m = 0; m < 4; ++m) _Pragma("unroll") for (int n = 0; n < 2; ++n) _Pragma("unroll") for (int k = 0; k < 2; ++k) \
        acc[ai][bj][m][n] = __builtin_amdgcn_mfma_f32_16x16x32_bf16(Bt[n][k], At[m][k], acc[ai][bj][m][n], 0, 0, 0); __builtin_amdgcn_s_setprio(0); } while (0)
#define PG8_WAIT_V(n) asm volatile("s_waitcnt vmcnt(" #n ")" ::: "memory")
#define PG8_WAIT_L(n) asm volatile("s_waitcnt lgkmcnt(" #n ")" ::: "memory")
#define PG8_BAR __builtin_amdgcn_s_barrier()
#define PG8_SCHED __builtin_amdgcn_sched_barrier(0)
    Unit cur, nxt; int ui = 0;
    if (!S.next(0, cur)) return;
    f32x4 acc[2][2][4][2];
#pragma unroll
    for (int a = 0; a < 2; ++a)
#pragma unroll
        for (int b = 0; b < 2; ++b)
#pragma unroll
            for (int m = 0; m < 4; ++m)
#pragma unroll
                for (int n = 0; n < 2; ++n) acc[a][b][m][n] = (f32x4){0.f, 0.f, 0.f, 0.f};
    bf16x8 At[4][2], B0[2][2], B1[2][2];
    const char* cA = (const char*)g.A + (size_t)cur.pm * tstep; const char* cB = (const char*)g.Bt + (size_t)cur.pn * tstep;
    S.a_ready(cur);
    if constexpr (SP2) {
        PG8_STAGE(PG8_SB(0, 0), cB, voffB); PG8_STAGE(PG8_SB(0, 1), cB + hstep, voffB); PG8_STAGE(PG8_SA(0, 0), cA, voffA); PG8_STAGE(PG8_SA(0, 1), cA + hstep, voffA);
        if (wr == 1) PG8_BAR;
        PG8_WAIT_V(2); PG8_BAR;
        PG8_STAGE(PG8_SB(1, 0), cB + kstep, voffB); PG8_STAGE(PG8_SA(1, 0), cA + kstep, voffA); PG8_STAGE(PG8_SB(1, 1), cB + hstep + kstep, voffB);
        PG8_WAIT_V(6); PG8_BAR;
    } else {
        PG8_STAGE(PG8_SB(0, 0), cB, voffB); PG8_STAGE(PG8_SA(0, 0), cA, voffA); PG8_STAGE(PG8_SB(0, 1), cB + hstep, voffB); PG8_STAGE(PG8_SA(0, 1), cA + hstep, voffA);
        if (wr == 1) PG8_BAR;
        PG8_WAIT_V(4); PG8_BAR;
        PG8_STAGE(PG8_SB(1, 0), cB + kstep, voffB); PG8_STAGE(PG8_SA(1, 0), cA + kstep, voffA); PG8_STAGE(PG8_SB(1, 1), cB + hstep + kstep, voffB);
        PG8_WAIT_V(6); PG8_BAR;
    }
    for (;;) {
        const bool has_next = S.next(ui + 1, nxt);
        const char* nA = has_next ? (const char*)g.A + (size_t)nxt.pm * tstep : cA; const char* nB = has_next ? (const char*)g.Bt + (size_t)nxt.pn * tstep : cB;
        for (int t = 0; t < nt; t += 2) {
            const bool last = (t == nt - 2);
            const char* a1 = cA + (size_t)(t + 1) * kstep;
            const char* a2 = last ? nA : cA + (size_t)(t + 2) * kstep; const char* b2 = last ? nB : cB + (size_t)(t + 2) * kstep;
            const char* a3 = a2 + kstep; const char* b3 = b2 + kstep;
            if (last && has_next) S.a_ready(nxt);
            if constexpr (SP2) {
            PG8_LDB(B0, 0, 0); PG8_LDB(B1, 0, 1); PG8_SCHED; PG8_LDA(At, 0, 0); PG8_STAGE(PG8_SA(1, 1), a1 + hstep, voffA);
            PG8_WAIT_V(8); PG8_WAIT_L(0); PG8_BAR; PG8_MMA(0, 0, At, B0); PG8_MMA(0, 1, At, B1); PG8_BAR; PG8_SCHED;
            PG8_LDA(At, 0, 1); PG8_STAGE(PG8_SB(0, 0), b2, voffB); PG8_STAGE(PG8_SB(0, 1), b2 + hstep, voffB); PG8_STAGE(PG8_SA(0, 0), a2, voffA);
            PG8_WAIT_V(8); PG8_WAIT_L(0); PG8_BAR; PG8_MMA(1, 0, At, B0); PG8_MMA(1, 1, At, B1); PG8_BAR; PG8_SCHED;
            PG8_LDB(B0, 1, 0); PG8_LDB(B1, 1, 1); PG8_SCHED; PG8_LDA(At, 1, 0); PG8_STAGE(PG8_SA(0, 1), a2 + hstep, voffA);
            PG8_WAIT_V(8); PG8_WAIT_L(0); PG8_BAR; PG8_MMA(0, 0, At, B0); PG8_MMA(0, 1, At, B1); PG8_BAR; PG8_SCHED;
            PG8_LDA(At, 1, 1); PG8_STAGE(PG8_SB(1, 0), b3, voffB); PG8_STAGE(PG8_SB(1, 1), b3 + hstep, voffB); PG8_STAGE(PG8_SA(1, 0), a3, voffA);
            PG8_WAIT_V(8); PG8_WAIT_L(0); PG8_BAR; PG8_MMA(1, 0, At, B0); PG8_MMA(1, 1, At, B1); PG8_BAR; PG8_SCHED;
            } else {
            PG8_LDB(B0, 0, 0); PG8_SCHED; PG8_LDA(At, 0, 0); PG8_STAGE(PG8_SA(1, 1), a1 + hstep, voffA);
            PG8_WAIT_L(8); PG8_BAR; PG8_WAIT_L(0); PG8_MMA(0, 0, At, B0); PG8_BAR; PG8_SCHED;
            PG8_LDB(B1, 0, 1); PG8_STAGE(PG8_SB(0, 0), b2, voffB);
            PG8_BAR; PG8_WAIT_L(0); PG8_MMA(0, 1, At, B1); PG8_BAR;
            PG8_LDA(At, 0, 1); PG8_STAGE(PG8_SA(0, 0), a2, voffA);
            PG8_BAR; PG8_WAIT_L(0); PG8_MMA(1, 0, At, B0); PG8_BAR; PG8_SCHED;
            PG8_STAGE(PG8_SB(0, 1), b2 + hstep, voffB);
            PG8_WAIT_V(6); PG8_BAR; PG8_MMA(1, 1, At, B1); PG8_BAR;
            PG8_LDB(B0, 1, 0); PG8_SCHED; PG8_LDA(At, 1, 0); PG8_STAGE(PG8_SA(0, 1), a2 + hstep, voffA);
            PG8_WAIT_L(8); PG8_BAR; PG8_WAIT_L(0); PG8_MMA(0, 0, At, B0); PG8_BAR; PG8_SCHED;
            PG8_LDB(B1, 1, 1); PG8_STAGE(PG8_SB(1, 0), b3, voffB);
            PG8_BAR; PG8_WAIT_L(0); PG8_MMA(0, 1, At, B1); PG8_BAR;
            PG8_LDA(At, 1, 1); PG8_STAGE(PG8_SA(1, 0), a3, voffA);
            PG8_BAR; PG8_WAIT_L(0); PG8_MMA(1, 0, At, B0); PG8_BAR; PG8_SCHED;
            PG8_STAGE(PG8_SB(1, 1), b3 + hstep, voffB);
            PG8_WAIT_V(6); PG8_BAR; PG8_MMA(1, 1, At, B1); PG8_BAR;
            }
        }
        if constexpr (ALIGN_EPI) { if (wr == 0) PG8_BAR; }
        if constexpr (!Epi::AFTER_DRAIN) { E(acc, cur, wr, wc, fr, fq); S.done(cur); }
        if (!has_next) break;
#pragma unroll
        for (int a = 0; a < 2; ++a)
#pragma unroll
            for (int b = 0; b < 2; ++b)
#pragma unroll
                for (int m = 0; m < 4; ++m)
#pragma unroll
                    for (int n = 0; n < 2; ++n) acc[a][b][m][n] = (f32x4){0.f, 0.f, 0.f, 0.f};
        cur = nxt; cA = nA; cB = nB; ++ui;
        if constexpr (ALIGN_EPI) { if (wr == 1) PG8_BAR; }
    }
    PG8_WAIT_V(0);
    if constexpr (!ALIGN_EPI) { if (wr == 0) PG8_BAR; }
    PG8_BAR;
    if constexpr (Epi::AFTER_DRAIN) { E.fused(acc, cur, wr, wc, fr, fq, lds, wid, lane); S.done(cur); }
#undef PG8_SA
#undef PG8_SB
#undef PG8_STAGE
#undef PG8_LDA
#undef PG8_LDB
#undef PG8_MMA
#undef PG8_WAIT_V
#undef PG8_WAIT_L
#undef PG8_BAR
#undef PG8_SCHED
}
}

constexpr int BATCH = 8, SEQ = 4096, DM = 1024, MTOK = BATCH * SEQ, HYW = 512, NIN = 3072, DFF = 4096;
constexpr int NWAVES = 8, NTHR = 512;
constexpr float NORM_EPS = 1e-6f, SUBLN_EPS = 1e-5f;
constexpr float QSCALE = 0.125f * 1.4426950408889634f;
constexpr int HRLEN = 8224;
constexpr size_t MiB = 1u << 20;
constexpr size_t WS_WIN = 0, WS_WOUT = 6 * MiB, WS_WUP = 8 * MiB, WS_WDOWN = 16 * MiB;
constexpr size_t WS_HR = 24 * MiB;
constexpr size_t WS_ROPE = 33 * MiB;
constexpr size_t WS_CTL = 34 * MiB, CTL_BYTES = 16384 + 3 * 131072;
constexpr size_t CTL_CNT = 14336, CTL_SS = 16384;
constexpr size_t WS_XN = 40 * MiB;
constexpr size_t WS_MO = 104 * MiB;
constexpr size_t WS_YT = 168 * MiB;
constexpr size_t WS_UVT = 200 * MiB;
constexpr size_t WS_QK = 328 * MiB;
constexpr size_t WS_KT = 360 * MiB;
constexpr size_t WS_VT = 296 * MiB;
constexpr size_t WS_MIX = 392 * MiB;
constexpr size_t WS_H = 200 * MiB;
constexpr size_t WS_END = 456 * MiB;
constexpr int LDS_BYTES = 135168;

#define LAS __attribute__((address_space(3)))
typedef unsigned short bf16;
typedef unsigned u32x4 __attribute__((ext_vector_type(4)));
typedef unsigned u32x2 __attribute__((ext_vector_type(2)));
typedef float f32x4 __attribute__((ext_vector_type(4)));
typedef float f32x16 __attribute__((ext_vector_type(16)));
typedef short bf16x8 __attribute__((ext_vector_type(8)));
typedef short s16x4 __attribute__((ext_vector_type(4)));

__device__ __forceinline__ unsigned f2bf(float f) { unsigned u = __builtin_bit_cast(unsigned, f); return (u + 0x7fffu + ((u >> 16) & 1u)) >> 16; }
__device__ __forceinline__ unsigned pk2(float lo, float hi) { return f2bf(lo) | (f2bf(hi) << 16); }
typedef float f32x2_t __attribute__((ext_vector_type(2))); typedef __bf16 bf16x2_t __attribute__((ext_vector_type(2)));
__device__ __forceinline__ unsigned cvtpk(float lo, float hi) { f32x2_t v = {lo, hi}; bf16x2_t b = __builtin_convertvector(v, bf16x2_t); return __builtin_bit_cast(unsigned, b); }
__device__ __forceinline__ float bf2f(unsigned short b) { return __builtin_bit_cast(float, (unsigned)b << 16); }
__device__ __forceinline__ float bflo(unsigned w) { return __builtin_bit_cast(float, w << 16); }
__device__ __forceinline__ float bfhi(unsigned w) { return __builtin_bit_cast(float, w & 0xffff0000u); }
__device__ __forceinline__ float wave_sum(float v) {
#pragma unroll
    for (int o = 1; o < 64; o <<= 1) v += __shfl_xor(v, o);
    return v;
}
__device__ __forceinline__ float swap_hi(float v) { return __shfl_xor(v, 32); }
#define LDS_WAIT() asm volatile("s_waitcnt lgkmcnt(0)" ::: "memory")

struct Args { const float* in[25]; float* out; unsigned char* ws; int ph_lo, ph_hi; };

__device__ __forceinline__ int win_src(int n) {
    if (n < 1536) return n;
    if (n < 2048) return n + 1024;
    const int pp = n - 2048, grp = pp >> 6, p = pp & 63, g = p >> 3, e = p & 7;
    const int d = (e < 4) ? (4 * g + e) : (32 + 4 * g + (e - 4));
    return 1536 + grp * 64 + d;
}
template <bool PERMW>
__device__ __forceinline__ void p0_transpose_item(const float* W, int K, int N, bf16* WT, LAS float* scr, int item, int lane) {
    const int nblk = N / 32, kb = item / nblk, nb = item % nblk, k0 = 64 * kb, n0 = 32 * nb;
    const int sc = PERMW ? win_src(n0 + (lane & 31)) : (n0 + (lane & 31));
#pragma unroll 8
    for (int i = 0; i < 32; ++i) { const int kk = 2 * i + (lane >> 5); scr[kk * 33 + (lane & 31)] = W[(size_t)(k0 + kk) * N + sc]; }
    LDS_WAIT(); asm volatile("" ::: "memory");
    const int c = lane & 7;
#pragma unroll
    for (int j = 0; j < 4; ++j) { const int n = (lane >> 3) + 8 * j; const LAS float* s = scr + (8 * c) * 33 + n;
        u32x4 o; o.x = pk2(s[0 * 33], s[1 * 33]); o.y = pk2(s[2 * 33], s[3 * 33]); o.z = pk2(s[4 * 33], s[5 * 33]); o.w = pk2(s[6 * 33], s[7 * 33]);
        *(u32x4*)(WT + (size_t)(n0 + n) * K + k0 + 8 * c) = o; }
    LDS_WAIT(); asm volatile("" ::: "memory");
}
__device__ __forceinline__ void rms_row_to_bf16(const float* xrow, const float* gain, bf16* orow, int lane) {
    const f32x4* xr = (const f32x4*)xrow + lane; const f32x4* gr = (const f32x4*)gain + lane;
    f32x4 v[4]; float s = 0.f;
#pragma unroll
    for (int j = 0; j < 4; ++j) { v[j] = xr[64 * j]; s += (v[j].x * v[j].x + v[j].y * v[j].y) + (v[j].z * v[j].z + v[j].w * v[j].w); }
    const float r = 1.0f / sqrtf(wave_sum(s) * (1.f / DM) + NORM_EPS);
    unsigned long long* o8 = (unsigned long long*)orow + lane;
#pragma unroll
    for (int j = 0; j < 4; ++j) { const f32x4 g = gr[64 * j];
        o8[64 * j] = (unsigned long long)pk2(v[j].x * r * g.x, v[j].y * r * g.y) | ((unsigned long long)pk2(v[j].z * r * g.z, v[j].w * r * g.w) << 32); }
}

__device__ __forceinline__ void filter_item(LAS unsigned char* lds, const Args& a, bf16* HR, int pg, int tid) {
    LAS float* Z = (LAS float*)lds;
    LAS float* HA = Z + 16 * 33;
    LAS float* HB = HA + 16 * 64;
    LAS float* W1 = HB + 16 * 64;
    LAS float* W2 = W1 + 33 * 64;
    LAS float* W3 = W2 + 64 * 64;
    const float* w1 = a.in[6]; const float* b1 = a.in[7]; const float* w2 = a.in[8]; const float* b2 = a.in[9];
    const float* w3 = a.in[10]; const float* b3 = a.in[11]; const float* w4 = a.in[12]; const float* freq = a.in[13]; const float* fbias = a.in[14];
    const int t0 = 16 * pg;
    for (int i = tid; i < 33 * 64; i += NTHR) W1[i] = w1[i];
    for (int i = tid; i < 64 * 64; i += NTHR) { W2[i] = w2[i]; W3[i] = w3[i]; }
    for (int i = tid; i < 16 * 33; i += NTHR) { const int p = i / 33, f = i % 33; const int pos = t0 + p; float val;
        if (f == 0) val = (float)pos * (1.0f / (float)(SEQ - 1));
        else { const int j = (f - 1) & 15; const float fj = 1e-4f + (float)j * ((15.0f - 1e-4f) / 15.0f); const float w = (6.283185307179586f / (float)SEQ) * (float)pos; const float arg = fj * w;
            val = (f <= 16) ? cosf(arg) : -sinf(arg); }
        Z[i] = val; }
    __syncthreads();
    for (int o = tid; o < 1024; o += NTHR) { const int p = o >> 6, n = o & 63; float acc = b1[n];
#pragma unroll 3
        for (int f = 0; f < 33; ++f) acc += Z[p * 33 + f] * W1[f * 64 + n];
        HA[o] = sinf(freq[n] * acc); }
    __syncthreads();
    for (int o = tid; o < 1024; o += NTHR) { const int p = o >> 6, n = o & 63; float acc = b2[n];
#pragma unroll 4
        for (int f = 0; f < 64; ++f) acc += HA[p * 64 + f] * W2[f * 64 + n];
        HB[o] = sinf(freq[n] * acc); }
    __syncthreads();
    for (int o = tid; o < 1024; o += NTHR) { const int p = o >> 6, n = o & 63; float acc = b3[n];
#pragma unroll 4
        for (int f = 0; f < 64; ++f) acc += HB[p * 64 + f] * W3[f * 64 + n];
        HA[o] = sinf(freq[n] * acc); }
    __syncthreads();
    {   const int c = tid;
        float af[16], ab[16];
#pragma unroll
        for (int p = 0; p < 16; ++p) { af[p] = 0.f; ab[p] = 0.f; }
        for (int k0 = 0; k0 < 64; k0 += 8) { float wf[8], wb[8];
#pragma unroll
            for (int kk = 0; kk < 8; ++kk) { wf[kk] = w4[(k0 + kk) * 1024 + c]; wb[kk] = w4[(k0 + kk) * 1024 + 512 + c]; }
#pragma unroll
            for (int kk = 0; kk < 8; ++kk)
#pragma unroll
                for (int p = 0; p < 16; ++p) { const float hv = HA[p * 64 + k0 + kk]; af[p] += hv * wf[kk]; ab[p] += hv * wb[kk]; } }
        const float min_decay = -4.605170185988091f / 1.5f, max_decay = -4.605170185988091f / 0.3f;
        const float adelta = fabsf(min_decay + (float)c * ((max_decay - min_decay) / 511.0f));
        bf16* hr = HR + (size_t)c * HRLEN;
#pragma unroll
        for (int p = 0; p < 16; ++p) { const int pos = t0 + p; const float tl = (float)pos * (1.0f / (float)(SEQ - 1)); const float dec = expf(-tl * adelta);
            const float vf = af[p] * dec, vb = ab[p] * dec;
            if (pos == 0) hr[4096] = (bf16)f2bf(vf + vb + fbias[c]);
            else { hr[4096 - pos] = (bf16)f2bf(vf); hr[4096 + pos] = (bf16)f2bf(vb); } }
        if (pg == 0) { hr[0] = 0; for (int i = 8192; i < HRLEN; ++i) hr[i] = 0; }
    }
    __syncthreads();
}

namespace att {
constexpr int KP = 272, VP = 144, KBUF = 64 * KP, VBUF = 128 * VP, VOFF = 2 * KBUF;
constexpr int NT = SEQ / 64;
__device__ __forceinline__ float max3(float a, float b, float c) { return fmaxf(fmaxf(a, b), c); }
__device__ __forceinline__ float fadd_s(float a, float b) { float r; asm("v_add_f32_e32 %0, %1, %2" : "=v"(r) : "v"(a), "v"(b)); return r; }
#define SBAR() __builtin_amdgcn_sched_barrier(0)
__device__ __forceinline__ void v_load(bf16x8 (&vf)[4], const LAS unsigned char* vb, int ks) {
#pragma unroll
    for (int e = 0; e < 4; ++e) vf[e] = *(const LAS bf16x8*)(vb + e * 32 * VP + ks * 32);
}
__device__ __forceinline__ void pv_tile(f32x16 (&o)[4], const u32x4 (&P)[4], bf16x8 (&vf0)[4], const LAS unsigned char* vb) {
    bf16x8 vf1[4];
#pragma unroll
    for (int ks = 0; ks < 4; ++ks) { const bf16x8 pb = __builtin_bit_cast(bf16x8, P[ks]);
        if (ks == 0 || ks == 2) v_load(vf1, vb, ks + 1); else if (ks == 1) v_load(vf0, vb, 2);
        SBAR(); __builtin_amdgcn_s_setprio(1);
#pragma unroll
        for (int e = 0; e < 4; ++e) o[e] = __builtin_amdgcn_mfma_f32_32x32x16_bf16((ks & 1) ? vf1[e] : vf0[e], pb, o[e], 0, 0, 0);
        __builtin_amdgcn_s_setprio(0); SBAR(); }
}
__device__ __forceinline__ float xhalf_max(float v) { auto rr = __builtin_amdgcn_permlane32_swap(__float_as_uint(v), __float_as_uint(v), false, false); return fmaxf(__uint_as_float(rr[0]), __uint_as_float(rr[1])); }
__device__ __forceinline__ float xhalf_sum(float v) { auto rr = __builtin_amdgcn_permlane32_swap(__float_as_uint(v), __float_as_uint(v), false, false); return __uint_as_float(rr[0]) + __uint_as_float(rr[1]); }
constexpr int QOFF = 2 * KBUF + 3 * VBUF;
#define ATT_SLOT(T, PKW, PVW, PKL, PVL) do { const int t = (T); \
        const LAS unsigned char* kst = lds + (t & 1) * KBUF; \
        bf16x8 vf0[4]; \
        if (c == 1 && t > 0 && VAR != 5) { v_load(vf0, lds + VOFF + vprev + voff, 0); pv_tile(o, P, vf0, lds + VOFF + vprev + voff); } \
        if (t + 2 < NT && VAR != 4) { _Pragma("unroll") for (int i = 0; i < 2; ++i) { PKL[i] = *(const u32x4*)(gk[i] + (size_t)(t + 2) * 8192); PVL[i] = *(const u32x4*)(gv[i] + (size_t)(t + 2) * 8192); } } \
        SBAR(); \
        f32x16 s0, s1; \
        { const LAS unsigned char* kb = kst + r32 * KP + c * 128 + hi * 16; const LAS unsigned char* qb_ = lds + QOFF + wid * 4096 + lane * 16; \
          bf16x8 ka[4], kc2[4], qa[2], qc[2]; \
          qa[0] = *(const LAS bf16x8*)(qb_); qa[1] = *(const LAS bf16x8*)(qb_ + 1024); \
          ka[0] = *(const LAS bf16x8*)(kb); ka[1] = *(const LAS bf16x8*)(kb + 32 * KP); ka[2] = *(const LAS bf16x8*)(kb + 32); ka[3] = *(const LAS bf16x8*)(kb + 32 * KP + 32); \
          SBAR(); \
          qc[0] = *(const LAS bf16x8*)(qb_ + 2048); qc[1] = *(const LAS bf16x8*)(qb_ + 3072); \
          kc2[0] = *(const LAS bf16x8*)(kb + 64); kc2[1] = *(const LAS bf16x8*)(kb + 32 * KP + 64); kc2[2] = *(const LAS bf16x8*)(kb + 96); kc2[3] = *(const LAS bf16x8*)(kb + 32 * KP + 96); \
          __builtin_amdgcn_s_setprio(1); s0 = __builtin_amdgcn_mfma_f32_32x32x16_bf16(ka[0], qa[0], zero16, 0, 0, 0); s1 = __builtin_amdgcn_mfma_f32_32x32x16_bf16(ka[1], qa[0], zero16, 0, 0, 0); \
          s0 = __builtin_amdgcn_mfma_f32_32x32x16_bf16(ka[2], qa[1], s0, 0, 0, 0); s1 = __builtin_amdgcn_mfma_f32_32x32x16_bf16(ka[3], qa[1], s1, 0, 0, 0); \
          SBAR(); \
          s0 = __builtin_amdgcn_mfma_f32_32x32x16_bf16(kc2[0], qc[0], s0, 0, 0, 0); s1 = __builtin_amdgcn_mfma_f32_32x32x16_bf16(kc2[1], qc[0], s1, 0, 0, 0); \
          s0 = __builtin_amdgcn_mfma_f32_32x32x16_bf16(kc2[2], qc[1], s0, 0, 0, 0); s1 = __builtin_amdgcn_mfma_f32_32x32x16_bf16(kc2[3], qc[1], s1, 0, 0, 0); __builtin_amdgcn_s_setprio(0); } \
        if (c == 0 && VAR != 5) v_load(vf0, lds + VOFF + vcur + voff, 0); \
        SBAR(); \
        if (VAR != 6) { float mx = max3(s0[0], s1[0], s0[1]); \
        mx = max3(mx, s1[1], s0[2]); mx = max3(mx, s1[2], s0[3]); mx = max3(mx, s1[3], s0[4]); mx = max3(mx, s1[4], s0[5]); \
        mx = max3(mx, s1[5], s0[6]); mx = max3(mx, s1[6], s0[7]); mx = max3(mx, s1[7], s0[8]); mx = max3(mx, s1[8], s0[9]); \
        mx = max3(mx, s1[9], s0[10]); mx = max3(mx, s1[10], s0[11]); mx = max3(mx, s1[11], s0[12]); mx = max3(mx, s1[12], s0[13]); \
        mx = max3(mx, s1[13], s0[14]); mx = max3(mx, s1[14], s0[15]); mx = fmaxf(mx, s1[15]); \
        mx = xhalf_max(mx); \
        if (t == 0) { if (__any(fabsf(mx) > 8.0f)) { mref = mx; gen = true; } } \
        else if (__any(mx > mref + 8.0f)) { const float mnew = fmaxf(mx, mref); const float al = __builtin_amdgcn_exp2f(mref - mnew); \
            _Pragma("unroll") for (int e = 0; e < 4; ++e) _Pragma("unroll") for (int r = 0; r < 16; ++r) o[e][r] *= al; \
            lsum *= al; mref = mnew; gen = true; } \
        float ps0 = 0.f, ps1 = 0.f; \
        if (gen) { _Pragma("unroll") for (int r = 0; r < 16; ++r) { s0[r] = __builtin_amdgcn_exp2f(s0[r] - mref); s1[r] = __builtin_amdgcn_exp2f(s1[r] - mref); ps0 += s0[r]; ps0 += s1[r]; } } \
        else { _Pragma("unroll") for (int r = 0; r < 16; ++r) { s0[r] = __builtin_amdgcn_exp2f(s0[r]); s1[r] = __builtin_amdgcn_exp2f(s1[r]); ps0 += s0[r]; ps0 += s1[r]; } } \
        lsum += ps0 + ps1; } \
        P[0] = (u32x4){cvtpk(s0[0], s0[1]), cvtpk(s0[2], s0[3]), cvtpk(s0[4], s0[5]), cvtpk(s0[6], s0[7])}; \
        P[1] = (u32x4){cvtpk(s0[8], s0[9]), cvtpk(s0[10], s0[11]), cvtpk(s0[12], s0[13]), cvtpk(s0[14], s0[15])}; \
        P[2] = (u32x4){cvtpk(s1[0], s1[1]), cvtpk(s1[2], s1[3]), cvtpk(s1[4], s1[5]), cvtpk(s1[6], s1[7])}; \
        P[3] = (u32x4){cvtpk(s1[8], s1[9]), cvtpk(s1[10], s1[11]), cvtpk(s1[12], s1[13]), cvtpk(s1[14], s1[15])}; \
        if (c == 0 && VAR != 5) pv_tile(o, P, vf0, lds + VOFF + vcur + voff); \
        if (t + 1 < NT && VAR != 4) { LAS unsigned char* kn = lds + ((t + 1) & 1) * KBUF; LAS unsigned char* vn = lds + vnext; \
            _Pragma("unroll") for (int i = 0; i < 2; ++i) { *(LAS u32x4*)(kn + lk[i]) = PKW[i]; *(LAS u32x4*)(vn + lv[i]) = PVW[i]; } } \
        { const int tmp = vprev; vprev = vcur; vcur = vnext; vnext = tmp; } \
        if (VAR != 3) { asm volatile("s_waitcnt lgkmcnt(0)\n\ts_barrier" ::: "memory"); } \
    } while (0)
template <int VAR> __device__ __forceinline__ void unit(LAS unsigned char* lds, const bf16* QK, const bf16* KT, const bf16* VT, bf16* MIX, const float* sgain, float lam, int b, int h, int qb) {
    const int tid = threadIdx.x, lane = tid & 63, r32 = lane & 31, hi = lane >> 5; const int wid = __builtin_amdgcn_readfirstlane(tid >> 6);
    const int qsub = wid & 3, c = wid >> 2;
    const size_t rowbase = (size_t)b * SEQ; const int q0 = qb * 128 + qsub * 32;
    { const bf16* qp = QK + (rowbase + q0 + r32) * 512 + h * 128 + c * 64 + hi * 8;
#pragma unroll
      for (int ds = 0; ds < 4; ++ds) *(LAS bf16x8*)(lds + QOFF + wid * 4096 + ds * 1024 + lane * 16) = *(const bf16x8*)(qp + ds * 16); }
    const bf16* gk[2]; const bf16* gv[2]; int lk[2], lv[2];
#pragma unroll
    for (int i = 0; i < 2; ++i) { const int id = tid + NTHR * i; const int kr = id >> 4, kc = id & 15; const int ve = id >> 3, vc = id & 7;
        gk[i] = KT + (size_t)(b * 4 + h) * 64 * 8192 + id * 8; lk[i] = kr * KP + kc * 16;
        gv[i] = VT + (size_t)(b * 4 + h) * 64 * 8192 + id * 8; lv[i] = VOFF + ve * VP + vc * 16; }
    u32x4 pkA[2], pvA[2], pkB[2], pvB[2];
#pragma unroll
    for (int i = 0; i < 2; ++i) { pkA[i] = *(const u32x4*)gk[i]; pvA[i] = *(const u32x4*)gv[i]; }
#pragma unroll
    for (int i = 0; i < 2; ++i) { pkB[i] = *(const u32x4*)(gk[i] + 8192); pvB[i] = *(const u32x4*)(gv[i] + 8192); }
#pragma unroll
    for (int i = 0; i < 2; ++i) { *(LAS u32x4*)(lds + lk[i]) = pkA[i]; *(LAS u32x4*)(lds + lv[i]) = pvA[i]; }
    __syncthreads();
    f32x16 o[4];
#pragma unroll
    for (int e = 0; e < 4; ++e) o[e] = (f32x16){};
    const f32x16 zero16 = (f32x16){};
    float mref = 0.f, lsum = 0.f; bool gen = false;
    u32x4 P[4];
#pragma unroll
    for (int ks = 0; ks < 4; ++ks) P[ks] = (u32x4){0u, 0u, 0u, 0u};
    int vcur = 0, vprev = 2 * VBUF, vnext = VBUF;
    const int voff = r32 * VP + hi * 16;
    for (int tt = 0; tt < NT; tt += 2) {
        ATT_SLOT(tt, pkB, pvB, pkA, pvA);
        ATT_SLOT(tt + 1, pkA, pvA, pkB, pvB);
    }
    if (c == 1) { bf16x8 vf0[4]; v_load(vf0, lds + VOFF + vprev + voff, 0); pv_tile(o, P, vf0, lds + VOFF + vprev + voff); }
    __syncthreads();
    lsum = xhalf_sum(lsum);
    const float sc = (c == 0) ? (1.0f / lsum) : (lam / lsum);
    LAS float* X = (LAS float*)lds + qsub * (128 * 32);
    if (c == 1) {
#pragma unroll
        for (int e = 0; e < 4; ++e)
#pragma unroll
            for (int r = 0; r < 16; ++r) { const int ee = 32 * e + (r & 3) + 8 * (r >> 2) + 4 * hi; X[ee * 32 + r32] = o[e][r] * sc; } }
    __syncthreads();
    if (c == 0) { float ss = 0.f;
#pragma unroll
        for (int e = 0; e < 4; ++e)
#pragma unroll
            for (int r = 0; r < 16; ++r) { const int ee = 32 * e + (r & 3) + 8 * (r >> 2) + 4 * hi; const float v = o[e][r] * sc - X[ee * 32 + r32]; o[e][r] = v; ss += v * v; }
        ss = xhalf_sum(ss);
        const float rs = (1.0f / sqrtf(ss * (1.0f / 128.0f) + SUBLN_EPS)) * 0.8f;
        bf16* op = MIX + (rowbase + q0 + r32) * 1024 + 512 + h * 128;
#pragma unroll
        for (int e = 0; e < 4; ++e)
#pragma unroll
            for (int q4 = 0; q4 < 4; ++q4) { const int ee = 32 * e + 8 * q4 + 4 * hi; const f32x4 g = *(const f32x4*)(sgain + ee);
                u32x2 w; w.x = cvtpk(o[e][4 * q4] * rs * g.x, o[e][4 * q4 + 1] * rs * g.y); w.y = cvtpk(o[e][4 * q4 + 2] * rs * g.z, o[e][4 * q4 + 3] * rs * g.w);
                *(u32x2*)(op + ee) = w; } }
    __syncthreads();
}
}

namespace hy {
constexpr int UP = 264, UBUF = 32 * UP * 2, HRB = HRLEN * 2;
constexpr int NCH = 17;
__device__ __forceinline__ float ldbf(const bf16* p) { return bf2f(*p); }
struct StageRegs { u32x2 xa, xb, va, vb; unsigned short xm, vm; };
__device__ __forceinline__ void stage_load(StageRegs& R, const bf16* X1, const bf16* V, int j, int tid) {
    const int b = tid >> 6, tt = tid & 63; const int S0 = 256 * j + 4 * tt - 4;
    const bool okA = (S0 >= 0 && S0 < SEQ), okB = (S0 + 4 < SEQ), okM = (S0 >= 1 && S0 <= SEQ);
    const size_t ia = (size_t)b * SEQ + (okA ? S0 : 0), ib = (size_t)b * SEQ + (okB ? S0 + 4 : 0), im = (size_t)b * SEQ + (okM ? S0 - 1 : 0);
    R.xa = *(const u32x2*)(X1 + ia); R.xb = *(const u32x2*)(X1 + ib); R.xm = X1[im];
    R.va = *(const u32x2*)(V + ia); R.vb = *(const u32x2*)(V + ib); R.vm = V[im];
}
__device__ __forceinline__ void stage_write(LAS unsigned char* ub, const StageRegs& R, const float (&w1)[4], const float (&wv)[4], int j, int tid) {
    const int b = tid >> 6, tt = tid & 63; const int S0 = 256 * j + 4 * tt - 4;
    const bool okA = (S0 >= 0 && S0 < SEQ), okB = (S0 + 4 < SEQ), okM = (S0 >= 1 && S0 <= SEQ);
    float xs[9], vs[9];
    xs[0] = okM ? bf2f(R.xm) : 0.f; vs[0] = okM ? bf2f(R.vm) : 0.f;
    xs[1] = okA ? bflo(R.xa.x) : 0.f; xs[2] = okA ? bfhi(R.xa.x) : 0.f; xs[3] = okA ? bflo(R.xa.y) : 0.f; xs[4] = okA ? bfhi(R.xa.y) : 0.f;
    xs[5] = okB ? bflo(R.xb.x) : 0.f; xs[6] = okB ? bfhi(R.xb.x) : 0.f; xs[7] = okB ? bflo(R.xb.y) : 0.f; xs[8] = okB ? bfhi(R.xb.y) : 0.f;
    vs[1] = okA ? bflo(R.va.x) : 0.f; vs[2] = okA ? bfhi(R.va.x) : 0.f; vs[3] = okA ? bflo(R.va.y) : 0.f; vs[4] = okA ? bfhi(R.va.y) : 0.f;
    vs[5] = okB ? bflo(R.vb.x) : 0.f; vs[6] = okB ? bfhi(R.vb.x) : 0.f; vs[7] = okB ? bflo(R.vb.y) : 0.f; vs[8] = okB ? bfhi(R.vb.y) : 0.f;
    float g[7];
#pragma unroll
    for (int i = 0; i < 7; ++i) { const float cx = w1[0] * xs[i] + w1[1] * xs[i + 1] + w1[2] * xs[i + 2] + w1[3]; const float cv = wv[0] * vs[i] + wv[1] * vs[i + 1] + wv[2] * vs[i + 2] + wv[3];
        g[i] = ((i < 4) ? okA : okB) ? cx * cv : 0.f; }
#pragma unroll
    for (int r = 0; r < 4; ++r) { u32x2 w; w.x = pk2(g[r], g[r + 1]); w.y = pk2(g[r + 2], g[r + 3]);
        *(LAS u32x2*)(ub + ((4 * b + r) * UP + 4 * tt) * 2) = w; }
}
__device__ __forceinline__ void channel(LAS unsigned char* lds, const bf16* UVT, const bf16* HR, const float* conv_w, const float* conv_b, bf16* YT, int c) {
    const int tid = threadIdx.x, lane = tid & 63, r32 = lane & 31, hi = lane >> 5; const int wid = __builtin_amdgcn_readfirstlane(tid >> 6);
    const bf16* X0 = UVT + (size_t)c * MTOK; const bf16* X1 = UVT + (size_t)(512 + c) * MTOK; const bf16* V = UVT + (size_t)(1024 + c) * MTOK;
    float w0[4], w1[4], wv[4];
#pragma unroll
    for (int k = 0; k < 3; ++k) { w0[k] = conv_w[k * 1536 + c]; w1[k] = conv_w[k * 1536 + 512 + c]; wv[k] = conv_w[k * 1536 + 1024 + c]; }
    w0[3] = conv_b[c]; w1[3] = conv_b[512 + c]; wv[3] = conv_b[1024 + c];
    for (int i = tid; i < HRB / 16; i += NTHR) { const bf16* src = HR + (size_t)c * HRLEN + 8 * i; ((LAS u32x4*)lds)[i] = *(const u32x4*)src;
        const u32x2 lo = *(const u32x2*)(src + 4); const u32x2 hi2 = (8 * i + 8 < HRLEN) ? *(const u32x2*)(src + 8) : (u32x2){0u, 0u};
        ((LAS u32x4*)(lds + HRB))[i] = (u32x4){lo.x, lo.y, hi2.x, hi2.y}; }
    LAS unsigned char* ub0 = lds + 2 * HRB;
    StageRegs SR;
    stage_load(SR, X1, V, 0, tid); stage_write(ub0, SR, w1, wv, 0, tid);
    __syncthreads();
    f32x16 acc[4];
#pragma unroll
    for (int n = 0; n < 4; ++n) acc[n] = (f32x16){};
    const int idx0 = 4096 - 4 * (128 * wid + r32) - 4 + 8 * hi;
    const int hb0 = (r32 & 1) ? idx0 * 2 : HRB + (idx0 - 4) * 2;
    for (int j = 0; j < NCH; ++j) {
        LAS unsigned char* ucur = ub0 + (j & 1) * UBUF;
        if (j + 1 < NCH) stage_load(SR, X1, V, j + 1, tid);
        const int nks = (j < NCH - 1) ? 16 : 1;
        const LAS unsigned char* ua = ucur + r32 * (UP * 2) + hi * 16;
        const LAS unsigned char* hp = lds + hb0 + j * 512;
        if (nks == 16) {
            bf16x8 a0, b0[4], a1, b1[4];
            a0 = *(const LAS bf16x8*)(ua);
#pragma unroll
            for (int n = 0; n < 4; ++n) b0[n] = *(const LAS bf16x8*)(hp - n * 256);
#pragma unroll
            for (int ks = 0; ks < 16; ks += 2) {
                a1 = *(const LAS bf16x8*)(ua + (ks + 1) * 32);
#pragma unroll
                for (int n = 0; n < 4; ++n) b1[n] = *(const LAS bf16x8*)(hp + (ks + 1) * 32 - n * 256);
                __builtin_amdgcn_sched_barrier(0);
#pragma unroll
                for (int n = 0; n < 4; ++n) acc[n] = __builtin_amdgcn_mfma_f32_32x32x16_bf16(a0, b0[n], acc[n], 0, 0, 0);
                __builtin_amdgcn_sched_barrier(0);
                if (ks + 2 < 16) { a0 = *(const LAS bf16x8*)(ua + (ks + 2) * 32);
#pragma unroll
                    for (int n = 0; n < 4; ++n) b0[n] = *(const LAS bf16x8*)(hp + (ks + 2) * 32 - n * 256); }
                __builtin_amdgcn_sched_barrier(0);
#pragma unroll
                for (int n = 0; n < 4; ++n) acc[n] = __builtin_amdgcn_mfma_f32_32x32x16_bf16(a1, b1[n], acc[n], 0, 0, 0);
                __builtin_amdgcn_sched_barrier(0);
            }
        } else {
            const bf16x8 a = *(const LAS bf16x8*)(ua);
#pragma unroll
            for (int n = 0; n < 4; ++n) { const bf16x8 bb = *(const LAS bf16x8*)(hp - n * 256);
                acc[n] = __builtin_amdgcn_mfma_f32_32x32x16_bf16(a, bb, acc[n], 0, 0, 0); }
        }
        if (j + 1 < NCH) stage_write(ub0 + ((j + 1) & 1) * UBUF, SR, w1, wv, j + 1, tid);
        __syncthreads();
    }
#pragma unroll
    for (int n = 0; n < 4; ++n) { const int t = 4 * (128 * wid + 32 * n + r32);
#pragma unroll
        for (int q = 0; q < 4; ++q) { const int b = 2 * q + hi; const bf16* xp = X0 + (size_t)b * SEQ + t; const u32x2 xa = *(const u32x2*)xp; float xs[6];
            { const float xm = ldbf(xp - ((t > 0) ? 1 : 0)), xq = ldbf(xp + ((t + 4 < SEQ) ? 4 : 0)); xs[0] = (t > 0) ? xm : 0.f; xs[5] = (t + 4 < SEQ) ? xq : 0.f; }
            xs[1] = bflo(xa.x); xs[2] = bfhi(xa.x); xs[3] = bflo(xa.y); xs[4] = bfhi(xa.y);
            float y[4];
#pragma unroll
            for (int i = 0; i < 4; ++i) y[i] = acc[n][4 * q + i] * (w0[0] * xs[i] + w0[1] * xs[i + 1] + w0[2] * xs[i + 2] + w0[3]);
            u32x2 w; w.x = pk2(y[0], y[1]); w.y = pk2(y[2], y[3]);
            *(u32x2*)(YT + (size_t)c * MTOK + (size_t)b * SEQ + t) = w; } }
    __syncthreads();
}
}

#define XB_TMO      128
#define XB_XCNT(j)  (256  + 64 * (j))
#define XB_XSUB(j)  (1280 + 64 * (j))
#define XB_XGEN(j)  (2304 + 64 * (j))
#define XB_TOP      3328
#define XB_TOPGEN   3392
#define XCD_BAR_WORDS 3456
#define XB_SPIN_CAP (1u << 18)

__device__ __forceinline__ unsigned xb_ld(unsigned* p)              { return __hip_atomic_load(p, __ATOMIC_RELAXED, __HIP_MEMORY_SCOPE_AGENT); }
__device__ __forceinline__ unsigned xb_add(unsigned* p, unsigned v) { return __hip_atomic_fetch_add(p, v, __ATOMIC_RELAXED, __HIP_MEMORY_SCOPE_AGENT); }
__device__ __forceinline__ unsigned xb_xcc_id() { return (unsigned)__builtin_amdgcn_s_getreg((3 << 11) | 20) & 0xFu; }
#define XB_SPIN(cond, bar) do { unsigned _sp = 0; while (cond) { __builtin_amdgcn_s_sleep(1); \
    if ((++_sp & 255u) == 0u) { if (xb_ld(&(bar)[XB_TMO])) break; if (_sp > XB_SPIN_CAP) { atomicAdd(&(bar)[XB_TMO], 1u); break; } } } } while (0)

struct XcdBarrier {
    unsigned* bar; unsigned x;
    volatile LAS unsigned* st;
};

__device__ __forceinline__ XcdBarrier xcd_barrier_post(unsigned* bar, volatile LAS unsigned* st) {
    XcdBarrier b; b.bar = bar; b.x = xb_xcc_id(); b.st = st;
    if (threadIdx.x == 0) (void)xb_add(&bar[XB_XCNT(b.x)], 1u);
    return b;
}
__device__ __forceinline__ void xcd_barrier_complete(unsigned* bar, unsigned x, unsigned& nloc, unsigned& nx) {
    const unsigned G = gridDim.x * gridDim.y * gridDim.z;
    unsigned sum, cnt, mine, sp = 0u;
    for (;;) {
        sum = 0u; cnt = 0u; mine = 0u;
#pragma unroll
        for (unsigned j = 0; j < 16; ++j) { const unsigned c = xb_ld(&bar[XB_XCNT(j)]); sum += c; cnt += (c > 0u) ? 1u : 0u; mine = (j == x) ? c : mine; }
        if (sum == G) break;
        __builtin_amdgcn_s_sleep(1);
        if ((++sp & 255u) == 0u) { if (xb_ld(&bar[XB_TMO])) break; if (sp > XB_SPIN_CAP) { atomicAdd(&bar[XB_TMO], 1u); break; } }
    }
    nloc = mine > 0u ? mine : 1u; nx = cnt > 0u ? cnt : 1u;
}

__device__ __forceinline__ void xcd_barrier(const XcdBarrier& b) {
    asm volatile("s_waitcnt vmcnt(0)" ::: "memory");
    __syncthreads();
    if (threadIdx.x == 0) {
        unsigned* bar = b.bar;
        __builtin_amdgcn_s_waitcnt(0);
        unsigned nloc = b.st[0], nx = b.st[1];
        if (nloc == 0u) { xcd_barrier_complete(bar, b.x, nloc, nx); b.st[0] = nloc; b.st[1] = nx; }
        const unsigned old = xb_add(&bar[XB_XSUB(b.x)], 1u);
        const unsigned gen = old / nloc;
        if (old + 1u == (gen + 1u) * nloc) {
            __builtin_amdgcn_fence(__ATOMIC_RELEASE, "agent");
            asm volatile("s_waitcnt vmcnt(0)" ::: "memory");
            const unsigned og = xb_add(&bar[XB_TOP], 1u);
            const unsigned tg = og / nx;
            if (og + 1u == (tg + 1u) * nx) xb_add(&bar[XB_TOPGEN], 1u);
            else XB_SPIN(xb_ld(&bar[XB_TOPGEN]) == tg, bar);
            __builtin_amdgcn_fence(__ATOMIC_ACQUIRE, "agent");
            xb_add(&bar[XB_XGEN(b.x)], 1u);
            asm volatile("s_waitcnt vmcnt(0)" ::: "memory");
        } else {
            XB_SPIN(xb_ld(&bar[XB_XGEN(b.x)]) == gen, bar);
            __builtin_amdgcn_fence(__ATOMIC_ACQUIRE, "agent");
            asm volatile("s_waitcnt vmcnt(0)" ::: "memory");
        }
    }
    __syncthreads();
}

__global__ void __launch_bounds__(NTHR, 2) fwd_kernel(Args a) {
    extern __shared__ __attribute__((aligned(16))) unsigned char lds_raw[];
    LAS unsigned char* lds = (LAS unsigned char*)lds_raw;
    const int tid = threadIdx.x, lane = tid & 63; const int wave = __builtin_amdgcn_readfirstlane(tid >> 6);
    const int G = gridDim.x, bx = blockIdx.x;
    const int gw = bx * NWAVES + wave, NGW = G * NWAVES;
    unsigned char* ws = a.ws;
    bf16* Win_t = (bf16*)(ws + WS_WIN); bf16* Wout_t = (bf16*)(ws + WS_WOUT); bf16* Wup_t = (bf16*)(ws + WS_WUP); bf16* Wdown_t = (bf16*)(ws + WS_WDOWN);
    bf16* HR = (bf16*)(ws + WS_HR); float* ROPE = (float*)(ws + WS_ROPE);
    bf16* XN = (bf16*)(ws + WS_XN); bf16* MO = (bf16*)(ws + WS_MO); bf16* YT = (bf16*)(ws + WS_YT); bf16* UVT = (bf16*)(ws + WS_UVT);
    bf16* QK = (bf16*)(ws + WS_QK); bf16* KT = (bf16*)(ws + WS_KT); bf16* VT = (bf16*)(ws + WS_VT); bf16* MIX = (bf16*)(ws + WS_MIX); bf16* HB = (bf16*)(ws + WS_H);
    const float* x = a.in[0];
    const int lo = a.ph_lo, hi_ph = a.ph_hi;
#if MK_COOP
    cg::grid_group grid = cg::this_grid();
    volatile LAS unsigned* bst = (volatile LAS unsigned*)(lds + 131072 + 64);
    if (tid < 4) bst[tid] = 0u;
    __syncthreads();
    XcdBarrier xbar = xcd_barrier_post((unsigned*)(ws + WS_CTL), bst);
#define SEAM(k) do { if (lo <= (k) && (k) + 1 < hi_ph) { if ((k) == 0) grid.sync(); else xcd_barrier(xbar); } } while (0)
#else
#define SEAM(k) do { } while (0)
#endif
#ifndef PHMASK
#define PHMASK 0x1ff
#endif
#define IN(k) (((PHMASK >> (k)) & 1) && lo <= (k) && (k) < hi_ph)

#ifndef DUP_P0
#define DUP_P0 1
#endif
    if (IN(0)) for (int rep0 = 0; rep0 < DUP_P0; ++rep0) {
        LAS float* scr = (LAS float*)(lds + wave * 16384);
        constexpr int I_IN = (DM / 64) * (NIN / 32), I_OUT = (DM / 64) * (DM / 32), I_UP = (DM / 64) * (DFF / 32), I_DN = (DFF / 64) * (DM / 32);
        for (int it = gw; it < I_IN + I_OUT + I_UP + I_DN; it += NGW) { int r = it;
            if (r < I_IN) { p0_transpose_item<true>(a.in[3], DM, NIN, Win_t, scr, r, lane); continue; } r -= I_IN;
            if (r < I_OUT) { p0_transpose_item<false>(a.in[20], DM, DM, Wout_t, scr, r, lane); continue; } r -= I_OUT;
            if (r < I_UP) { p0_transpose_item<false>(a.in[23], DM, DFF, Wup_t, scr, r, lane); continue; } r -= I_UP;
            p0_transpose_item<false>(a.in[24], DFF, DM, Wdown_t, scr, r, lane); }
        for (int m = gw; m < MTOK; m += NGW) rms_row_to_bf16(x + (size_t)m * DM, a.in[1], XN + (size_t)m * DM, lane);
        for (int i = bx * NTHR + tid; i < SEQ * 32; i += G * NTHR) { const int pos = i >> 5, k = i & 31;
            const float inv = exp2f(-(float)(2 * k) * (13.287712379549449f / 64.0f)); const float ang = (float)pos * inv;
            ROPE[2 * i] = cosf(ang); ROPE[2 * i + 1] = sinf(ang); }
        __syncthreads();
        for (int pg = bx; pg < SEQ / 16; pg += G) filter_item(lds, a, HR, pg, tid);
    }
    SEAM(0);
#ifndef DUP_P1
#define DUP_P1 1
#endif
    if (IN(1)) {
        { pg8::Gemm g{Win_t, XN, 2048, MTOK, DM}; pg8::StaticOrder S; S.init(2048, MTOK, G, bx);
          pg8::EpiUV E{UVT, VT};
          pg8::gemm_phase<pg8::EpiUV, pg8::StaticOrder, true, true>(lds, g, S, E); }
        { pg8::Gemm g{XN, Win_t + (size_t)2048 * DM, MTOK, 1024, DM}; pg8::StaticOrder S; S.init(MTOK, 1024, G, bx);
          pg8::EpiRope E{QK, KT, ROPE, QSCALE};
          pg8::gemm_phase<pg8::EpiRope, pg8::StaticOrder, true, true>(lds, g, S, E); }
    }
#if DUP_P1 == 2
    if (IN(1)) {
        { pg8::Gemm g{Win_t, XN, 2048, MTOK, DM}; pg8::StaticOrder S; S.init(2048, MTOK, G, bx);
          pg8::EpiUV E{UVT, VT};
          pg8::gemm_phase<pg8::EpiUV, pg8::StaticOrder, true, true>(lds, g, S, E); }
        { pg8::Gemm g{XN, Win_t + (size_t)2048 * DM, MTOK, 1024, DM}; pg8::StaticOrder S; S.init(MTOK, 1024, G, bx);
          pg8::EpiRope E{QK, KT, ROPE, QSCALE};
          pg8::gemm_phase<pg8::EpiRope, pg8::StaticOrder, true, true>(lds, g, S, E); }
    }
#endif
    SEAM(1);
    if (IN(2)) {
        float lam;
        { const float p1 = a.in[15][lane] * a.in[16][lane], p2 = a.in[17][lane] * a.in[18][lane];
          lam = expf(wave_sum(p1)) - expf(wave_sum(p2)) + 0.2f; }
#ifndef DUP_ATT
#define DUP_ATT 1
#endif
#ifndef DUP_HY
#define DUP_HY 1
#endif
#ifndef ATT_VAR
#define ATT_VAR 0
#endif
        for (int u = bx; u < 1024; u += G) { const int bh = (u & 7) + 8 * (u >> 8), qb = (u >> 3) & 31;
            att::unit<0>(lds, QK, KT, VT, MIX, a.in[19], lam, bh >> 2, bh & 3, qb); }
        if (DUP_ATT > 1)
        for (int u = bx; u < 1024; u += G) { const int bh = (u & 7) + 8 * (u >> 8), qb = (u >> 3) & 31;
            att::unit<ATT_VAR>(lds, QK, KT, VT, MO, a.in[19], lam, bh >> 2, bh & 3, qb); }
        for (int rep = 0; rep < DUP_HY; ++rep)
        for (int c = bx; c < HYW; c += G) hy::channel(lds, UVT, HR, a.in[4], a.in[5], YT, c);
    }
    SEAM(2);
#ifndef DUP_P3
#define DUP_P3 1
#endif
    if (IN(3)) for (int rep3 = 0; rep3 < DUP_P3; ++rep3) {
        LAS unsigned short* scr = (LAS unsigned short*)(lds + wave * 16384);
        for (int it = gw; it < 8 * (MTOK / 64); it += NGW) { const int ct = it & 7, mt = it >> 3; const int c0 = 64 * ct, m0 = 64 * mt;
#pragma unroll
            for (int i = 0; i < 8; ++i) { const int cc = 8 * i + (lane >> 3), mch = lane & 7; const u32x4 v = *(const u32x4*)(YT + (size_t)(c0 + cc) * MTOK + m0 + 8 * mch);
                LAS unsigned* d = (LAS unsigned*)(scr + cc * 66 + 8 * mch); d[0] = v.x; d[1] = v.y; d[2] = v.z; d[3] = v.w; }
            LDS_WAIT(); asm volatile("" ::: "memory");
#pragma unroll
            for (int i = 0; i < 8; ++i) { const int mm = 8 * i + (lane >> 3), cch = lane & 7; const LAS unsigned short* s = scr + (8 * cch) * 66 + mm;
                u32x4 o; o.x = (unsigned)s[0] | ((unsigned)s[66] << 16); o.y = (unsigned)s[2 * 66] | ((unsigned)s[3 * 66] << 16);
                o.z = (unsigned)s[4 * 66] | ((unsigned)s[5 * 66] << 16); o.w = (unsigned)s[6 * 66] | ((unsigned)s[7 * 66] << 16);
                *(u32x4*)(MIX + (size_t)(m0 + mm) * 1024 + c0 + 8 * cch) = o; }
            LDS_WAIT(); asm volatile("" ::: "memory"); }
        __syncthreads();
    }
    SEAM(3);
    if (IN(4)) {
        pg8::Gemm g{MIX, Wout_t, MTOK, DM, DM}; pg8::StaticOrder S; S.init(MTOK, DM, G, bx);
        float* ssb = (float*)(ws + WS_CTL + CTL_SS); unsigned* cntb = (unsigned*)(ws + WS_CTL + CTL_CNT);
        pg8::EpiNormResNorm E{x, MO, XN, a.in[2], a.in[21], ssb, ssb + MTOK, cntb, cntb + 128, NORM_EPS};
        pg8::gemm_phase<pg8::EpiNormResNorm, pg8::StaticOrder, true, true>(lds, g, S, E);
    }
    SEAM(4);
#ifndef DUP_P6
#define DUP_P6 1
#endif
    if (IN(6)) for (int rep6 = 0; rep6 < DUP_P6; ++rep6) {
        pg8::Gemm g{XN, Wup_t, MTOK, DFF, DM}; pg8::StaticOrder S; S.init(MTOK, DFF, G, bx);
        pg8::EpiBf16<1> E{HB, DFF};
        pg8::gemm_phase<pg8::EpiBf16<1>, pg8::StaticOrder, true, true>(lds, g, S, E);
    }
    SEAM(6);
    if (IN(7)) {
        pg8::Gemm g{HB, Wdown_t, MTOK, DM, DFF}; pg8::StaticOrder S; S.init(MTOK, DM, G, bx);
        float* ssb = (float*)(ws + WS_CTL + CTL_SS); unsigned* cntb = (unsigned*)(ws + WS_CTL + CTL_CNT);
        pg8::EpiNormRes E{MO, a.out, a.in[22], ssb + 2 * MTOK, cntb + 256, NORM_EPS};
        pg8::gemm_phase<pg8::EpiNormRes, pg8::StaticOrder, true, true>(lds, g, S, E);
    }
#undef IN
#undef SEAM
}

constexpr int NPHASE = 9;
extern "C" void kernel_launch(void* const* d_in, const int* in_sizes, int n_in, void* d_out, int out_size, void* d_ws, size_t ws_size, hipStream_t stream) {
    static int grid = 0;
    if (grid == 0) {
        if (n_in != 25 || in_sizes[0] != MTOK * DM || out_size != MTOK * DM || ws_size < WS_END) {
            fprintf(stderr, "kernel_launch: unexpected shapes (n_in %d in0 %d out %d ws %zu)\n", n_in, n_in > 0 ? in_sizes[0] : -1, out_size, ws_size); grid = -1; return; }
        int dev = 0, cus = 0, per_cu = 0;
        hipGetDevice(&dev); hipDeviceGetAttribute(&cus, hipDeviceAttributeMultiprocessorCount, dev);
        hipFuncSetAttribute((const void*)fwd_kernel, hipFuncAttributeMaxDynamicSharedMemorySize, LDS_BYTES);
        hipOccupancyMaxActiveBlocksPerMultiprocessor(&per_cu, (const void*)fwd_kernel, NTHR, LDS_BYTES);
        if (per_cu < 1) { fprintf(stderr, "kernel_launch: occupancy query says %d blocks/CU\n", per_cu); per_cu = 1; }
        (void)hipGetLastError();
        grid = cus >= 256 ? 256 : cus;
    }
    if (grid < 0) return;
    Args a{};
    for (int i = 0; i < 25; ++i) a.in[i] = (const float*)d_in[i];
    a.out = (float*)d_out; a.ws = (unsigned char*)d_ws;
#if MK_COOP
    a.ph_lo = 0; a.ph_hi = NPHASE;
    if (hipMemsetAsync((unsigned char*)d_ws + WS_CTL, 0, CTL_BYTES, stream) != hipSuccess) { fprintf(stderr, "kernel_launch: memset of the barrier words failed\n"); return; }
    void* args[] = {&a};
    hipError_t e = hipLaunchCooperativeKernel((const void*)fwd_kernel, dim3(grid), dim3(NTHR), args, LDS_BYTES, stream);
    if (e != hipSuccess) fprintf(stderr, "cooperative launch failed: %s (grid %d)\n", hipGetErrorString(e), grid);
#else
    for (int p = 0; p < NPHASE; ++p) { a.ph_lo = p; a.ph_hi = p + 1; hipLaunchKernelGGL(fwd_kernel, dim3(grid), dim3(NTHR), LDS_BYTES, stream, a); }
#endif
}
```

```cpp
#include <hip/hip_runtime.h>
#include <hip/hip_cooperative_groups.h>
#include <cstdio>
#include <cstdint>
#include <cmath>
namespace cg = cooperative_groups;
#ifndef MK_COOP
#define MK_COOP 1
#endif
namespace pg8 {
#define PG8_LAS __attribute__((address_space(3)))
typedef unsigned short bf16_t;
typedef short bf16x8 __attribute__((ext_vector_type(8)));
typedef float f32x4 __attribute__((ext_vector_type(4)));
typedef unsigned u32x4 __attribute__((ext_vector_type(4)));
constexpr int BM = 256, BK = 64, HALF = 128, HTB = HALF * BK * 2  , STAGE_BYTES = 8 * HTB, NXCD = 8, WGM = 8;

__host__ __device__ __forceinline__ int lds_byte(int r, int c) { const int st = (r >> 4) * 2 + (c >> 5), rr = r & 15, cc = c & 31, ob = rr * 64 + cc * 2; return st * 1024 + (ob ^ (((ob >> 9) & 1) << 5)); }
__host__ __device__ __forceinline__ void stage_rc(int b, int& R, int& C) { const int st = b / 1024, sb = b % 1024, swz = sb ^ (((sb >> 9) & 1) << 5); R = (st >> 1) * 16 + swz / 64; C = (st & 1) * 32 + (swz % 64) / 2; }
__host__ __device__ __forceinline__ int perm32(int rho) { const int n = rho >> 4, i = rho & 15; return 8 * (i >> 2) + 4 * n + (i & 3); }

struct Unit { int pm, pn; };
struct Gemm { const bf16_t* A; const bf16_t* Bt; int M, N, K; };

struct StaticOrder {
    int nM, nN, nwg, G, c;
    __host__ __device__ void init(int M, int N, int G_, int c_) { nM = M / BM; nN = N / BM; nwg = nM * nN; G = G_; c = c_; }
    __host__ __device__ bool next(int i, Unit& u) const {
        const long L = (long)i * G + c; if (L >= nwg) return false;
        int wgid = (int)L; { const int q = nwg / NXCD, r = nwg % NXCD, xcd = wgid % NXCD, off = wgid / NXCD; wgid = (xcd < r ? xcd * (q + 1) : r * (q + 1) + (xcd - r) * q) + off; }
        const int nig = WGM * nN, gid = wgid / nig, fm = gid * WGM, gsz = (nM - fm) < WGM ? (nM - fm) : WGM;
        u.pm = fm + ((wgid % nig) % gsz); u.pn = (wgid % nig) / gsz; return true;
    }
    __device__ __forceinline__ void a_ready(const Unit&) const {}
    __device__ __forceinline__ void done(const Unit&) const {}
};

__device__ __forceinline__ unsigned cvt_pk_bf16(float lo, float hi) { unsigned r; asm volatile("v_cvt_pk_bf16_f32 %0, %1, %2" : "=v"(r) : "v"(lo), "v"(hi)); return r; }
typedef float f32x2 __attribute__((ext_vector_type(2)));
typedef float f32x2 __attribute__((ext_vector_type(2)));
typedef unsigned u32x2 __attribute__((ext_vector_type(2)));
template <int ACT> struct EpiBf16 {
    static constexpr bool PERM = true, AFTER_DRAIN = false;
    bf16_t* O; int ldc;
    __device__ __forceinline__ void operator()(const f32x4 (&acc)[2][2][4][2], const Unit& u, int wr, int wc, int fr, int fq) const {
        const int row0 = u.pm * BM + wr * 64 + fr; const int col0 = u.pn * BM + wc * 32 + 8 * fq;
#pragma unroll
        for (int ai = 0; ai < 2; ++ai)
#pragma unroll
            for (int m = 0; m < 4; ++m) { bf16_t* rowp = O + (size_t)(row0 + ai * HALF + m * 16) * ldc + col0;
#pragma unroll
                for (int bj = 0; bj < 2; ++bj) { f32x4 v0 = acc[ai][bj][m][0], v1 = acc[ai][bj][m][1];
                    if (ACT == 1) {
#pragma unroll
                        for (int j = 0; j < 4; ++j) { float a = v0[j] > 0.f ? v0[j] : 0.f; v0[j] = a * a; float b = v1[j] > 0.f ? v1[j] : 0.f; v1[j] = b * b; } }
                    u32x4 w; w.x = cvt_pk_bf16(v0[0], v0[1]); w.y = cvt_pk_bf16(v0[2], v0[3]); w.z = cvt_pk_bf16(v1[0], v1[1]); w.w = cvt_pk_bf16(v1[2], v1[3]);
                    *(u32x4*)(rowp + bj * HALF) = w; } }
    }
};
struct EpiRope {
    static constexpr bool PERM = true, AFTER_DRAIN = false;
    bf16_t* Q; bf16_t* KT; const float* rope; float qscale;
    __device__ __forceinline__ void operator()(const f32x4 (&acc)[2][2][4][2], const Unit& u, int wr, int wc, int fr, int fq) const {
        const int row0 = u.pm * BM + wr * 64 + fr; const int col0 = u.pn * BM + wc * 32 + 8 * fq;
        const int g = (wc & 1) * 4 + fq;
        const float sc = (u.pn < 2) ? qscale : 1.0f;
#pragma unroll
        for (int ai = 0; ai < 2; ++ai)
#pragma unroll
            for (int m = 0; m < 4; ++m) { const int row = row0 + ai * HALF + m * 16; const int pos = row & 4095;
                const f32x4 cs0 = *(const f32x4*)(rope + (size_t)pos * 64 + 8 * g), cs1 = *(const f32x4*)(rope + (size_t)pos * 64 + 8 * g + 4);
                const float c[4] = {cs0[0], cs0[2], cs1[0], cs1[2]}, s[4] = {cs0[1], cs0[3], cs1[1], cs1[3]};
                bf16_t* rowp;
                if (u.pn < 2) rowp = Q + (size_t)row * 512 + col0;
                else { const int ck = col0 - 512, hh = ck >> 7, cc = ck & 127; rowp = KT + ((size_t)(((row >> 12) * 4 + hh) * 64 + (pos >> 6)) * 8192 + (pos & 63) * 128 + cc); }
#pragma unroll
                for (int bj = 0; bj < 2; ++bj) { const f32x4 lo = acc[ai][bj][m][0], hi = acc[ai][bj][m][1]; float ol[4], oh[4];
#pragma unroll
                    for (int j = 0; j < 4; ++j) { ol[j] = (lo[j] * c[j] - hi[j] * s[j]) * sc; oh[j] = (hi[j] * c[j] + lo[j] * s[j]) * sc; }
                    u32x4 w; w.x = cvt_pk_bf16(ol[0], ol[1]); w.y = cvt_pk_bf16(ol[2], ol[3]); w.z = cvt_pk_bf16(oh[0], oh[1]); w.w = cvt_pk_bf16(oh[2], oh[3]);
                    *(u32x4*)(rowp + ((u.pn < 2) ? bj * HALF : bj * (64 * 8192))) = w; } }
    }
};
struct EpiUV {
    static constexpr bool PERM = true, AFTER_DRAIN = false;
    bf16_t* UT; bf16_t* VT;
    __device__ __forceinline__ void operator()(const f32x4 (&acc)[2][2][4][2], const Unit& u, int wr, int wc, int fr, int fq) const {
        const int row0 = u.pm * BM + wr * 64 + fr; const int col0 = u.pn * BM + wc * 32 + 8 * fq;
#pragma unroll
        for (int ai = 0; ai < 2; ++ai)
#pragma unroll
            for (int m = 0; m < 4; ++m) { const int row = row0 + ai * HALF + m * 16;
#pragma unroll
                for (int bj = 0; bj < 2; ++bj) { const int col = col0 + bj * HALF; bf16_t* p;
                    if (u.pm < 6) p = UT + (size_t)row * 32768 + col;
                    else { const int ev = row - 1536, hh = ev >> 7, ee = ev & 127, bb = col >> 12, pos = col & 4095;
                        p = VT + ((size_t)((bb * 4 + hh) * 64 + (pos >> 6)) * 8192 + ee * 64 + (pos & 48) + ((pos & 8) >> 1)); }
                    const f32x4 v0 = acc[ai][bj][m][0], v1 = acc[ai][bj][m][1];
                    u32x4 w; w.x = cvt_pk_bf16(v0[0], v0[1]); w.y = cvt_pk_bf16(v0[2], v0[3]); w.z = cvt_pk_bf16(v1[0], v1[1]); w.w = cvt_pk_bf16(v1[2], v1[3]);
                    if (u.pm < 6) *(u32x4*)p = w;
                    else { *(u32x2*)p = (u32x2){w.x, w.y}; *(u32x2*)(p + 8) = (u32x2){w.z, w.w}; } } }
    }
};

__device__ __forceinline__ void panel_sumsq(const f32x4 (&acc)[2][2][4][2], float* ss, unsigned* cnt, const Unit& u, int wr, int fr, int fq, int lane) {
#pragma unroll
    for (int ai = 0; ai < 2; ++ai)
#pragma unroll
        for (int m = 0; m < 4; ++m) { float s = 0.f;
#pragma unroll
            for (int bj = 0; bj < 2; ++bj)
#pragma unroll
                for (int n = 0; n < 2; ++n) { const f32x4 x = acc[ai][bj][m][n]; s += (x[0] * x[0] + x[1] * x[1]) + (x[2] * x[2] + x[3] * x[3]); }
            s += __shfl_xor(s, 16); s += __shfl_xor(s, 32);
            if (fq == 0) __hip_atomic_fetch_add(ss + u.pm * BM + ai * HALF + wr * 64 + m * 16 + fr, s, __ATOMIC_RELAXED, __HIP_MEMORY_SCOPE_AGENT); }
    asm volatile("s_waitcnt vmcnt(0)" ::: "memory");
    __syncthreads();
    if (threadIdx.x == 0) { __hip_atomic_fetch_add(cnt + u.pm, 1u, __ATOMIC_RELAXED, __HIP_MEMORY_SCOPE_AGENT);
        unsigned spins = 0;
        while (__hip_atomic_load(cnt + u.pm, __ATOMIC_RELAXED, __HIP_MEMORY_SCOPE_AGENT) < 4u) { __builtin_amdgcn_s_sleep(8); if (++spins > (1u << 20)) break; } }
    __syncthreads();
}
struct EpiNormRes {
    static constexpr bool PERM = true, AFTER_DRAIN = false;
    const bf16_t* x1b; float* out; const float* gain; float* ss; unsigned* cnt; float eps;
    __device__ __forceinline__ void operator()(f32x4 (&acc)[2][2][4][2], const Unit& u, int wr, int wc, int fr, int fq) const {
        const int lane = fq * 16 + fr;
        panel_sumsq(acc, ss, cnt, u, wr, fr, fq, lane);
        const int row0 = u.pm * BM + wr * 64 + fr; const int col0 = u.pn * BM + wc * 32 + 8 * fq;
        f32x4 g[2][2];
#pragma unroll
        for (int bj = 0; bj < 2; ++bj) { g[bj][0] = *(const f32x4*)(gain + col0 + bj * HALF); g[bj][1] = *(const f32x4*)(gain + col0 + bj * HALF + 4); }
#pragma unroll
        for (int ai = 0; ai < 2; ++ai)
#pragma unroll
            for (int m = 0; m < 4; ++m) { const int row = row0 + ai * HALF + m * 16;
                const float r = 1.0f / sqrtf(__hip_atomic_load(ss + row, __ATOMIC_RELAXED, __HIP_MEMORY_SCOPE_AGENT) * (1.0f / 1024.0f) + eps);
                float* rowp = out + (size_t)row * 1024 + col0; const bf16_t* xp = x1b + (size_t)row * 1024 + col0;
#pragma unroll
                for (int bj = 0; bj < 2; ++bj) { const u32x4 xb = *(const u32x4*)(xp + bj * HALF);
                    const f32x4 b0 = (f32x4){__builtin_bit_cast(float, xb.x << 16), __builtin_bit_cast(float, xb.x & 0xffff0000u), __builtin_bit_cast(float, xb.y << 16), __builtin_bit_cast(float, xb.y & 0xffff0000u)};
                    const f32x4 b1 = (f32x4){__builtin_bit_cast(float, xb.z << 16), __builtin_bit_cast(float, xb.z & 0xffff0000u), __builtin_bit_cast(float, xb.w << 16), __builtin_bit_cast(float, xb.w & 0xffff0000u)};
                    *(f32x4*)(rowp + bj * HALF) = b0 + acc[ai][bj][m][0] * r * g[bj][0]; *(f32x4*)(rowp + bj * HALF + 4) = b1 + acc[ai][bj][m][1] * r * g[bj][1]; } }
    }
};
struct EpiNormResNorm {
    static constexpr bool PERM = true, AFTER_DRAIN = false;
    const float* base; bf16_t* x1b; bf16_t* xn; const float* g1; const float* g2; float* ss1; float* ss2; unsigned* cnt1; unsigned* cnt2; float eps;
    __device__ __forceinline__ void operator()(f32x4 (&acc)[2][2][4][2], const Unit& u, int wr, int wc, int fr, int fq) const {
        const int lane = fq * 16 + fr;
        panel_sumsq(acc, ss1, cnt1, u, wr, fr, fq, lane);
        const int row0 = u.pm * BM + wr * 64 + fr; const int col0 = u.pn * BM + wc * 32 + 8 * fq;
        { f32x4 g[2][2];
#pragma unroll
          for (int bj = 0; bj < 2; ++bj) { g[bj][0] = *(const f32x4*)(g1 + col0 + bj * HALF); g[bj][1] = *(const f32x4*)(g1 + col0 + bj * HALF + 4); }
#pragma unroll
          for (int ai = 0; ai < 2; ++ai)
#pragma unroll
            for (int m = 0; m < 4; ++m) { const int row = row0 + ai * HALF + m * 16;
                const float r = 1.0f / sqrtf(__hip_atomic_load(ss1 + row, __ATOMIC_RELAXED, __HIP_MEMORY_SCOPE_AGENT) * (1.0f / 1024.0f) + eps);
                const float* bp = base + (size_t)row * 1024 + col0; bf16_t* rowp = x1b + (size_t)row * 1024 + col0;
#pragma unroll
                for (int bj = 0; bj < 2; ++bj) { const f32x4 b0 = *(const f32x4*)(bp + bj * HALF), b1 = *(const f32x4*)(bp + bj * HALF + 4);
                    const f32x4 x0 = b0 + acc[ai][bj][m][0] * r * g[bj][0], x1 = b1 + acc[ai][bj][m][1] * r * g[bj][1];
                    acc[ai][bj][m][0] = x0; acc[ai][bj][m][1] = x1;
                    u32x4 w; w.x = cvt_pk_bf16(x0[0], x0[1]); w.y = cvt_pk_bf16(x0[2], x0[3]); w.z = cvt_pk_bf16(x1[0], x1[1]); w.w = cvt_pk_bf16(x1[2], x1[3]);
                    *(u32x4*)(rowp + bj * HALF) = w; } } }
        panel_sumsq(acc, ss2, cnt2, u, wr, fr, fq, lane);
        { f32x4 g[2][2];
#pragma unroll
          for (int bj = 0; bj < 2; ++bj) { g[bj][0] = *(const f32x4*)(g2 + col0 + bj * HALF); g[bj][1] = *(const f32x4*)(g2 + col0 + bj * HALF + 4); }
#pragma unroll
          for (int ai = 0; ai < 2; ++ai)
#pragma unroll
            for (int m = 0; m < 4; ++m) { const int row = row0 + ai * HALF + m * 16;
                const float r = 1.0f / sqrtf(__hip_atomic_load(ss2 + row, __ATOMIC_RELAXED, __HIP_MEMORY_SCOPE_AGENT) * (1.0f / 1024.0f) + eps);
                bf16_t* xp = xn + (size_t)row * 1024 + col0;
#pragma unroll
                for (int bj = 0; bj < 2; ++bj) { const f32x4 v0 = acc[ai][bj][m][0] * r * g[bj][0], v1 = acc[ai][bj][m][1] * r * g[bj][1];
                    u32x4 w; w.x = cvt_pk_bf16(v0[0], v0[1]); w.y = cvt_pk_bf16(v0[2], v0[3]); w.z = cvt_pk_bf16(v1[0], v1[1]); w.w = cvt_pk_bf16(v1[2], v1[3]);
                    *(u32x4*)(xp + bj * HALF) = w; } } }
    }
};
template <class Epi, class Sched, bool ALIGN_EPI = false, bool SP2 = false>
__device__ __forceinline__ void gemm_phase(PG8_LAS unsigned char* lds, const Gemm g, const Sched& S, const Epi& E) {
    const int tid = threadIdx.x, wid = __builtin_amdgcn_readfirstlane(tid >> 6), lane = tid & 63, wr = wid >> 2, wc = wid & 3, fr = lane & 15, fq = lane >> 4;
    const int K = g.K, nt = K / BK;
    unsigned voffA[2], voffB[2];
#pragma unroll
    for (int i = 0; i < 2; ++i) { int R, C; stage_rc(tid * 16 + i * 8192, R, C); const int Rb = Epi::PERM ? ((R & ~31) + perm32(R & 31)) : R;
        voffA[i] = (unsigned)(R * K + C) * 2u; voffB[i] = (unsigned)(Rb * K + C) * 2u; }
    const size_t kstep = (size_t)(BK * 2);
    const size_t hstep = (size_t)HALF * K * 2;
    const size_t tstep = 2 * hstep;
    const unsigned ldsw = (unsigned)wid * 1024u;
    const int aoff = lds_byte(wr * 64 + fr, fq * 8), boff = lds_byte(wc * 32 + fr, fq * 8);
#define PG8_SA(b, h) (((b) * 2 + (h)) * HTB)
#define PG8_SB(b, h) ((4 + (b) * 2 + (h)) * HTB)
#define PG8_STAGE(bufoff, gbase, voff) do { _Pragma("unroll") for (int _i = 0; _i < 2; ++_i) \
        __builtin_amdgcn_global_load_lds((const unsigned*)((const char*)(gbase) + (voff)[_i]), (PG8_LAS unsigned*)(lds + (bufoff) + ldsw + _i * 8192), 16, 0, 0); } while (0)
#define PG8_LDA(dst, b, h) do { _Pragma("unroll") for (int m = 0; m < 4; ++m) _Pragma("unroll") for (int k = 0; k < 2; ++k) dst[m][k] = *(const PG8_LAS bf16x8*)(lds + PG8_SA(b, h) + aoff + m * 2048 + k * 1024); } while (0)
#define PG8_LDB(dst, b, h) do { _Pragma("unroll") for (int n = 0; n < 2; ++n) _Pragma("unroll") for (int k = 0; k < 2; ++k) dst[n][k] = *(const PG8_LAS bf16x8*)(lds + PG8_SB(b, h) + boff + n * 2048 + k * 1024); } while (0)
#define PG8_MMA(ai, bj, At, Bt) do { __builtin_amdgcn_s_setprio(1); _Pragma("unroll") for (int m = 0; m < 4; ++m) _Pragma("unroll") for (int n = 0; n < 2; ++n) _Pragma("unroll") for (int k = 0; k < 2; ++k) \
        acc[ai][bj][m][n] = __builtin_amdgcn_mfma_f32_16x16x32_bf16(Bt[n][k], At[m][k], acc[ai][bj][m][n], 0, 0, 0); __builtin_amdgcn_s_setprio(0); } while (0)
#define PG8_WAIT_V(n) asm volatile("s_waitcnt vmcnt(" #n ")" ::: "memory")
#define PG8_WAIT_L(n) asm volatile("s_waitcnt lgkmcnt(" #n ")" ::: "memory")
#define PG8_BAR __builtin_amdgcn_s_barrier()
#define PG8_SCHED __builtin_amdgcn_sched_barrier(0)
    Unit cur, nxt; int ui = 0;
    if (!S.next(0, cur)) return;
    f32x4 acc[2][2][4][2];
#pragma unroll
    for (int a = 0; a < 2; ++a)
#pragma unroll
        for (int b = 0; b < 2; ++b)
#pragma unroll
            for (int m = 0; m < 4; ++m)
#pragma unroll
                for (int n = 0; n < 2; ++n) acc[a][b][m][n] = (f32x4){0.f, 0.f, 0.f, 0.f};
    bf16x8 At[4][2], B0[2][2], B1[2][2];
    const char* cA = (const char*)g.A + (size_t)cur.pm * tstep; const char* cB = (const char*)g.Bt + (size_t)cur.pn * tstep;
    S.a_ready(cur);
    if constexpr (SP2) {
        PG8_STAGE(PG8_SB(0, 0), cB, voffB); PG8_STAGE(PG8_SB(0, 1), cB + hstep, voffB); PG8_STAGE(PG8_SA(0, 0), cA, voffA); PG8_STAGE(PG8_SA(0, 1), cA + hstep, voffA);
        if (wr == 1) PG8_BAR;
        PG8_WAIT_V(2); PG8_BAR;
        PG8_STAGE(PG8_SB(1, 0), cB + kstep, voffB); PG8_STAGE(PG8_SA(1, 0), cA + kstep, voffA); PG8_STAGE(PG8_SB(1, 1), cB + hstep + kstep, voffB);
        PG8_WAIT_V(6); PG8_BAR;
    } else {
        PG8_STAGE(PG8_SB(0, 0), cB, voffB); PG8_STAGE(PG8_SA(0, 0), cA, voffA); PG8_STAGE(PG8_SB(0, 1), cB + hstep, voffB); PG8_STAGE(PG8_SA(0, 1), cA + hstep, voffA);
        if (wr == 1) PG8_BAR;
        PG8_WAIT_V(4); PG8_BAR;
        PG8_STAGE(PG8_SB(1, 0), cB + kstep, voffB); PG8_STAGE(PG8_SA(1, 0), cA + kstep, voffA); PG8_STAGE(PG8_SB(1, 1), cB + hstep + kstep, voffB);
        PG8_WAIT_V(6); PG8_BAR;
    }
    for (;;) {
        const bool has_next = S.next(ui + 1, nxt);
        const char* nA = has_next ? (const char*)g.A + (size_t)nxt.pm * tstep : cA; const char* nB = has_next ? (const char*)g.Bt + (size_t)nxt.pn * tstep : cB;
        for (int t = 0; t < nt; t += 2) {
            const bool last = (t == nt - 2);
            const char* a1 = cA + (size_t)(t + 1) * kstep;
            const char* a2 = last ? nA : cA + (size_t)(t + 2) * kstep; const char* b2 = last ? nB : cB + (size_t)(t + 2) * kstep;
            const char* a3 = a2 + kstep; const char* b3 = b2 + kstep;
            if (last && has_next) S.a_ready(nxt);
            if constexpr (SP2) {
            PG8_LDB(B0, 0, 0); PG8_LDB(B1, 0, 1); PG8_SCHED; PG8_LDA(At, 0, 0); PG8_STAGE(PG8_SA(1, 1), a1 + hstep, voffA);
            PG8_WAIT_V(8); PG8_WAIT_L(0); PG8_BAR; PG8_MMA(0, 0, At, B0); PG8_MMA(0, 1, At, B1); PG8_BAR; PG8_SCHED;
            PG8_LDA(At, 0, 1); PG8_STAGE(PG8_SB(0, 0), b2, voffB); PG8_STAGE(PG8_SB(0, 1), b2 + hstep, voffB); PG8_STAGE(PG8_SA(0, 0), a2, voffA);
            PG8_WAIT_V(8); PG8_WAIT_L(0); PG8_BAR; PG8_MMA(1, 0, At, B0); PG8_MMA(1, 1, At, B1); PG8_BAR; PG8_SCHED;
            PG8_LDB(B0, 1, 0); PG8_LDB(B1, 1, 1); PG8_SCHED; PG8_LDA(At, 1, 0); PG8_STAGE(PG8_SA(0, 1), a2 + hstep, voffA);
            PG8_WAIT_V(8); PG8_WAIT_L(0); PG8_BAR; PG8_MMA(0, 0, At, B0); PG8_MMA(0, 1, At, B1); PG8_BAR; PG8_SCHED;
            PG8_LDA(At, 1, 1); PG8_STAGE(PG8_SB(1, 0), b3, voffB); PG8_STAGE(PG8_SB(1, 1), b3 + hstep, voffB); PG8_STAGE(PG8_SA(1, 0), a3, voffA);
            PG8_WAIT_V(8); PG8_WAIT_L(0); PG8_BAR; PG8_MMA(1, 0, At, B0); PG8_MMA(1, 1, At, B1); PG8_BAR; PG8_SCHED;
            } else {
            PG8_LDB(B0, 0, 0); PG8_SCHED; PG8_LDA(At, 0, 0); PG8_STAGE(PG8_SA(1, 1), a1 + hstep, voffA);
            PG8_WAIT_L(8); PG8_BAR; PG8_WAIT_L(0); PG8_MMA(0, 0, At, B0); PG8_BAR; PG8_SCHED;
            PG8_LDB(B1, 0, 1); PG8_STAGE(PG8_SB(0, 0), b2, voffB);
            PG8_BAR; PG8_WAIT_L(0); PG8_MMA(0, 1, At, B1); PG8_BAR;
            PG8_LDA(At, 0, 1); PG8_STAGE(PG8_SA(0, 0), a2, voffA);
            PG8_BAR; PG8_WAIT_L(0); PG8_MMA(1, 0, At, B0); PG8_BAR; PG8_SCHED;
            PG8_STAGE(PG8_SB(0, 1), b2 + hstep, voffB);
            PG8_WAIT_V(6); PG8_BAR; PG8_MMA(1, 1, At, B1); PG8_BAR;
            PG8_LDB(B0, 1, 0); PG8_SCHED; PG8_LDA(At, 1, 0); PG8_STAGE(PG8_SA(0, 1), a2 + hstep, voffA);
            PG8_WAIT_L(8); PG8_BAR; PG8_WAIT_L(0); PG8_MMA(0, 0, At, B0); PG8_BAR; PG8_SCHED;
            PG8_LDB(B1, 1, 1); PG8_STAGE(PG8_SB(1, 0), b3, voffB);
            PG8_BAR; PG8_WAIT_L(0); PG8_MMA(0, 1, At, B1); PG8_BAR;
            PG8_LDA(At, 1, 1); PG8_STAGE(PG8_SA(1, 0), a3, voffA);
            PG8_BAR; PG8_WAIT_L(0); PG8_MMA(1, 0, At, B0); PG8_BAR; PG8_SCHED;
            PG8_STAGE(PG8_SB(1, 1), b3 + hstep, voffB);
            PG8_WAIT_V(6); PG8_BAR; PG8_MMA(1, 1, At, B1); PG8_BAR;
            }
        }
        if constexpr (ALIGN_EPI) { if (wr == 0) PG8_BAR; }
        if constexpr (!Epi::AFTER_DRAIN) { E(acc, cur, wr, wc, fr, fq); S.done(cur); }
        if (!has_next) break;
#pragma unroll
        for (int a = 0; a < 2; ++a)
#pragma unroll
            for (int b = 0; b < 2; ++b)
#pragma unroll
                for (int m = 0; m < 4; ++m)
#pragma unroll
                    for (int n = 0; n < 2; ++n) acc[a][b][m][n] = (f32x4){0.f, 0.f, 0.f, 0.f};
        cur = nxt; cA = nA; cB = nB; ++ui;
        if constexpr (ALIGN_EPI) { if (wr == 1) PG8_BAR; }
    }
    PG8_WAIT_V(0);
    if constexpr (!ALIGN_EPI) { if (wr == 0) PG8_BAR; }
    PG8_BAR;
    if constexpr (Epi::AFTER_DRAIN) { E.fused(acc, cur, wr, wc, fr, fq, lds, wid, lane); S.done(cur); }
#undef PG8_SA
#undef PG8_SB
#undef PG8_STAGE
#undef PG8_LDA
#undef PG8_LDB
#undef PG8_MMA
#undef PG8_WAIT_V
#undef PG8_WAIT_L
#undef PG8_BAR
#undef PG8_SCHED
}
}

constexpr int BATCH = 8, SEQ = 4096, DM = 1024, MTOK = BATCH * SEQ, HYW = 512, NIN = 3072, DFF = 4096;
constexpr int NWAVES = 8, NTHR = 512;
constexpr float NORM_EPS = 1e-6f, SUBLN_EPS = 1e-5f;
constexpr float QSCALE = 0.125f * 1.4426950408889634f;
constexpr int HRLEN = 8224;
constexpr size_t MiB = 1u << 20;
constexpr size_t WS_WIN = 0, WS_WOUT = 6 * MiB, WS_WUP = 8 * MiB, WS_WDOWN = 16 * MiB;
constexpr size_t WS_HR = 24 * MiB;
constexpr size_t WS_ROPE = 33 * MiB;
constexpr size_t WS_CTL = 34 * MiB, CTL_BYTES = 16384 + 3 * 131072;
constexpr size_t CTL_CNT = 14336, CTL_SS = 16384;
constexpr size_t WS_XN = 40 * MiB;
constexpr size_t WS_MO = 104 * MiB;
constexpr size_t WS_YT = 168 * MiB;
constexpr size_t WS_UVT = 200 * MiB;
constexpr size_t WS_QK = 328 * MiB;
constexpr size_t WS_KT = 360 * MiB;
constexpr size_t WS_VT = 296 * MiB;
constexpr size_t WS_MIX = 392 * MiB;
constexpr size_t WS_H = 200 * MiB;
constexpr size_t WS_END = 456 * MiB;
constexpr int LDS_BYTES = 135168;

#define LAS __attribute__((address_space(3)))
typedef unsigned short bf16;
typedef unsigned u32x4 __attribute__((ext_vector_type(4)));
typedef unsigned u32x2 __attribute__((ext_vector_type(2)));
typedef float f32x4 __attribute__((ext_vector_type(4)));
typedef float f32x16 __attribute__((ext_vector_type(16)));
typedef short bf16x8 __attribute__((ext_vector_type(8)));
typedef short s16x4 __attribute__((ext_vector_type(4)));

__device__ __forceinline__ unsigned f2bf(float f) { unsigned u = __builtin_bit_cast(unsigned, f); return (u + 0x7fffu + ((u >> 16) & 1u)) >> 16; }
__device__ __forceinline__ unsigned pk2(float lo, float hi) { return f2bf(lo) | (f2bf(hi) << 16); }
typedef float f32x2_t __attribute__((ext_vector_type(2))); typedef __bf16 bf16x2_t __attribute__((ext_vector_type(2)));
__device__ __forceinline__ unsigned cvtpk(float lo, float hi) { f32x2_t v = {lo, hi}; bf16x2_t b = __builtin_convertvector(v, bf16x2_t); return __builtin_bit_cast(unsigned, b); }
__device__ __forceinline__ float bf2f(unsigned short b) { return __builtin_bit_cast(float, (unsigned)b << 16); }
__device__ __forceinline__ float bflo(unsigned w) { return __builtin_bit_cast(float, w << 16); }
__device__ __forceinline__ float bfhi(unsigned w) { return __builtin_bit_cast(float, w & 0xffff0000u); }
__device__ __forceinline__ float wave_sum(float v) {
#pragma unroll
    for (int o = 1; o < 64; o <<= 1) v += __shfl_xor(v, o);
    return v;
}
__device__ __forceinline__ float swap_hi(float v) { return __shfl_xor(v, 32); }
#define LDS_WAIT() asm volatile("s_waitcnt lgkmcnt(0)" ::: "memory")

struct Args { const float* in[25]; float* out; unsigned char* ws; int ph_lo, ph_hi; };

__device__ __forceinline__ int win_src(int n) {
    if (n < 1536) return n;
    if (n < 2048) return n + 1024;
    const int pp = n - 2048, grp = pp >> 6, p = pp & 63, g = p >> 3, e = p & 7;
    const int d = (e < 4) ? (4 * g + e) : (32 + 4 * g + (e - 4));
    return 1536 + grp * 64 + d;
}
template <bool PERMW>
__device__ __forceinline__ void p0_transpose_item(const float* W, int K, int N, bf16* WT, LAS float* scr, int item, int lane) {
    const int nblk = N / 32, kb = item / nblk, nb = item % nblk, k0 = 64 * kb, n0 = 32 * nb;
    const int sc = PERMW ? win_src(n0 + (lane & 31)) : (n0 + (lane & 31));
#pragma unroll 8
    for (int i = 0; i < 32; ++i) { const int kk = 2 * i + (lane >> 5); scr[kk * 33 + (lane & 31)] = W[(size_t)(k0 + kk) * N + sc]; }
    LDS_WAIT(); asm volatile("" ::: "memory");
    const int c = lane & 7;
#pragma unroll
    for (int j = 0; j < 4; ++j) { const int n = (lane >> 3) + 8 * j; const LAS float* s = scr + (8 * c) * 33 + n;
        u32x4 o; o.x = pk2(s[0 * 33], s[1 * 33]); o.y = pk2(s[2 * 33], s[3 * 33]); o.z = pk2(s[4 * 33], s[5 * 33]); o.w = pk2(s[6 * 33], s[7 * 33]);
        *(u32x4*)(WT + (size_t)(n0 + n) * K + k0 + 8 * c) = o; }
    LDS_WAIT(); asm volatile("" ::: "memory");
}
__device__ __forceinline__ void rms_row_to_bf16(const float* xrow, const float* gain, bf16* orow, int lane) {
    const f32x4* xr = (const f32x4*)xrow + lane; const f32x4* gr = (const f32x4*)gain + lane;
    f32x4 v[4]; float s = 0.f;
#pragma unroll
    for (int j = 0; j < 4; ++j) { v[j] = xr[64 * j]; s += (v[j].x * v[j].x + v[j].y * v[j].y) + (v[j].z * v[j].z + v[j].w * v[j].w); }
    const float r = 1.0f / sqrtf(wave_sum(s) * (1.f / DM) + NORM_EPS);
    unsigned long long* o8 = (unsigned long long*)orow + lane;
#pragma unroll
    for (int j = 0; j < 4; ++j) { const f32x4 g = gr[64 * j];
        o8[64 * j] = (unsigned long long)pk2(v[j].x * r * g.x, v[j].y * r * g.y) | ((unsigned long long)pk2(v[j].z * r * g.z, v[j].w * r * g.w) << 32); }
}

__device__ __forceinline__ void filter_item(LAS unsigned char* lds, const Args& a, bf16* HR, int pg, int tid) {
    LAS float* Z = (LAS float*)lds;
    LAS float* HA = Z + 16 * 33;
    LAS float* HB = HA + 16 * 64;
    LAS float* W1 = HB + 16 * 64;
    LAS float* W2 = W1 + 33 * 64;
    LAS float* W3 = W2 + 64 * 64;
    const float* w1 = a.in[6]; const float* b1 = a.in[7]; const float* w2 = a.in[8]; const float* b2 = a.in[9];
    const float* w3 = a.in[10]; const float* b3 = a.in[11]; const float* w4 = a.in[12]; const float* freq = a.in[13]; const float* fbias = a.in[14];
    const int t0 = 16 * pg;
    for (int i = tid; i < 33 * 64; i += NTHR) W1[i] = w1[i];
    for (int i = tid; i < 64 * 64; i += NTHR) { W2[i] = w2[i]; W3[i] = w3[i]; }
    for (int i = tid; i < 16 * 33; i += NTHR) { const int p = i / 33, f = i % 33; const int pos = t0 + p; float val;
        if (f == 0) val = (float)pos * (1.0f / (float)(SEQ - 1));
        else { const int j = (f - 1) & 15; const float fj = 1e-4f + (float)j * ((15.0f - 1e-4f) / 15.0f); const float w = (6.283185307179586f / (float)SEQ) * (float)pos; const float arg = fj * w;
            val = (f <= 16) ? cosf(arg) : -sinf(arg); }
        Z[i] = val; }
    __syncthreads();
    for (int o = tid; o < 1024; o += NTHR) { const int p = o >> 6, n = o & 63; float acc = b1[n];
#pragma unroll 3
        for (int f = 0; f < 33; ++f) acc += Z[p * 33 + f] * W1[f * 64 + n];
        HA[o] = sinf(freq[n] * acc); }
    __syncthreads();
    for (int o = tid; o < 1024; o += NTHR) { const int p = o >> 6, n = o & 63; float acc = b2[n];
#pragma unroll 4
        for (int f = 0; f < 64; ++f) acc += HA[p * 64 + f] * W2[f * 64 + n];
        HB[o] = sinf(freq[n] * acc); }
    __syncthreads();
    for (int o = tid; o < 1024; o += NTHR) { const int p = o >> 6, n = o & 63; float acc = b3[n];
#pragma unroll 4
        for (int f = 0; f < 64; ++f) acc += HB[p * 64 + f] * W3[f * 64 + n];
        HA[o] = sinf(freq[n] * acc); }
    __syncthreads();
    {   const int c = tid;
        float af[16], ab[16];
#pragma unroll
        for (int p = 0; p < 16; ++p) { af[p] = 0.f; ab[p] = 0.f; }
        for (int k0 = 0; k0 < 64; k0 += 8) { float wf[8], wb[8];
#pragma unroll
            for (int kk = 0; kk < 8; ++kk) { wf[kk] = w4[(k0 + kk) * 1024 + c]; wb[kk] = w4[(k0 + kk) * 1024 + 512 + c]; }
#pragma unroll
            for (int kk = 0; kk < 8; ++kk)
#pragma unroll
                for (int p = 0; p < 16; ++p) { const float hv = HA[p * 64 + k0 + kk]; af[p] += hv * wf[kk]; ab[p] += hv * wb[kk]; } }
        const float min_decay = -4.605170185988091f / 1.5f, max_decay = -4.605170185988091f / 0.3f;
        const float adelta = fabsf(min_decay + (float)c * ((max_decay - min_decay) / 511.0f));
        bf16* hr = HR + (size_t)c * HRLEN;
#pragma unroll
        for (int p = 0; p < 16; ++p) { const int pos = t0 + p; const float tl = (float)pos * (1.0f / (float)(SEQ - 1)); const float dec = expf(-tl * adelta);
            const float vf = af[p] * dec, vb = ab[p] * dec;
            if (pos == 0) hr[4096] = (bf16)f2bf(vf + vb + fbias[c]);
            else { hr[4096 - pos] = (bf16)f2bf(vf); hr[4096 + pos] = (bf16)f2bf(vb); } }
        if (pg == 0) { hr[0] = 0; for (int i = 8192; i < HRLEN; ++i) hr[i] = 0; }
    }
    __syncthreads();
}

namespace att {
constexpr int KP = 272, VP = 144, KBUF = 64 * KP, VBUF = 128 * VP, VOFF = 2 * KBUF;
constexpr int NT = SEQ / 64;
__device__ __forceinline__ float max3(float a, float b, float c) { return fmaxf(fmaxf(a, b), c); }
__device__ __forceinline__ float fadd_s(float a, float b) { float r; asm("v_add_f32_e32 %0, %1, %2" : "=v"(r) : "v"(a), "v"(b)); return r; }
#define SBAR() __builtin_amdgcn_sched_barrier(0)
__device__ __forceinline__ void v_load(bf16x8 (&vf)[4], const LAS unsigned char* vb, int ks) {
#pragma unroll
    for (int e = 0; e < 4; ++e) vf[e] = *(const LAS bf16x8*)(vb + e * 32 * VP + ks * 32);
}
__device__ __forceinline__ void pv_tile(f32x16 (&o)[4], const u32x4 (&P)[4], bf16x8 (&vf0)[4], const LAS unsigned char* vb) {
    bf16x8 vf1[4];
#pragma unroll
    for (int ks = 0; ks < 4; ++ks) { const bf16x8 pb = __builtin_bit_cast(bf16x8, P[ks]);
        if (ks == 0 || ks == 2) v_load(vf1, vb, ks + 1); else if (ks == 1) v_load(vf0, vb, 2);
        SBAR(); __builtin_amdgcn_s_setprio(1);
#pragma unroll
        for (int e = 0; e < 4; ++e) o[e] = __builtin_amdgcn_mfma_f32_32x32x16_bf16((ks & 1) ? vf1[e] : vf0[e], pb, o[e], 0, 0, 0);
        __builtin_amdgcn_s_setprio(0); SBAR(); }
}
__device__ __forceinline__ float xhalf_max(float v) { auto rr = __builtin_amdgcn_permlane32_swap(__float_as_uint(v), __float_as_uint(v), false, false); return fmaxf(__uint_as_float(rr[0]), __uint_as_float(rr[1])); }
__device__ __forceinline__ float xhalf_sum(float v) { auto rr = __builtin_amdgcn_permlane32_swap(__float_as_uint(v), __float_as_uint(v), false, false); return __uint_as_float(rr[0]) + __uint_as_float(rr[1]); }
constexpr int QOFF = 2 * KBUF + 3 * VBUF;
#define ATT_SLOT(T, PKW, PVW, PKL, PVL) do { const int t = (T); \
        const LAS unsigned char* kst = lds + (t & 1) * KBUF; \
        bf16x8 vf0[4]; \
        if (c == 1 && t > 0 && VAR != 5) { v_load(vf0, lds + VOFF + vprev + voff, 0); pv_tile(o, P, vf0, lds + VOFF + vprev + voff); } \
        if (t + 2 < NT && VAR != 4) { _Pragma("unroll") for (int i = 0; i < 2; ++i) { PKL[i] = *(const u32x4*)(gk[i] + (size_t)(t + 2) * 8192); PVL[i] = *(const u32x4*)(gv[i] + (size_t)(t + 2) * 8192); } } \
        SBAR(); \
        f32x16 s0, s1; \
        { const LAS unsigned char* kb = kst + r32 * KP + c * 128 + hi * 16; const LAS unsigned char* qb_ = lds + QOFF + wid * 4096 + lane * 16; \
          bf16x8 ka[4], kc2[4], qa[2], qc[2]; \
          qa[0] = *(const LAS bf16x8*)(qb_); qa[1] = *(const LAS bf16x8*)(qb_ + 1024); \
          ka[0] = *(const LAS bf16x8*)(kb); ka[1] = *(const LAS bf16x8*)(kb + 32 * KP); ka[2] = *(const LAS bf16x8*)(kb + 32); ka[3] = *(const LAS bf16x8*)(kb + 32 * KP + 32); \
          SBAR(); \
          qc[0] = *(const LAS bf16x8*)(qb_ + 2048); qc[1] = *(const LAS bf16x8*)(qb_ + 3072); \
          kc2[0] = *(const LAS bf16x8*)(kb + 64); kc2[1] = *(const LAS bf16x8*)(kb + 32 * KP + 64); kc2[2] = *(const LAS bf16x8*)(kb + 96); kc2[3] = *(const LAS bf16x8*)(kb + 32 * KP + 96); \
          __builtin_amdgcn_s_setprio(1); s0 = __builtin_amdgcn_mfma_f32_32x32x16_bf16(ka[0], qa[0], zero16, 0, 0, 0); s1 = __builtin_amdgcn_mfma_f32_32x32x16_bf16(ka[1], qa[0], zero16, 0, 0, 0); \
          s0 = __builtin_amdgcn_mfma_f32_32x32x16_bf16(ka[2], qa[1], s0, 0, 0, 0); s1 = __builtin_amdgcn_mfma_f32_32x32x16_bf16(ka[3], qa[1], s1, 0, 0, 0); \
          SBAR(); \
          s0 = __builtin_amdgcn_mfma_f32_32x32x16_bf16(kc2[0], qc[0], s0, 0, 0, 0); s1 = __builtin_amdgcn_mfma_f32_32x32x16_bf16(kc2[1], qc[0], s1, 0, 0, 0); \
          s0 = __builtin_amdgcn_mfma_f32_32x32x16_bf16(kc2[2], qc[1], s0, 0, 0, 0); s1 = __builtin_amdgcn_mfma_f32_32x32x16_bf16(kc2[3], qc[1], s1, 0, 0, 0); __builtin_amdgcn_s_setprio(0); } \
        if (c == 0 && VAR != 5) v_load(vf0, lds + VOFF + vcur + voff, 0); \
        SBAR(); \
        if (VAR != 6) { float mx = max3(s0[0], s1[0], s0[1]); \
        mx = max3(mx, s1[1], s0[2]); mx = max3(mx, s1[2], s0[3]); mx = max3(mx, s1[3], s0[4]); mx = max3(mx, s1[4], s0[5]); \
        mx = max3(mx, s1[5], s0[6]); mx = max3(mx, s1[6], s0[7]); mx = max3(mx, s1[7], s0[8]); mx = max3(mx, s1[8], s0[9]); \
        mx = max3(mx, s1[9], s0[10]); mx = max3(mx, s1[10], s0[11]); mx = max3(mx, s1[11], s0[12]); mx = max3(mx, s1[12], s0[13]); \
        mx = max3(mx, s1[13], s0[14]); mx = max3(mx, s1[14], s0[15]); mx = fmaxf(mx, s1[15]); \
        mx = xhalf_max(mx); \
        if (t == 0) { if (__any(fabsf(mx) > 8.0f)) { mref = mx; gen = true; } } \
        else if (__any(mx > mref + 8.0f)) { const float mnew = fmaxf(mx, mref); const float al = __builtin_amdgcn_exp2f(mref - mnew); \
            _Pragma("unroll") for (int e = 0; e < 4; ++e) _Pragma("unroll") for (int r = 0; r < 16; ++r) o[e][r] *= al; \
            lsum *= al; mref = mnew; gen = true; } \
        float ps0 = 0.f, ps1 = 0.f; \
        if (gen) { _Pragma("unroll") for (int r = 0; r < 16; ++r) { s0[r] = __builtin_amdgcn_exp2f(s0[r] - mref); s1[r] = __builtin_amdgcn_exp2f(s1[r] - mref); ps0 += s0[r]; ps0 += s1[r]; } } \
        else { _Pragma("unroll") for (int r = 0; r < 16; ++r) { s0[r] = __builtin_amdgcn_exp2f(s0[r]); s1[r] = __builtin_amdgcn_exp2f(s1[r]); ps0 += s0[r]; ps0 += s1[r]; } } \
        lsum += ps0 + ps1; } \
        P[0] = (u32x4){cvtpk(s0[0], s0[1]), cvtpk(s0[2], s0[3]), cvtpk(s0[4], s0[5]), cvtpk(s0[6], s0[7])}; \
        P[1] = (u32x4){cvtpk(s0[8], s0[9]), cvtpk(s0[10], s0[11]), cvtpk(s0[12], s0[13]), cvtpk(s0[14], s0[15])}; \
        P[2] = (u32x4){cvtpk(s1[0], s1[1]), cvtpk(s1[2], s1[3]), cvtpk(s1[4], s1[5]), cvtpk(s1[6], s1[7])}; \
        P[3] = (u32x4){cvtpk(s1[8], s1[9]), cvtpk(s1[10], s1[11]), cvtpk(s1[12], s1[13]), cvtpk(s1[14], s1[15])}; \
        if (c == 0 && VAR != 5) pv_tile(o, P, vf0, lds + VOFF + vcur + voff); \
        if (t + 1 < NT && VAR != 4) { LAS unsigned char* kn = lds + ((t + 1) & 1) * KBUF; LAS unsigned char* vn = lds + vnext; \
            _Pragma("unroll") for (int i = 0; i < 2; ++i) { *(LAS u32x4*)(kn + lk[i]) = PKW[i]; *(LAS u32x4*)(vn + lv[i]) = PVW[i]; } } \
        { const int tmp = vprev; vprev = vcur; vcur = vnext; vnext = tmp; } \
        if (VAR != 3) { asm volatile("s_waitcnt lgkmcnt(0)\n\ts_barrier" ::: "memory"); } \
    } while (0)
template <int VAR> __device__ __forceinline__ void unit(LAS unsigned char* lds, const bf16* QK, const bf16* KT, const bf16* VT, bf16* MIX, const float* sgain, float lam, int b, int h, int qb) {
    const int tid = threadIdx.x, lane = tid & 63, r32 = lane & 31, hi = lane >> 5; const int wid = __builtin_amdgcn_readfirstlane(tid >> 6);
    const int qsub = wid & 3, c = wid >> 2;
    const size_t rowbase = (size_t)b * SEQ; const int q0 = qb * 128 + qsub * 32;
    { const bf16* qp = QK + (rowbase + q0 + r32) * 512 + h * 128 + c * 64 + hi * 8;
#pragma unroll
      for (int ds = 0; ds < 4; ++ds) *(LAS bf16x8*)(lds + QOFF + wid * 4096 + ds * 1024 + lane * 16) = *(const bf16x8*)(qp + ds * 16); }
    const bf16* gk[2]; const bf16* gv[2]; int lk[2], lv[2];
#pragma unroll
    for (int i = 0; i < 2; ++i) { const int id = tid + NTHR * i; const int kr = id >> 4, kc = id & 15; const int ve = id >> 3, vc = id & 7;
        gk[i] = KT + (size_t)(b * 4 + h) * 64 * 8192 + id * 8; lk[i] = kr * KP + kc * 16;
        gv[i] = VT + (size_t)(b * 4 + h) * 64 * 8192 + id * 8; lv[i] = VOFF + ve * VP + vc * 16; }
    u32x4 pkA[2], pvA[2], pkB[2], pvB[2];
#pragma unroll
    for (int i = 0; i < 2; ++i) { pkA[i] = *(const u32x4*)gk[i]; pvA[i] = *(const u32x4*)gv[i]; }
#pragma unroll
    for (int i = 0; i < 2; ++i) { pkB[i] = *(const u32x4*)(gk[i] + 8192); pvB[i] = *(const u32x4*)(gv[i] + 8192); }
#pragma unroll
    for (int i = 0; i < 2; ++i) { *(LAS u32x4*)(lds + lk[i]) = pkA[i]; *(LAS u32x4*)(lds + lv[i]) = pvA[i]; }
    __syncthreads();
    f32x16 o[4];
#pragma unroll
    for (int e = 0; e < 4; ++e) o[e] = (f32x16){};
    const f32x16 zero16 = (f32x16){};
    float mref = 0.f, lsum = 0.f; bool gen = false;
    u32x4 P[4];
#pragma unroll
    for (int ks = 0; ks < 4; ++ks) P[ks] = (u32x4){0u, 0u, 0u, 0u};
    int vcur = 0, vprev = 2 * VBUF, vnext = VBUF;
    const int voff = r32 * VP + hi * 16;
    for (int tt = 0; tt < NT; tt += 2) {
        ATT_SLOT(tt, pkB, pvB, pkA, pvA);
        ATT_SLOT(tt + 1, pkA, pvA, pkB, pvB);
    }
    if (c == 1) { bf16x8 vf0[4]; v_load(vf0, lds + VOFF + vprev + voff, 0); pv_tile(o, P, vf0, lds + VOFF + vprev + voff); }
    __syncthreads();
    lsum = xhalf_sum(lsum);
    const float sc = (c == 0) ? (1.0f / lsum) : (lam / lsum);
    LAS float* X = (LAS float*)lds + qsub * (128 * 32);
    if (c == 1) {
#pragma unroll
        for (int e = 0; e < 4; ++e)
#pragma unroll
            for (int r = 0; r < 16; ++r) { const int ee = 32 * e + (r & 3) + 8 * (r >> 2) + 4 * hi; X[ee * 32 + r32] = o[e][r] * sc; } }
    __syncthreads();
    if (c == 0) { float ss = 0.f;
#pragma unroll
        for (int e = 0; e < 4; ++e)
#pragma unroll
            for (int r = 0; r < 16; ++r) { const int ee = 32 * e + (r & 3) + 8 * (r >> 2) + 4 * hi; const float v = o[e][r] * sc - X[ee * 32 + r32]; o[e][r] = v; ss += v * v; }
        ss = xhalf_sum(ss);
        const float rs = (1.0f / sqrtf(ss * (1.0f / 128.0f) + SUBLN_EPS)) * 0.8f;
        bf16* op = MIX + (rowbase + q0 + r32) * 1024 + 512 + h * 128;
#pragma unroll
        for (int e = 0; e < 4; ++e)
#pragma unroll
            for (int q4 = 0; q4 < 4; ++q4) { const int ee = 32 * e + 8 * q4 + 4 * hi; const f32x4 g = *(const f32x4*)(sgain + ee);
                u32x2 w; w.x = cvtpk(o[e][4 * q4] * rs * g.x, o[e][4 * q4 + 1] * rs * g.y); w.y = cvtpk(o[e][4 * q4 + 2] * rs * g.z, o[e][4 * q4 + 3] * rs * g.w);
                *(u32x2*)(op + ee) = w; } }
    __syncthreads();
}
}

namespace hy {
constexpr int UP = 264, UBUF = 32 * UP * 2, HRB = HRLEN * 2;
constexpr int NCH = 17;
__device__ __forceinline__ float ldbf(const bf16* p) { return bf2f(*p); }
struct StageRegs { u32x2 xa, xb, va, vb; unsigned short xm, vm; };
__device__ __forceinline__ void stage_load(StageRegs& R, const bf16* X1, const bf16* V, int j, int tid) {
    const int b = tid >> 6, tt = tid & 63; const int S0 = 256 * j + 4 * tt - 4;
    const bool okA = (S0 >= 0 && S0 < SEQ), okB = (S0 + 4 < SEQ), okM = (S0 >= 1 && S0 <= SEQ);
    const size_t ia = (size_t)b * SEQ + (okA ? S0 : 0), ib = (size_t)b * SEQ + (okB ? S0 + 4 : 0), im = (size_t)b * SEQ + (okM ? S0 - 1 : 0);
    R.xa = *(const u32x2*)(X1 + ia); R.xb = *(const u32x2*)(X1 + ib); R.xm = X1[im];
    R.va = *(const u32x2*)(V + ia); R.vb = *(const u32x2*)(V + ib); R.vm = V[im];
}
__device__ __forceinline__ void stage_write(LAS unsigned char* ub, const StageRegs& R, const float (&w1)[4], const float (&wv)[4], int j, int tid) {
    const int b = tid >> 6, tt = tid & 63; const int S0 = 256 * j + 4 * tt - 4;
    const bool okA = (S0 >= 0 && S0 < SEQ), okB = (S0 + 4 < SEQ), okM = (S0 >= 1 && S0 <= SEQ);
    float xs[9], vs[9];
    xs[0] = okM ? bf2f(R.xm) : 0.f; vs[0] = okM ? bf2f(R.vm) : 0.f;
    xs[1] = okA ? bflo(R.xa.x) : 0.f; xs[2] = okA ? bfhi(R.xa.x) : 0.f; xs[3] = okA ? bflo(R.xa.y) : 0.f; xs[4] = okA ? bfhi(R.xa.y) : 0.f;
    xs[5] = okB ? bflo(R.xb.x) : 0.f; xs[6] = okB ? bfhi(R.xb.x) : 0.f; xs[7] = okB ? bflo(R.xb.y) : 0.f; xs[8] = okB ? bfhi(R.xb.y) : 0.f;
    vs[1] = okA ? bflo(R.va.x) : 0.f; vs[2] = okA ? bfhi(R.va.x) : 0.f; vs[3] = okA ? bflo(R.va.y) : 0.f; vs[4] = okA ? bfhi(R.va.y) : 0.f;
    vs[5] = okB ? bflo(R.vb.x) : 0.f; vs[6] = okB ? bfhi(R.vb.x) : 0.f; vs[7] = okB ? bflo(R.vb.y) : 0.f; vs[8] = okB ? bfhi(R.vb.y) : 0.f;
    float g[7];
#pragma unroll
    for (int i = 0; i < 7; ++i) { const float cx = w1[0] * xs[i] + w1[1] * xs[i + 1] + w1[2] * xs[i + 2] + w1[3]; const float cv = wv[0] * vs[i] + wv[1] * vs[i + 1] + wv[2] * vs[i + 2] + wv[3];
        g[i] = ((i < 4) ? okA : okB) ? cx * cv : 0.f; }
#pragma unroll
    for (int r = 0; r < 4; ++r) { u32x2 w; w.x = pk2(g[r], g[r + 1]); w.y = pk2(g[r + 2], g[r + 3]);
        *(LAS u32x2*)(ub + ((4 * b + r) * UP + 4 * tt) * 2) = w; }
}
__device__ __forceinline__ void channel(LAS unsigned char* lds, const bf16* UVT, const bf16* HR, const float* conv_w, const float* conv_b, bf16* YT, int c) {
    const int tid = threadIdx.x, lane = tid & 63, r32 = lane & 31, hi = lane >> 5; const int wid = __builtin_amdgcn_readfirstlane(tid >> 6);
    const bf16* X0 = UVT + (size_t)c * MTOK; const bf16* X1 = UVT + (size_t)(512 + c) * MTOK; const bf16* V = UVT + (size_t)(1024 + c) * MTOK;
    float w0[4], w1[4], wv[4];
#pragma unroll
    for (int k = 0; k < 3; ++k) { w0[k] = conv_w[k * 1536 + c]; w1[k] = conv_w[k * 1536 + 512 + c]; wv[k] = conv_w[k * 1536 + 1024 + c]; }
    w0[3] = conv_b[c]; w1[3] = conv_b[512 + c]; wv[3] = conv_b[1024 + c];
    for (int i = tid; i < HRB / 16; i += NTHR) { const bf16* src = HR + (size_t)c * HRLEN + 8 * i; ((LAS u32x4*)lds)[i] = *(const u32x4*)src;
        const u32x2 lo = *(const u32x2*)(src + 4); const u32x2 hi2 = (8 * i + 8 < HRLEN) ? *(const u32x2*)(src + 8) : (u32x2){0u, 0u};
        ((LAS u32x4*)(lds + HRB))[i] = (u32x4){lo.x, lo.y, hi2.x, hi2.y}; }
    LAS unsigned char* ub0 = lds + 2 * HRB;
    StageRegs SR;
    stage_load(SR, X1, V, 0, tid); stage_write(ub0, SR, w1, wv, 0, tid);
    __syncthreads();
    f32x16 acc[4];
#pragma unroll
    for (int n = 0; n < 4; ++n) acc[n] = (f32x16){};
    const int idx0 = 4096 - 4 * (128 * wid + r32) - 4 + 8 * hi;
    const int hb0 = (r32 & 1) ? idx0 * 2 : HRB + (idx0 - 4) * 2;
    for (int j = 0; j < NCH; ++j) {
        LAS unsigned char* ucur = ub0 + (j & 1) * UBUF;
        if (j + 1 < NCH) stage_load(SR, X1, V, j + 1, tid);
        const int nks = (j < NCH - 1) ? 16 : 1;
        const LAS unsigned char* ua = ucur + r32 * (UP * 2) + hi * 16;
        const LAS unsigned char* hp = lds + hb0 + j * 512;
        if (nks == 16) {
            bf16x8 a0, b0[4], a1, b1[4];
            a0 = *(const LAS bf16x8*)(ua);
#pragma unroll
            for (int n = 0; n < 4; ++n) b0[n] = *(const LAS bf16x8*)(hp - n * 256);
#pragma unroll
            for (int ks = 0; ks < 16; ks += 2) {
                a1 = *(const LAS bf16x8*)(ua + (ks + 1) * 32);
#pragma unroll
                for (int n = 0; n < 4; ++n) b1[n] = *(const LAS bf16x8*)(hp + (ks + 1) * 32 - n * 256);
                __builtin_amdgcn_sched_barrier(0);
#pragma unroll
                for (int n = 0; n < 4; ++n) acc[n] = __builtin_amdgcn_mfma_f32_32x32x16_bf16(a0, b0[n], acc[n], 0, 0, 0);
                __builtin_amdgcn_sched_barrier(0);
                if (ks + 2 < 16) { a0 = *(const LAS bf16x8*)(ua + (ks + 2) * 32);
#pragma unroll
                    for (int n = 0; n < 4; ++n) b0[n] = *(const LAS bf16x8*)(hp + (ks + 2) * 32 - n * 256); }
                __builtin_amdgcn_sched_barrier(0);
#pragma unroll
                for (int n = 0; n < 4; ++n) acc[n] = __builtin_amdgcn_mfma_f32_32x32x16_bf16(a1, b1[n], acc[n], 0, 0, 0);
                __builtin_amdgcn_sched_barrier(0);
            }
        } else {
            const bf16x8 a = *(const LAS bf16x8*)(ua);
#pragma unroll
            for (int n = 0; n < 4; ++n) { const bf16x8 bb = *(const LAS bf16x8*)(hp - n * 256);
                acc[n] = __builtin_amdgcn_mfma_f32_32x32x16_bf16(a, bb, acc[n], 0, 0, 0); }
        }
        if (j + 1 < NCH) stage_write(ub0 + ((j + 1) & 1) * UBUF, SR, w1, wv, j + 1, tid);
        __syncthreads();
    }
#pragma unroll
    for (int n = 0; n < 4; ++n) { const int t = 4 * (128 * wid + 32 * n + r32);
#pragma unroll
        for (int q = 0; q < 4; ++q) { const int b = 2 * q + hi; const bf16* xp = X0 + (size_t)b * SEQ + t; const u32x2 xa = *(const u32x2*)xp; float xs[6];
            { const float xm = ldbf(xp - ((t > 0) ? 1 : 0)), xq = ldbf(xp + ((t + 4 < SEQ) ? 4 : 0)); xs[0] = (t > 0) ? xm : 0.f; xs[5] = (t + 4 < SEQ) ? xq : 0.f; }
            xs[1] = bflo(xa.x); xs[2] = bfhi(xa.x); xs[3] = bflo(xa.y); xs[4] = bfhi(xa.y);
            float y[4];
#pragma unroll
            for (int i = 0; i < 4; ++i) y[i] = acc[n][4 * q + i] * (w0[0] * xs[i] + w0[1] * xs[i + 1] + w0[2] * xs[i + 2] + w0[3]);
            u32x2 w; w.x = pk2(y[0], y[1]); w.y = pk2(y[2], y[3]);
            *(u32x2*)(YT + (size_t)c * MTOK + (size_t)b * SEQ + t) = w; } }
    __syncthreads();
}
}

#define XB_TMO      128
#define XB_XCNT(j)  (256  + 64 * (j))
#define XB_XSUB(j)  (1280 + 64 * (j))
#define XB_XGEN(j)  (2304 + 64 * (j))
#define XB_TOP      3328
#define XB_TOPGEN   3392
#define XCD_BAR_WORDS 3456
#define XB_SPIN_CAP (1u << 18)

__device__ __forceinline__ unsigned xb_ld(unsigned* p)              { return __hip_atomic_load(p, __ATOMIC_RELAXED, __HIP_MEMORY_SCOPE_AGENT); }
__device__ __forceinline__ unsigned xb_add(unsigned* p, unsigned v) { return __hip_atomic_fetch_add(p, v, __ATOMIC_RELAXED, __HIP_MEMORY_SCOPE_AGENT); }
__device__ __forceinline__ unsigned xb_xcc_id() { return (unsigned)__builtin_amdgcn_s_getreg((3 << 11) | 20) & 0xFu; }
#define XB_SPIN(cond, bar) do { unsigned _sp = 0; while (cond) { __builtin_amdgcn_s_sleep(1); \
    if ((++_sp & 255u) == 0u) { if (xb_ld(&(bar)[XB_TMO])) break; if (_sp > XB_SPIN_CAP) { atomicAdd(&(bar)[XB_TMO], 1u); break; } } } } while (0)

struct XcdBarrier {
    unsigned* bar; unsigned x;
    volatile LAS unsigned* st;
};

__device__ __forceinline__ XcdBarrier xcd_barrier_post(unsigned* bar, volatile LAS unsigned* st) {
    XcdBarrier b; b.bar = bar; b.x = xb_xcc_id(); b.st = st;
    if (threadIdx.x == 0) (void)xb_add(&bar[XB_XCNT(b.x)], 1u);
    return b;
}
__device__ __forceinline__ void xcd_barrier_complete(unsigned* bar, unsigned x, unsigned& nloc, unsigned& nx) {
    const unsigned G = gridDim.x * gridDim.y * gridDim.z;
    unsigned sum, cnt, mine, sp = 0u;
    for (;;) {
        sum = 0u; cnt = 0u; mine = 0u;
#pragma unroll
        for (unsigned j = 0; j < 16; ++j) { const unsigned c = xb_ld(&bar[XB_XCNT(j)]); sum += c; cnt += (c > 0u) ? 1u : 0u; mine = (j == x) ? c : mine; }
        if (sum == G) break;
        __builtin_amdgcn_s_sleep(1);
        if ((++sp & 255u) == 0u) { if (xb_ld(&bar[XB_TMO])) break; if (sp > XB_SPIN_CAP) { atomicAdd(&bar[XB_TMO], 1u); break; } }
    }
    nloc = mine > 0u ? mine : 1u; nx = cnt > 0u ? cnt : 1u;
}

__device__ __forceinline__ void xcd_barrier(const XcdBarrier& b) {
    asm volatile("s_waitcnt vmcnt(0)" ::: "memory");
    __syncthreads();
    if (threadIdx.x == 0) {
        unsigned* bar = b.bar;
        __builtin_amdgcn_s_waitcnt(0);
        unsigned nloc = b.st[0], nx = b.st[1];
        if (nloc == 0u) { xcd_barrier_complete(bar, b.x, nloc, nx); b.st[0] = nloc; b.st[1] = nx; }
        const unsigned old = xb_add(&bar[XB_XSUB(b.x)], 1u);
        const unsigned gen = old / nloc;
        if (old + 1u == (gen + 1u) * nloc) {
            __builtin_amdgcn_fence(__ATOMIC_RELEASE, "agent");
            asm volatile("s_waitcnt vmcnt(0)" ::: "memory");
            const unsigned og = xb_add(&bar[XB_TOP], 1u);
            const unsigned tg = og / nx;
            if (og + 1u == (tg + 1u) * nx) xb_add(&bar[XB_TOPGEN], 1u);
            else XB_SPIN(xb_ld(&bar[XB_TOPGEN]) == tg, bar);
            __builtin_amdgcn_fence(__ATOMIC_ACQUIRE, "agent");
            xb_add(&bar[XB_XGEN(b.x)], 1u);
            asm volatile("s_waitcnt vmcnt(0)" ::: "memory");
        } else {
            XB_SPIN(xb_ld(&bar[XB_XGEN(b.x)]) == gen, bar);
            __builtin_amdgcn_fence(__ATOMIC_ACQUIRE, "agent");
            asm volatile("s_waitcnt vmcnt(0)" ::: "memory");
        }
    }
    __syncthreads();
}

__global__ void __launch_bounds__(NTHR, 2) fwd_kernel(Args a) {
    extern __shared__ __attribute__((aligned(16))) unsigned char lds_raw[];
    LAS unsigned char* lds = (LAS unsigned char*)lds_raw;
    const int tid = threadIdx.x, lane = tid & 63; const int wave = __builtin_amdgcn_readfirstlane(tid >> 6);
    const int G = gridDim.x, bx = blockIdx.x;
    const int gw = bx * NWAVES + wave, NGW = G * NWAVES;
    unsigned char* ws = a.ws;
    bf16* Win_t = (bf16*)(ws + WS_WIN); bf16* Wout_t = (bf16*)(ws + WS_WOUT); bf16* Wup_t = (bf16*)(ws + WS_WUP); bf16* Wdown_t = (bf16*)(ws + WS_WDOWN);
    bf16* HR = (bf16*)(ws + WS_HR); float* ROPE = (float*)(ws + WS_ROPE);
    bf16* XN = (bf16*)(ws + WS_XN); bf16* MO = (bf16*)(ws + WS_MO); bf16* YT = (bf16*)(ws + WS_YT); bf16* UVT = (bf16*)(ws + WS_UVT);
    bf16* QK = (bf16*)(ws + WS_QK); bf16* KT = (bf16*)(ws + WS_KT); bf16* VT = (bf16*)(ws + WS_VT); bf16* MIX = (bf16*)(ws + WS_MIX); bf16* HB = (bf16*)(ws + WS_H);
    const float* x = a.in[0];
    const int lo = a.ph_lo, hi_ph = a.ph_hi;
#if MK_COOP
    cg::grid_group grid = cg::this_grid();
    volatile LAS unsigned* bst = (volatile LAS unsigned*)(lds + 131072 + 64);
    if (tid < 4) bst[tid] = 0u;
    __syncthreads();
    XcdBarrier xbar = xcd_barrier_post((unsigned*)(ws + WS_CTL), bst);
#define SEAM(k) do { if (lo <= (k) && (k) + 1 < hi_ph) { if (hi_ph > 64) grid.sync(); else xcd_barrier(xbar); } } while (0)
#else
#define SEAM(k) do { } while (0)
#endif
#ifndef PHMASK
#define PHMASK 0x1ff
#endif
#define IN(k) (((PHMASK >> (k)) & 1) && lo <= (k) && (k) < hi_ph)

#ifndef DUP_P0
#define DUP_P0 1
#endif
    if (IN(0)) for (int rep0 = 0; rep0 < DUP_P0; ++rep0) {
        LAS float* scr = (LAS float*)(lds + wave * 16384);
        constexpr int I_IN = (DM / 64) * (NIN / 32), I_OUT = (DM / 64) * (DM / 32), I_UP = (DM / 64) * (DFF / 32), I_DN = (DFF / 64) * (DM / 32);
        for (int it = gw; it < I_IN + I_OUT + I_UP + I_DN; it += NGW) { int r = it;
            if (r < I_IN) { p0_transpose_item<true>(a.in[3], DM, NIN, Win_t, scr, r, lane); continue; } r -= I_IN;
            if (r < I_OUT) { p0_transpose_item<false>(a.in[20], DM, DM, Wout_t, scr, r, lane); continue; } r -= I_OUT;
            if (r < I_UP) { p0_transpose_item<false>(a.in[23], DM, DFF, Wup_t, scr, r, lane); continue; } r -= I_UP;
            p0_transpose_item<false>(a.in[24], DFF, DM, Wdown_t, scr, r, lane); }
        for (int m = gw; m < MTOK; m += NGW) rms_row_to_bf16(x + (size_t)m * DM, a.in[1], XN + (size_t)m * DM, lane);
        for (int i = bx * NTHR + tid; i < SEQ * 32; i += G * NTHR) { const int pos = i >> 5, k = i & 31;
            const float inv = exp2f(-(float)(2 * k) * (13.287712379549449f / 64.0f)); const float ang = (float)pos * inv;
            ROPE[2 * i] = cosf(ang); ROPE[2 * i + 1] = sinf(ang); }
        __syncthreads();
        for (int pg = bx; pg < SEQ / 16; pg += G) filter_item(lds, a, HR, pg, tid);
    }
    SEAM(0);
#ifndef DUP_P1
#define DUP_P1 1
#endif
    if (IN(1)) {
        { pg8::Gemm g{Win_t, XN, 2048, MTOK, DM}; pg8::StaticOrder S; S.init(2048, MTOK, G, bx);
          pg8::EpiUV E{UVT, VT};
          pg8::gemm_phase<pg8::EpiUV, pg8::StaticOrder, true, true>(lds, g, S, E); }
        { pg8::Gemm g{XN, Win_t + (size_t)2048 * DM, MTOK, 1024, DM}; pg8::StaticOrder S; S.init(MTOK, 1024, G, bx);
          pg8::EpiRope E{QK, KT, ROPE, QSCALE};
          pg8::gemm_phase<pg8::EpiRope, pg8::StaticOrder, true, true>(lds, g, S, E); }
    }
#if DUP_P1 == 2
    if (IN(1)) {
        { pg8::Gemm g{Win_t, XN, 2048, MTOK, DM}; pg8::StaticOrder S; S.init(2048, MTOK, G, bx);
          pg8::EpiUV E{UVT, VT};
          pg8::gemm_phase<pg8::EpiUV, pg8::StaticOrder, true, true>(lds, g, S, E); }
        { pg8::Gemm g{XN, Win_t + (size_t)2048 * DM, MTOK, 1024, DM}; pg8::StaticOrder S; S.init(MTOK, 1024, G, bx);
          pg8::EpiRope E{QK, KT, ROPE, QSCALE};
          pg8::gemm_phase<pg8::EpiRope, pg8::StaticOrder, true, true>(lds, g, S, E); }
    }
#endif
    SEAM(1);
    if (IN(2)) {
        float lam;
        { const float p1 = a.in[15][lane] * a.in[16][lane], p2 = a.in[17][lane] * a.in[18][lane];
          lam = expf(wave_sum(p1)) - expf(wave_sum(p2)) + 0.2f; }
#ifndef DUP_ATT
#define DUP_ATT 1
#endif
#ifndef DUP_HY
#define DUP_HY 1
#endif
#ifndef ATT_VAR
#define ATT_VAR 0
#endif
        for (int u = bx; u < 1024; u += G) { const int bh = (u & 7) + 8 * (u >> 8), qb = (u >> 3) & 31;
            att::unit<0>(lds, QK, KT, VT, MIX, a.in[19], lam, bh >> 2, bh & 3, qb); }
        if (DUP_ATT > 1)
        for (int u = bx; u < 1024; u += G) { const int bh = (u & 7) + 8 * (u >> 8), qb = (u >> 3) & 31;
            att::unit<ATT_VAR>(lds, QK, KT, VT, MO, a.in[19], lam, bh >> 2, bh & 3, qb); }
        for (int rep = 0; rep < DUP_HY; ++rep)
        for (int c = bx; c < HYW; c += G) hy::channel(lds, UVT, HR, a.in[4], a.in[5], YT, c);
    }
    SEAM(2);
#ifndef DUP_P3
#define DUP_P3 1
#endif
    if (IN(3)) for (int rep3 = 0; rep3 < DUP_P3; ++rep3) {
        LAS unsigned short* scr = (LAS unsigned short*)(lds + wave * 16384);
        for (int it = gw; it < 8 * (MTOK / 64); it += NGW) { const int ct = it & 7, mt = it >> 3; const int c0 = 64 * ct, m0 = 64 * mt;
#pragma unroll
            for (int i = 0; i < 8; ++i) { const int cc = 8 * i + (lane >> 3), mch = lane & 7; const u32x4 v = *(const u32x4*)(YT + (size_t)(c0 + cc) * MTOK + m0 + 8 * mch);
                LAS unsigned* d = (LAS unsigned*)(scr + cc * 66 + 8 * mch); d[0] = v.x; d[1] = v.y; d[2] = v.z; d[3] = v.w; }
            LDS_WAIT(); asm volatile("" ::: "memory");
#pragma unroll
            for (int i = 0; i < 8; ++i) { const int mm = 8 * i + (lane >> 3), cch = lane & 7; const LAS unsigned short* s = scr + (8 * cch) * 66 + mm;
                u32x4 o; o.x = (unsigned)s[0] | ((unsigned)s[66] << 16); o.y = (unsigned)s[2 * 66] | ((unsigned)s[3 * 66] << 16);
                o.z = (unsigned)s[4 * 66] | ((unsigned)s[5 * 66] << 16); o.w = (unsigned)s[6 * 66] | ((unsigned)s[7 * 66] << 16);
                *(u32x4*)(MIX + (size_t)(m0 + mm) * 1024 + c0 + 8 * cch) = o; }
            LDS_WAIT(); asm volatile("" ::: "memory"); }
        __syncthreads();
    }
    SEAM(3);
    if (IN(4)) {
        pg8::Gemm g{MIX, Wout_t, MTOK, DM, DM}; pg8::StaticOrder S; S.init(MTOK, DM, G, bx);
        float* ssb = (float*)(ws + WS_CTL + CTL_SS); unsigned* cntb = (unsigned*)(ws + WS_CTL + CTL_CNT);
        pg8::EpiNormResNorm E{x, MO, XN, a.in[2], a.in[21], ssb, ssb + MTOK, cntb, cntb + 128, NORM_EPS};
        pg8::gemm_phase<pg8::EpiNormResNorm, pg8::StaticOrder, true, true>(lds, g, S, E);
    }
    SEAM(4);
#ifndef DUP_P6
#define DUP_P6 1
#endif
    if (IN(6)) for (int rep6 = 0; rep6 < DUP_P6; ++rep6) {
        pg8::Gemm g{XN, Wup_t, MTOK, DFF, DM}; pg8::StaticOrder S; S.init(MTOK, DFF, G, bx);
        pg8::EpiBf16<1> E{HB, DFF};
        pg8::gemm_phase<pg8::EpiBf16<1>, pg8::StaticOrder, true, true>(lds, g, S, E);
    }
    SEAM(6);
    if (IN(7)) {
        pg8::Gemm g{HB, Wdown_t, MTOK, DM, DFF}; pg8::StaticOrder S; S.init(MTOK, DM, G, bx);
        float* ssb = (float*)(ws + WS_CTL + CTL_SS); unsigned* cntb = (unsigned*)(ws + WS_CTL + CTL_CNT);
        pg8::EpiNormRes E{MO, a.out, a.in[22], ssb + 2 * MTOK, cntb + 256, NORM_EPS};
        pg8::gemm_phase<pg8::EpiNormRes, pg8::StaticOrder, true, true>(lds, g, S, E);
    }
#undef IN
#undef SEAM
}

constexpr int NPHASE = 9;
extern "C" void kernel_launch(void* const* d_in, const int* in_sizes, int n_in, void* d_out, int out_size, void* d_ws, size_t ws_size, hipStream_t stream) {
    static int grid = 0;
    if (grid == 0) {
        if (n_in != 25 || in_sizes[0] != MTOK * DM || out_size != MTOK * DM || ws_size < WS_END) {
            fprintf(stderr, "kernel_launch: unexpected shapes (n_in %d in0 %d out %d ws %zu)\n", n_in, n_in > 0 ? in_sizes[0] : -1, out_size, ws_size); grid = -1; return; }
        int dev = 0, cus = 0, per_cu = 0;
        hipGetDevice(&dev); hipDeviceGetAttribute(&cus, hipDeviceAttributeMultiprocessorCount, dev);
        hipFuncSetAttribute((const void*)fwd_kernel, hipFuncAttributeMaxDynamicSharedMemorySize, LDS_BYTES);
        hipOccupancyMaxActiveBlocksPerMultiprocessor(&per_cu, (const void*)fwd_kernel, NTHR, LDS_BYTES);
        if (per_cu < 1) { fprintf(stderr, "kernel_launch: occupancy query says %d blocks/CU\n", per_cu); per_cu = 1; }
        (void)hipGetLastError();
        grid = cus >= 256 ? 256 : cus;
    }
    if (grid < 0) return;
    Args a{};
    for (int i = 0; i < 25; ++i) a.in[i] = (const float*)d_in[i];
    a.out = (float*)d_out; a.ws = (unsigned char*)d_ws;
#if MK_COOP
    a.ph_lo = 0; a.ph_hi = NPHASE;
    if (hipMemsetAsync((unsigned char*)d_ws + WS_CTL, 0, CTL_BYTES, stream) != hipSuccess) { fprintf(stderr, "kernel_launch: memset of the barrier words failed\n"); return; }
    void* args[] = {&a};
    hipError_t e = hipLaunchCooperativeKernel((const void*)fwd_kernel, dim3(grid), dim3(NTHR), args, LDS_BYTES, stream);
    if (e != hipSuccess) fprintf(stderr, "cooperative launch failed: %s (grid %d)\n", hipGetErrorString(e), grid);
#else
    for (int p = 0; p < NPHASE; ++p) { a.ph_lo = p; a.ph_hi = p + 1; hipLaunchKernelGGL(fwd_kernel, dim3(grid), dim3(NTHR), LDS_BYTES, stream, a); }
#endif
}
```

```cpp
#include <hip/hip_runtime.h>
#include <hip/hip_cooperative_groups.h>
#include <cstdio>
#include <cstdint>
#include <cmath>
namespace cg = cooperative_groups;
#ifndef MK_COOP
#define MK_COOP 1
#endif
namespace pg8 {
#define PG8_LAS __attribute__((address_space(3)))
typedef unsigned short bf16_t;
typedef short bf16x8 __attribute__((ext_vector_type(8)));
typedef float f32x4 __attribute__((ext_vector_type(4)));
typedef unsigned u32x4 __attribute__((ext_vector_type(4)));
constexpr int BM = 256, BK = 64, HALF = 128, HTB = HALF * BK * 2  , STAGE_BYTES = 8 * HTB, NXCD = 8, WGM = 8;

__host__ __device__ __forceinline__ int lds_byte(int r, int c) { const int st = (r >> 4) * 2 + (c >> 5), rr = r & 15, cc = c & 31, ob = rr * 64 + cc * 2; return st * 1024 + (ob ^ (((ob >> 9) & 1) << 5)); }
__host__ __device__ __forceinline__ void stage_rc(int b, int& R, int& C) { const int st = b / 1024, sb = b % 1024, swz = sb ^ (((sb >> 9) & 1) << 5); R = (st >> 1) * 16 + swz / 64; C = (st & 1) * 32 + (swz % 64) / 2; }
__host__ __device__ __forceinline__ int perm32(int rho) { const int n = rho >> 4, i = rho & 15; return 8 * (i >> 2) + 4 * n + (i & 3); }

struct Unit { int pm, pn; };
struct Gemm { const bf16_t* A; const bf16_t* Bt; int M, N, K; };

struct StaticOrder {
    int nM, nN, nwg, G, c;
    __host__ __device__ void init(int M, int N, int G_, int c_) { nM = M / BM; nN = N / BM; nwg = nM * nN; G = G_; c = c_; }
    __host__ __device__ bool next(int i, Unit& u) const {
        const long L = (long)i * G + c; if (L >= nwg) return false;
        int wgid = (int)L; { const int q = nwg / NXCD, r = nwg % NXCD, xcd = wgid % NXCD, off = wgid / NXCD; wgid = (xcd < r ? xcd * (q + 1) : r * (q + 1) + (xcd - r) * q) + off; }
        const int nig = WGM * nN, gid = wgid / nig, fm = gid * WGM, gsz = (nM - fm) < WGM ? (nM - fm) : WGM;
        u.pm = fm + ((wgid % nig) % gsz); u.pn = (wgid % nig) / gsz; return true;
    }
    __device__ __forceinline__ void a_ready(const Unit&) const {}
    __device__ __forceinline__ void done(const Unit&) const {}
};

__device__ __forceinline__ unsigned cvt_pk_bf16(float lo, float hi) { unsigned r; asm volatile("v_cvt_pk_bf16_f32 %0, %1, %2" : "=v"(r) : "v"(lo), "v"(hi)); return r; }
typedef float f32x2 __attribute__((ext_vector_type(2)));
typedef float f32x2 __attribute__((ext_vector_type(2)));
typedef unsigned u32x2 __attribute__((ext_vector_type(2)));
template <int ACT> struct EpiBf16 {
    static constexpr bool PERM = true, AFTER_DRAIN = false;
    bf16_t* O; int ldc;
    __device__ __forceinline__ void operator()(const f32x4 (&acc)[2][2][4][2], const Unit& u, int wr, int wc, int fr, int fq) const {
        const int row0 = u.pm * BM + wr * 64 + fr; const int col0 = u.pn * BM + wc * 32 + 8 * fq;
#pragma unroll
        for (int ai = 0; ai < 2; ++ai)
#pragma unroll
            for (int m = 0; m < 4; ++m) { bf16_t* rowp = O + (size_t)(row0 + ai * HALF + m * 16) * ldc + col0;
#pragma unroll
                for (int bj = 0; bj < 2; ++bj) { f32x4 v0 = acc[ai][bj][m][0], v1 = acc[ai][bj][m][1];
                    if (ACT == 1) {
#pragma unroll
                        for (int j = 0; j < 4; ++j) { float a = v0[j] > 0.f ? v0[j] : 0.f; v0[j] = a * a; float b = v1[j] > 0.f ? v1[j] : 0.f; v1[j] = b * b; } }
                    u32x4 w; w.x = cvt_pk_bf16(v0[0], v0[1]); w.y = cvt_pk_bf16(v0[2], v0[3]); w.z = cvt_pk_bf16(v1[0], v1[1]); w.w = cvt_pk_bf16(v1[2], v1[3]);
                    *(u32x4*)(rowp + bj * HALF) = w; } }
    }
};
struct EpiRope {
    static constexpr bool PERM = true, AFTER_DRAIN = false;
    bf16_t* Q; bf16_t* KT; const float* rope; float qscale;
    __device__ __forceinline__ void operator()(const f32x4 (&acc)[2][2][4][2], const Unit& u, int wr, int wc, int fr, int fq) const {
        const int row0 = u.pm * BM + wr * 64 + fr; const int col0 = u.pn * BM + wc * 32 + 8 * fq;
        const int g = (wc & 1) * 4 + fq;
        const float sc = (u.pn < 2) ? qscale : 1.0f;
#pragma unroll
        for (int ai = 0; ai < 2; ++ai)
#pragma unroll
            for (int m = 0; m < 4; ++m) { const int row = row0 + ai * HALF + m * 16; const int pos = row & 4095;
                const f32x4 cs0 = *(const f32x4*)(rope + (size_t)pos * 64 + 8 * g), cs1 = *(const f32x4*)(rope + (size_t)pos * 64 + 8 * g + 4);
                const float c[4] = {cs0[0], cs0[2], cs1[0], cs1[2]}, s[4] = {cs0[1], cs0[3], cs1[1], cs1[3]};
                bf16_t* rowp;
                if (u.pn < 2) rowp = Q + (size_t)row * 512 + col0;
                else { const int ck = col0 - 512, hh = ck >> 7, cc = ck & 127; rowp = KT + ((size_t)(((row >> 12) * 4 + hh) * 64 + (pos >> 6)) * 8192 + (pos & 63) * 128 + cc); }
#pragma unroll
                for (int bj = 0; bj < 2; ++bj) { const f32x4 lo = acc[ai][bj][m][0], hi = acc[ai][bj][m][1]; float ol[4], oh[4];
#pragma unroll
                    for (int j = 0; j < 4; ++j) { ol[j] = (lo[j] * c[j] - hi[j] * s[j]) * sc; oh[j] = (hi[j] * c[j] + lo[j] * s[j]) * sc; }
                    u32x4 w; w.x = cvt_pk_bf16(ol[0], ol[1]); w.y = cvt_pk_bf16(ol[2], ol[3]); w.z = cvt_pk_bf16(oh[0], oh[1]); w.w = cvt_pk_bf16(oh[2], oh[3]);
                    *(u32x4*)(rowp + ((u.pn < 2) ? bj * HALF : bj * (64 * 8192))) = w; } }
    }
};
struct EpiUV {
    static constexpr bool PERM = true, AFTER_DRAIN = false;
    bf16_t* UT; bf16_t* VT;
    __device__ __forceinline__ void operator()(const f32x4 (&acc)[2][2][4][2], const Unit& u, int wr, int wc, int fr, int fq) const {
        const int row0 = u.pm * BM + wr * 64 + fr; const int col0 = u.pn * BM + wc * 32 + 8 * fq;
#pragma unroll
        for (int ai = 0; ai < 2; ++ai)
#pragma unroll
            for (int m = 0; m < 4; ++m) { const int row = row0 + ai * HALF + m * 16;
#pragma unroll
                for (int bj = 0; bj < 2; ++bj) { const int col = col0 + bj * HALF; bf16_t* p;
                    if (u.pm < 6) p = UT + (size_t)row * 32768 + col;
                    else { const int ev = row - 1536, hh = ev >> 7, ee = ev & 127, bb = col >> 12, pos = col & 4095;
                        p = VT + ((size_t)((bb * 4 + hh) * 64 + (pos >> 6)) * 8192 + ee * 64 + (pos & 48) + ((pos & 8) >> 1)); }
                    const f32x4 v0 = acc[ai][bj][m][0], v1 = acc[ai][bj][m][1];
                    u32x4 w; w.x = cvt_pk_bf16(v0[0], v0[1]); w.y = cvt_pk_bf16(v0[2], v0[3]); w.z = cvt_pk_bf16(v1[0], v1[1]); w.w = cvt_pk_bf16(v1[2], v1[3]);
                    if (u.pm < 6) *(u32x4*)p = w;
                    else { *(u32x2*)p = (u32x2){w.x, w.y}; *(u32x2*)(p + 8) = (u32x2){w.z, w.w}; } } }
    }
};

__device__ __forceinline__ void panel_sumsq(const f32x4 (&acc)[2][2][4][2], float* ss, unsigned* cnt, const Unit& u, int wr, int fr, int fq, int lane) {
#pragma unroll
    for (int ai = 0; ai < 2; ++ai)
#pragma unroll
        for (int m = 0; m < 4; ++m) { float s = 0.f;
#pragma unroll
            for (int bj = 0; bj < 2; ++bj)
#pragma unroll
                for (int n = 0; n < 2; ++n) { const f32x4 x = acc[ai][bj][m][n]; s += (x[0] * x[0] + x[1] * x[1]) + (x[2] * x[2] + x[3] * x[3]); }
            s += __shfl_xor(s, 16); s += __shfl_xor(s, 32);
            if (fq == 0) __hip_atomic_fetch_add(ss + u.pm * BM + ai * HALF + wr * 64 + m * 16 + fr, s, __ATOMIC_RELAXED, __HIP_MEMORY_SCOPE_AGENT); }
    asm volatile("s_waitcnt vmcnt(0)" ::: "memory");
    __syncthreads();
    if (threadIdx.x == 0) { __hip_atomic_fetch_add(cnt + u.pm, 1u, __ATOMIC_RELAXED, __HIP_MEMORY_SCOPE_AGENT);
        unsigned spins = 0;
        while (__hip_atomic_load(cnt + u.pm, __ATOMIC_RELAXED, __HIP_MEMORY_SCOPE_AGENT) < 4u) { __builtin_amdgcn_s_sleep(8); if (++spins > (1u << 20)) break; } }
    __syncthreads();
}
struct EpiNormRes {
    static constexpr bool PERM = true, AFTER_DRAIN = false;
    const bf16_t* x1b; float* out; const float* gain; float* ss; unsigned* cnt; float eps;
    __device__ __forceinline__ void operator()(f32x4 (&acc)[2][2][4][2], const Unit& u, int wr, int wc, int fr, int fq) const {
        const int lane = fq * 16 + fr;
        panel_sumsq(acc, ss, cnt, u, wr, fr, fq, lane);
        const int row0 = u.pm * BM + wr * 64 + fr; const int col0 = u.pn * BM + wc * 32 + 8 * fq;
        f32x4 g[2][2];
#pragma unroll
        for (int bj = 0; bj < 2; ++bj) { g[bj][0] = *(const f32x4*)(gain + col0 + bj * HALF); g[bj][1] = *(const f32x4*)(gain + col0 + bj * HALF + 4); }
#pragma unroll
        for (int ai = 0; ai < 2; ++ai)
#pragma unroll
            for (int m = 0; m < 4; ++m) { const int row = row0 + ai * HALF + m * 16;
                const float r = 1.0f / sqrtf(__hip_atomic_load(ss + row, __ATOMIC_RELAXED, __HIP_MEMORY_SCOPE_AGENT) * (1.0f / 1024.0f) + eps);
                float* rowp = out + (size_t)row * 1024 + col0; const bf16_t* xp = x1b + (size_t)row * 1024 + col0;
#pragma unroll
                for (int bj = 0; bj < 2; ++bj) { const u32x4 xb = *(const u32x4*)(xp + bj * HALF);
                    const f32x4 b0 = (f32x4){__builtin_bit_cast(float, xb.x << 16), __builtin_bit_cast(float, xb.x & 0xffff0000u), __builtin_bit_cast(float, xb.y << 16), __builtin_bit_cast(float, xb.y & 0xffff0000u)};
                    const f32x4 b1 = (f32x4){__builtin_bit_cast(float, xb.z << 16), __builtin_bit_cast(float, xb.z & 0xffff0000u), __builtin_bit_cast(float, xb.w << 16), __builtin_bit_cast(float, xb.w & 0xffff0000u)};
                    *(f32x4*)(rowp + bj * HALF) = b0 + acc[ai][bj][m][0] * r * g[bj][0]; *(f32x4*)(rowp + bj * HALF + 4) = b1 + acc[ai][bj][m][1] * r * g[bj][1]; } }
    }
};
struct EpiNormResNorm {
    static constexpr bool PERM = true, AFTER_DRAIN = false;
    const float* base; bf16_t* x1b; bf16_t* xn; const float* g1; const float* g2; float* ss1; float* ss2; unsigned* cnt1; unsigned* cnt2; float eps;
    __device__ __forceinline__ void operator()(f32x4 (&acc)[2][2][4][2], const Unit& u, int wr, int wc, int fr, int fq) const {
        const int lane = fq * 16 + fr;
        panel_sumsq(acc, ss1, cnt1, u, wr, fr, fq, lane);
        const int row0 = u.pm * BM + wr * 64 + fr; const int col0 = u.pn * BM + wc * 32 + 8 * fq;
        { f32x4 g[2][2];
#pragma unroll
          for (int bj = 0; bj < 2; ++bj) { g[bj][0] = *(const f32x4*)(g1 + col0 + bj * HALF); g[bj][1] = *(const f32x4*)(g1 + col0 + bj * HALF + 4); }
#pragma unroll
          for (int ai = 0; ai < 2; ++ai)
#pragma unroll
            for (int m = 0; m < 4; ++m) { const int row = row0 + ai * HALF + m * 16;
                const float r = 1.0f / sqrtf(__hip_atomic_load(ss1 + row, __ATOMIC_RELAXED, __HIP_MEMORY_SCOPE_AGENT) * (1.0f / 1024.0f) + eps);
                const float* bp = base + (size_t)row * 1024 + col0; bf16_t* rowp = x1b + (size_t)row * 1024 + col0;
#pragma unroll
                for (int bj = 0; bj < 2; ++bj) { const f32x4 b0 = *(const f32x4*)(bp + bj * HALF), b1 = *(const f32x4*)(bp + bj * HALF + 4);
                    const f32x4 x0 = b0 + acc[ai][bj][m][0] * r * g[bj][0], x1 = b1 + acc[ai][bj][m][1] * r * g[bj][1];
                    acc[ai][bj][m][0] = x0; acc[ai][bj][m][1] = x1;
                    u32x4 w; w.x = cvt_pk_bf16(x0[0], x0[1]); w.y = cvt_pk_bf16(x0[2], x0[3]); w.z = cvt_pk_bf16(x1[0], x1[1]); w.w = cvt_pk_bf16(x1[2], x1[3]);
                    *(u32x4*)(rowp + bj * HALF) = w; } } }
        panel_sumsq(acc, ss2, cnt2, u, wr, fr, fq, lane);
        { f32x4 g[2][2];
#pragma unroll
          for (int bj = 0; bj < 2; ++bj) { g[bj][0] = *(const f32x4*)(g2 + col0 + bj * HALF); g[bj][1] = *(const f32x4*)(g2 + col0 + bj * HALF + 4); }
#pragma unroll
          for (int ai = 0; ai < 2; ++ai)
#pragma unroll
            for (int m = 0; m < 4; ++m) { const int row = row0 + ai * HALF + m * 16;
                const float r = 1.0f / sqrtf(__hip_atomic_load(ss2 + row, __ATOMIC_RELAXED, __HIP_MEMORY_SCOPE_AGENT) * (1.0f / 1024.0f) + eps);
                bf16_t* xp = xn + (size_t)row * 1024 + col0;
#pragma unroll
                for (int bj = 0; bj < 2; ++bj) { const f32x4 v0 = acc[ai][bj][m][0] * r * g[bj][0], v1 = acc[ai][bj][m][1] * r * g[bj][1];
                    u32x4 w; w.x = cvt_pk_bf16(v0[0], v0[1]); w.y = cvt_pk_bf16(v0[2], v0[3]); w.z = cvt_pk_bf16(v1[0], v1[1]); w.w = cvt_pk_bf16(v1[2], v1[3]);
                    *(u32x4*)(xp + bj * HALF) = w; } } }
    }
};
template <class Epi, class Sched, bool ALIGN_EPI = false, bool SP2 = false>
__device__ __forceinline__ void gemm_phase(PG8_LAS unsigned char* lds, const Gemm g, const Sched& S, const Epi& E) {
    const int tid = threadIdx.x, wid = __builtin_amdgcn_readfirstlane(tid >> 6), lane = tid & 63, wr = wid >> 2, wc = wid & 3, fr = lane & 15, fq = lane >> 4;
    const int K = g.K, nt = K / BK;
    unsigned voffA[2], voffB[2];
#pragma unroll
    for (int i = 0; i < 2; ++i) { int R, C; stage_rc(tid * 16 + i * 8192, R, C); const int Rb = Epi::PERM ? ((R & ~31) + perm32(R & 31)) : R;
        voffA[i] = (unsigned)(R * K + C) * 2u; voffB[i] = (unsigned)(Rb * K + C) * 2u; }
    const size_t kstep = (size_t)(BK * 2);
    const size_t hstep = (size_t)HALF * K * 2;
    const size_t tstep = 2 * hstep;
    const unsigned ldsw = (unsigned)wid * 1024u;
    const int aoff = lds_byte(wr * 64 + fr, fq * 8), boff = lds_byte(wc * 32 + fr, fq * 8);
#define PG8_SA(b, h) (((b) * 2 + (h)) * HTB)
#define PG8_SB(b, h) ((4 + (b) * 2 + (h)) * HTB)
#define PG8_STAGE(bufoff, gbase, voff) do { _Pragma("unroll") for (int _i = 0; _i < 2; ++_i) \
        __builtin_amdgcn_global_load_lds((const unsigned*)((const char*)(gbase) + (voff)[_i]), (PG8_LAS unsigned*)(lds + (bufoff) + ldsw + _i * 8192), 16, 0, 0); } while (0)
#define PG8_LDA(dst, b, h) do { _Pragma("unroll") for (int m = 0; m < 4; ++m) _Pragma("unroll") for (int k = 0; k < 2; ++k) dst[m][k] = *(const PG8_LAS bf16x8*)(lds + PG8_SA(b, h) + aoff + m * 2048 + k * 1024); } while (0)
#define PG8_LDB(dst, b, h) do { _Pragma("unroll") for (int n = 0; n < 2; ++n) _Pragma("unroll") for (int k = 0; k < 2; ++k) dst[n][k] = *(const PG8_LAS bf16x8*)(lds + PG8_SB(b, h) + boff + n * 2048 + k * 1024); } while (0)
#define PG8_MMA(ai, bj, At, Bt) do { __builtin_amdgcn_s_setprio(1); _Pragma("unroll") for (int m = 0; m < 4; ++m) _Pragma("unroll") for (int n = 0; n < 2; ++n) _Pragma("unroll") for (int k = 0; k < 2; ++k) \
        acc[ai][bj][m][n] = __builtin_amdgcn_mfma_f32_16x16x32_bf16(Bt[n][k], At[m][k], acc[ai][bj][m][n], 0, 0, 0); __builtin_amdgcn_s_setprio(0); } while (0)
#define PG8_WAIT_V(n) asm volatile("s_waitcnt vmcnt(" #n ")" ::: "memory")
#define PG8_WAIT_L(n) asm volatile("s_waitcnt lgkmcnt(" #n ")" ::: "memory")
#define PG8_BAR __builtin_amdgcn_s_barrier()
#define PG8_SCHED __builtin_amdgcn_sched_barrier(0)
    Unit cur, nxt; int ui = 0;
    if (!S.next(0, cur)) return;
    f32x4 acc[2][2][4][2];
#pragma unroll
    for (int a = 0; a < 2; ++a)
#pragma unroll
        for (int b = 0; b < 2; ++b)
#pragma unroll
            for (int m = 0; m < 4; ++m)
#pragma unroll
                for (int n = 0; n < 2; ++n) acc[a][b][m][n] = (f32x4){0.f, 0.f, 0.f, 0.f};
    bf16x8 At[4][2], B0[2][2], B1[2][2];
    const char* cA = (const char*)g.A + (size_t)cur.pm * tstep; const char* cB = (const char*)g.Bt + (size_t)cur.pn * tstep;
    S.a_ready(cur);
    if constexpr (SP2) {
        PG8_STAGE(PG8_SB(0, 0), cB, voffB); PG8_STAGE(PG8_SB(0, 1), cB + hstep, voffB); PG8_STAGE(PG8_SA(0, 0), cA, voffA); PG8_STAGE(PG8_SA(0, 1), cA + hstep, voffA);
        if (wr == 1) PG8_BAR;
        PG8_WAIT_V(2); PG8_BAR;
        PG8_STAGE(PG8_SB(1, 0), cB + kstep, voffB); PG8_STAGE(PG8_SA(1, 0), cA + kstep, voffA); PG8_STAGE(PG8_SB(1, 1), cB + hstep + kstep, voffB);
        PG8_WAIT_V(6); PG8_BAR;
    } else {
        PG8_STAGE(PG8_SB(0, 0), cB, voffB); PG8_STAGE(PG8_SA(0, 0), cA, voffA); PG8_STAGE(PG8_SB(0, 1), cB + hstep, voffB); PG8_STAGE(PG8_SA(0, 1), cA + hstep, voffA);
        if (wr == 1) PG8_BAR;
        PG8_WAIT_V(4); PG8_BAR;
        PG8_STAGE(PG8_SB(1, 0), cB + kstep, voffB); PG8_STAGE(PG8_SA(1, 0), cA + kstep, voffA); PG8_STAGE(PG8_SB(1, 1), cB + hstep + kstep, voffB);
        PG8_WAIT_V(6); PG8_BAR;
    }
    for (;;) {
        const bool has_next = S.next(ui + 1, nxt);
        const char* nA = has_next ? (const char*)g.A + (size_t)nxt.pm * tstep : cA; const char* nB = has_next ? (const char*)g.Bt + (size_t)nxt.pn * tstep : cB;
        for (int t = 0; t < nt; t += 2) {
            const bool last = (t == nt - 2);
            const char* a1 = cA + (size_t)(t + 1) * kstep;
            const char* a2 = last ? nA : cA + (size_t)(t + 2) * kstep; const char* b2 = last ? nB : cB + (size_t)(t + 2) * kstep;
            const char* a3 = a2 + kstep; const char* b3 = b2 + kstep;
            if (last && has_next) S.a_ready(nxt);
            if constexpr (SP2) {
            PG8_LDB(B0, 0, 0); PG8_LDB(B1, 0, 1); PG8_SCHED; PG8_LDA(At, 0, 0); PG8_STAGE(PG8_SA(1, 1), a1 + hstep, voffA);
            PG8_WAIT_V(8); PG8_WAIT_L(0); PG8_BAR; PG8_MMA(0, 0, At, B0); PG8_MMA(0, 1, At, B1); PG8_BAR; PG8_SCHED;
            PG8_LDA(At, 0, 1); PG8_STAGE(PG8_SB(0, 0), b2, voffB); PG8_STAGE(PG8_SB(0, 1), b2 + hstep, voffB); PG8_STAGE(PG8_SA(0, 0), a2, voffA);
            PG8_WAIT_V(8); PG8_WAIT_L(0); PG8_BAR; PG8_MMA(1, 0, At, B0); PG8_MMA(1, 1, At, B1); PG8_BAR; PG8_SCHED;
            PG8_LDB(B0, 1, 0); PG8_LDB(B1, 1, 1); PG8_SCHED; PG8_LDA(At, 1, 0); PG8_STAGE(PG8_SA(0, 1), a2 + hstep, voffA);
            PG8_WAIT_V(8); PG8_WAIT_L(0); PG8_BAR; PG8_MMA(0, 0, At, B0); PG8_MMA(0, 1, At, B1); PG8_BAR; PG8_SCHED;
            PG8_LDA(At, 1, 1); PG8_STAGE(PG8_SB(1, 0), b3, voffB); PG8_STAGE(PG8_SB(1, 1), b3 + hstep, voffB); PG8_STAGE(PG8_SA(1, 0), a3, voffA);
            PG8_WAIT_V(8); PG8_WAIT_L(0); PG8_BAR; PG8_MMA(1, 0, At, B0); PG8_MMA(1, 1, At, B1); PG8_BAR; PG8_SCHED;
            } else {
            PG8_LDB(B0, 0, 0); PG8_SCHED; PG8_LDA(At, 0, 0); PG8_STAGE(PG8_SA(1, 1), a1 + hstep, voffA);
            PG8_WAIT_L(8); PG8_BAR; PG8_WAIT_L(0); PG8_MMA(0, 0, At, B0); PG8_BAR; PG8_SCHED;
            PG8_LDB(B1, 0, 1); PG8_STAGE(PG8_SB(0, 0), b2, voffB);
            PG8_BAR; PG8_WAIT_L(0); PG8_MMA(0, 1, At, B1); PG8_BAR;
            PG8_LDA(At, 0, 1); PG8_STAGE(PG8_SA(0, 0), a2, voffA);
            PG8_BAR; PG8_WAIT_L(0); PG8_MMA(1, 0, At, B0); PG8_BAR; PG8_SCHED;
            PG8_STAGE(PG8_SB(0, 1), b2 + hstep, voffB);
            PG8_WAIT_V(6); PG8_BAR; PG8_MMA(1, 1, At, B1); PG8_BAR;
            PG8_LDB(B0, 1, 0); PG8_SCHED; PG8_LDA(At, 1, 0); PG8_STAGE(PG8_SA(0, 1), a2 + hstep, voffA);
            PG8_WAIT_L(8); PG8_BAR; PG8_WAIT_L(0); PG8_MMA(0, 0, At, B0); PG8_BAR; PG8_SCHED;
            PG8_LDB(B1, 1, 1); PG8_STAGE(PG8_SB(1, 0), b3, voffB);
            PG8_BAR; PG8_WAIT_L(0); PG8_MMA(0, 1, At, B1); PG8_BAR;
            PG8_LDA(At, 1, 1); PG8_STAGE(PG8_SA(1, 0), a3, voffA);
            PG8_BAR; PG8_WAIT_L(0); PG8_MMA(1, 0, At, B0); PG8_BAR; PG8_SCHED;
            PG8_STAGE(PG8_SB(1, 1), b3 + hstep, voffB);
            PG8_WAIT_V(6); PG8_BAR; PG8_MMA(1, 1, At, B1); PG8_BAR;
            }
        }
        if constexpr (ALIGN_EPI) { if (wr == 0) PG8_BAR; }
        if constexpr (!Epi::AFTER_DRAIN) { E(acc, cur, wr, wc, fr, fq); S.done(cur); }
        if (!has_next) break;
#pragma unroll
        for (int a = 0; a < 2; ++a)
#pragma unroll
            for (int b = 0; b < 2; ++b)
#pragma unroll
                for (int m = 0; m < 4; ++m)
#pragma unroll
                    for (int n = 0; n < 2; ++n) acc[a][b][m][n] = (f32x4){0.f, 0.f, 0.f, 0.f};
        cur = nxt; cA = nA; cB = nB; ++ui;
        if constexpr (ALIGN_EPI) { if (wr == 1) PG8_BAR; }
    }
    PG8_WAIT_V(0);
    if constexpr (!ALIGN_EPI) { if (wr == 0) PG8_BAR; }
    PG8_BAR;
    if constexpr (Epi::AFTER_DRAIN) { E.fused(acc, cur, wr, wc, fr, fq, lds, wid, lane); S.done(cur); }
#undef PG8_SA
#undef PG8_SB
#undef PG8_STAGE
#undef PG8_LDA
#undef PG8_LDB
#undef PG8_MMA
#undef PG8_WAIT_V
#undef PG8_WAIT_L
#undef PG8_BAR
#undef PG8_SCHED
}
}

constexpr int BATCH = 8, SEQ = 4096, DM = 1024, MTOK = BATCH * SEQ, HYW = 512, NIN = 3072, DFF = 4096;
constexpr int NWAVES = 8, NTHR = 512;
constexpr float NORM_EPS = 1e-6f, SUBLN_EPS = 1e-5f;
constexpr float QSCALE = 0.125f * 1.4426950408889634f;
constexpr int HRLEN = 8224;
constexpr size_t MiB = 1u << 20;
constexpr size_t WS_WIN = 0, WS_WOUT = 6 * MiB, WS_WUP = 8 * MiB, WS_WDOWN = 16 * MiB;
constexpr size_t WS_HR = 24 * MiB;
constexpr size_t WS_ROPE = 33 * MiB;
constexpr size_t WS_CTL = 34 * MiB, CTL_BYTES = 16384 + 3 * 131072;
constexpr size_t CTL_CNT = 14336, CTL_SS = 16384;
constexpr size_t WS_XN = 40 * MiB;
constexpr size_t WS_MO = 104 * MiB;
constexpr size_t WS_YT = 168 * MiB;
constexpr size_t WS_UVT = 200 * MiB;
constexpr size_t WS_QK = 328 * MiB;
constexpr size_t WS_KT = 360 * MiB;
constexpr size_t WS_VT = 296 * MiB;
constexpr size_t WS_MIX = 392 * MiB;
constexpr size_t WS_H = 200 * MiB;
constexpr size_t WS_END = 456 * MiB;
constexpr int LDS_BYTES = 135168;

#define LAS __attribute__((address_space(3)))
typedef unsigned short bf16;
typedef unsigned u32x4 __attribute__((ext_vector_type(4)));
typedef unsigned u32x2 __attribute__((ext_vector_type(2)));
typedef float f32x4 __attribute__((ext_vector_type(4)));
typedef float f32x16 __attribute__((ext_vector_type(16)));
typedef short bf16x8 __attribute__((ext_vector_type(8)));
typedef short s16x4 __attribute__((ext_vector_type(4)));

__device__ __forceinline__ unsigned f2bf(float f) { unsigned u = __builtin_bit_cast(unsigned, f); return (u + 0x7fffu + ((u >> 16) & 1u)) >> 16; }
__device__ __forceinline__ unsigned pk2(float lo, float hi) { return f2bf(lo) | (f2bf(hi) << 16); }
typedef float f32x2_t __attribute__((ext_vector_type(2))); typedef __bf16 bf16x2_t __attribute__((ext_vector_type(2)));
__device__ __forceinline__ unsigned cvtpk(float lo, float hi) { f32x2_t v = {lo, hi}; bf16x2_t b = __builtin_convertvector(v, bf16x2_t); return __builtin_bit_cast(unsigned, b); }
__device__ __forceinline__ float bf2f(unsigned short b) { return __builtin_bit_cast(float, (unsigned)b << 16); }
__device__ __forceinline__ float bflo(unsigned w) { return __builtin_bit_cast(float, w << 16); }
__device__ __forceinline__ float bfhi(unsigned w) { return __builtin_bit_cast(float, w & 0xffff0000u); }
__device__ __forceinline__ float wave_sum(float v) {
#pragma unroll
    for (int o = 1; o < 64; o <<= 1) v += __shfl_xor(v, o);
    return v;
}
__device__ __forceinline__ float swap_hi(float v) { return __shfl_xor(v, 32); }
#define LDS_WAIT() asm volatile("s_waitcnt lgkmcnt(0)" ::: "memory")

struct Args { const float* in[25]; float* out; unsigned char* ws; int ph_lo, ph_hi; };

__device__ __forceinline__ int win_src(int n) {
    if (n < 1536) return n;
    if (n < 2048) return n + 1024;
    const int pp = n - 2048, grp = pp >> 6, p = pp & 63, g = p >> 3, e = p & 7;
    const int d = (e < 4) ? (4 * g + e) : (32 + 4 * g + (e - 4));
    return 1536 + grp * 64 + d;
}
template <bool PERMW>
__device__ __forceinline__ void p0_transpose_item(const float* W, int K, int N, bf16* WT, LAS float* scr, int item, int lane) {
    const int nblk = N / 32, kb = item / nblk, nb = item % nblk, k0 = 64 * kb, n0 = 32 * nb;
    const int sc = PERMW ? win_src(n0 + (lane & 31)) : (n0 + (lane & 31));
#pragma unroll 8
    for (int i = 0; i < 32; ++i) { const int kk = 2 * i + (lane >> 5); scr[kk * 33 + (lane & 31)] = W[(size_t)(k0 + kk) * N + sc]; }
    LDS_WAIT(); asm volatile("" ::: "memory");
    const int c = lane & 7;
#pragma unroll
    for (int j = 0; j < 4; ++j) { const int n = (lane >> 3) + 8 * j; const LAS float* s = scr + (8 * c) * 33 + n;
        u32x4 o; o.x = pk2(s[0 * 33], s[1 * 33]); o.y = pk2(s[2 * 33], s[3 * 33]); o.z = pk2(s[4 * 33], s[5 * 33]); o.w = pk2(s[6 * 33], s[7 * 33]);
        *(u32x4*)(WT + (size_t)(n0 + n) * K + k0 + 8 * c) = o; }
    LDS_WAIT(); asm volatile("" ::: "memory");
}
__device__ __forceinline__ void rms_row_to_bf16(const float* xrow, const float* gain, bf16* orow, int lane) {
    const f32x4* xr = (const f32x4*)xrow + lane; const f32x4* gr = (const f32x4*)gain + lane;
    f32x4 v[4]; float s = 0.f;
#pragma unroll
    for (int j = 0; j < 4; ++j) { v[j] = xr[64 * j]; s += (v[j].x * v[j].x + v[j].y * v[j].y) + (v[j].z * v[j].z + v[j].w * v[j].w); }
    const float r = 1.0f / sqrtf(wave_sum(s) * (1.f / DM) + NORM_EPS);
    unsigned long long* o8 = (unsigned long long*)orow + lane;
#pragma unroll
    for (int j = 0; j < 4; ++j) { const f32x4 g = gr[64 * j];
        o8[64 * j] = (unsigned long long)pk2(v[j].x * r * g.x, v[j].y * r * g.y) | ((unsigned long long)pk2(v[j].z * r * g.z, v[j].w * r * g.w) << 32); }
}

__device__ __forceinline__ void filter_item(LAS unsigned char* lds, const Args& a, bf16* HR, int pg, int tid) {
    LAS float* Z = (LAS float*)lds;
    LAS float* HA = Z + 16 * 33;
    LAS float* HB = HA + 16 * 64;
    LAS float* W1 = HB + 16 * 64;
    LAS float* W2 = W1 + 33 * 64;
    LAS float* W3 = W2 + 64 * 64;
    const float* w1 = a.in[6]; const float* b1 = a.in[7]; const float* w2 = a.in[8]; const float* b2 = a.in[9];
    const float* w3 = a.in[10]; const float* b3 = a.in[11]; const float* w4 = a.in[12]; const float* freq = a.in[13]; const float* fbias = a.in[14];
    const int t0 = 16 * pg;
    for (int i = tid; i < 33 * 64; i += NTHR) W1[i] = w1[i];
    for (int i = tid; i < 64 * 64; i += NTHR) { W2[i] = w2[i]; W3[i] = w3[i]; }
    for (int i = tid; i < 16 * 33; i += NTHR) { const int p = i / 33, f = i % 33; const int pos = t0 + p; float val;
        if (f == 0) val = (float)pos * (1.0f / (float)(SEQ - 1));
        else { const int j = (f - 1) & 15; const float fj = 1e-4f + (float)j * ((15.0f - 1e-4f) / 15.0f); const float w = (6.283185307179586f / (float)SEQ) * (float)pos; const float arg = fj * w;
            val = (f <= 16) ? cosf(arg) : -sinf(arg); }
        Z[i] = val; }
    __syncthreads();
    for (int o = tid; o < 1024; o += NTHR) { const int p = o >> 6, n = o & 63; float acc = b1[n];
#pragma unroll 3
        for (int f = 0; f < 33; ++f) acc += Z[p * 33 + f] * W1[f * 64 + n];
        HA[o] = sinf(freq[n] * acc); }
    __syncthreads();
    for (int o = tid; o < 1024; o += NTHR) { const int p = o >> 6, n = o & 63; float acc = b2[n];
#pragma unroll 4
        for (int f = 0; f < 64; ++f) acc += HA[p * 64 + f] * W2[f * 64 + n];
        HB[o] = sinf(freq[n] * acc); }
    __syncthreads();
    for (int o = tid; o < 1024; o += NTHR) { const int p = o >> 6, n = o & 63; float acc = b3[n];
#pragma unroll 4
        for (int f = 0; f < 64; ++f) acc += HB[p * 64 + f] * W3[f * 64 + n];
        HA[o] = sinf(freq[n] * acc); }
    __syncthreads();
    {   const int c = tid;
        float af[16], ab[16];
#pragma unroll
        for (int p = 0; p < 16; ++p) { af[p] = 0.f; ab[p] = 0.f; }
        for (int k0 = 0; k0 < 64; k0 += 8) { float wf[8], wb[8];
#pragma unroll
            for (int kk = 0; kk < 8; ++kk) { wf[kk] = w4[(k0 + kk) * 1024 + c]; wb[kk] = w4[(k0 + kk) * 1024 + 512 + c]; }
#pragma unroll
            for (int kk = 0; kk < 8; ++kk)
#pragma unroll
                for (int p = 0; p < 16; ++p) { const float hv = HA[p * 64 + k0 + kk]; af[p] += hv * wf[kk]; ab[p] += hv * wb[kk]; } }
        const float min_decay = -4.605170185988091f / 1.5f, max_decay = -4.605170185988091f / 0.3f;
        const float adelta = fabsf(min_decay + (float)c * ((max_decay - min_decay) / 511.0f));
        bf16* hr = HR + (size_t)c * HRLEN;
#pragma unroll
        for (int p = 0; p < 16; ++p) { const int pos = t0 + p; const float tl = (float)pos * (1.0f / (float)(SEQ - 1)); const float dec = expf(-tl * adelta); af[p] *= dec; ab[p] *= dec; }
        {   const float e0 = (pg == 0) ? (af[0] + ab[0] + fbias[c]) : ab[0];
            *(u32x4*)(hr + 4096 + t0) = (u32x4){cvtpk(e0, ab[1]), cvtpk(ab[2], ab[3]), cvtpk(ab[4], ab[5]), cvtpk(ab[6], ab[7])};
            *(u32x4*)(hr + 4096 + t0 + 8) = (u32x4){cvtpk(ab[8], ab[9]), cvtpk(ab[10], ab[11]), cvtpk(ab[12], ab[13]), cvtpk(ab[14], ab[15])};
            bf16* hf = hr + 4096 - t0;
            if (pg > 0) hf[0] = (bf16)f2bf(af[0]);
            hf[-15] = (bf16)f2bf(af[15]);
            *(unsigned*)(hf - 14) = cvtpk(af[14], af[13]);
            *(u32x2*)(hf - 12) = (u32x2){cvtpk(af[12], af[11]), cvtpk(af[10], af[9])};
            *(u32x4*)(hf - 8) = (u32x4){cvtpk(af[8], af[7]), cvtpk(af[6], af[5]), cvtpk(af[4], af[3]), cvtpk(af[2], af[1])}; }
        if (pg == 0) { hr[0] = 0; for (int i = 8192; i < HRLEN; ++i) hr[i] = 0; }
    }
    __syncthreads();
}

namespace att {
constexpr int KP = 272, VP = 144, KBUF = 64 * KP, VBUF = 128 * VP, VOFF = 2 * KBUF;
constexpr int NT = SEQ / 64;
__device__ __forceinline__ float max3(float a, float b, float c) { return fmaxf(fmaxf(a, b), c); }
__device__ __forceinline__ float fadd_s(float a, float b) { float r; asm("v_add_f32_e32 %0, %1, %2" : "=v"(r) : "v"(a), "v"(b)); return r; }
#define SBAR() __builtin_amdgcn_sched_barrier(0)
__device__ __forceinline__ void v_load(bf16x8 (&vf)[4], const LAS unsigned char* vb, int ks) {
#pragma unroll
    for (int e = 0; e < 4; ++e) vf[e] = *(const LAS bf16x8*)(vb + e * 32 * VP + ks * 32);
}
__device__ __forceinline__ void pv_tile(f32x16 (&o)[4], const u32x4 (&P)[4], bf16x8 (&vf0)[4], const LAS unsigned char* vb) {
    bf16x8 vf1[4];
#pragma unroll
    for (int ks = 0; ks < 4; ++ks) { const bf16x8 pb = __builtin_bit_cast(bf16x8, P[ks]);
        if (ks == 0 || ks == 2) v_load(vf1, vb, ks + 1); else if (ks == 1) v_load(vf0, vb, 2);
        SBAR(); __builtin_amdgcn_s_setprio(1);
#pragma unroll
        for (int e = 0; e < 4; ++e) o[e] = __builtin_amdgcn_mfma_f32_32x32x16_bf16((ks & 1) ? vf1[e] : vf0[e], pb, o[e], 0, 0, 0);
        __builtin_amdgcn_s_setprio(0); SBAR(); }
}
__device__ __forceinline__ float xhalf_max(float v) { auto rr = __builtin_amdgcn_permlane32_swap(__float_as_uint(v), __float_as_uint(v), false, false); return fmaxf(__uint_as_float(rr[0]), __uint_as_float(rr[1])); }
__device__ __forceinline__ float xhalf_sum(float v) { auto rr = __builtin_amdgcn_permlane32_swap(__float_as_uint(v), __float_as_uint(v), false, false); return __uint_as_float(rr[0]) + __uint_as_float(rr[1]); }
constexpr int QOFF = 2 * KBUF + 3 * VBUF;
#define ATT_SLOT(T, PKW, PVW, PKL, PVL) do { const int t = (T); \
        const LAS unsigned char* kst = lds + (t & 1) * KBUF; \
        bf16x8 vf0[4]; \
        if (c == 1 && t > 0 && VAR != 5) { v_load(vf0, lds + VOFF + vprev + voff, 0); pv_tile(o, P, vf0, lds + VOFF + vprev + voff); } \
        if (t + 2 < NT && VAR != 4) { _Pragma("unroll") for (int i = 0; i < 2; ++i) { PKL[i] = *(const u32x4*)(gk[i] + (size_t)(t + 2) * 8192); PVL[i] = *(const u32x4*)(gv[i] + (size_t)(t + 2) * 8192); } } \
        SBAR(); \
        f32x16 s0, s1; \
        { const LAS unsigned char* kb = kst + r32 * KP + c * 128 + hi * 16; const LAS unsigned char* qb_ = lds + QOFF + wid * 4096 + lane * 16; \
          bf16x8 ka[4], kc2[4], qa[2], qc[2]; \
          qa[0] = *(const LAS bf16x8*)(qb_); qa[1] = *(const LAS bf16x8*)(qb_ + 1024); \
          ka[0] = *(const LAS bf16x8*)(kb); ka[1] = *(const LAS bf16x8*)(kb + 32 * KP); ka[2] = *(const LAS bf16x8*)(kb + 32); ka[3] = *(const LAS bf16x8*)(kb + 32 * KP + 32); \
          SBAR(); \
          qc[0] = *(const LAS bf16x8*)(qb_ + 2048); qc[1] = *(const LAS bf16x8*)(qb_ + 3072); \
          kc2[0] = *(const LAS bf16x8*)(kb + 64); kc2[1] = *(const LAS bf16x8*)(kb + 32 * KP + 64); kc2[2] = *(const LAS bf16x8*)(kb + 96); kc2[3] = *(const LAS bf16x8*)(kb + 32 * KP + 96); \
          __builtin_amdgcn_s_setprio(1); s0 = __builtin_amdgcn_mfma_f32_32x32x16_bf16(ka[0], qa[0], zero16, 0, 0, 0); s1 = __builtin_amdgcn_mfma_f32_32x32x16_bf16(ka[1], qa[0], zero16, 0, 0, 0); \
          s0 = __builtin_amdgcn_mfma_f32_32x32x16_bf16(ka[2], qa[1], s0, 0, 0, 0); s1 = __builtin_amdgcn_mfma_f32_32x32x16_bf16(ka[3], qa[1], s1, 0, 0, 0); \
          SBAR(); \
          s0 = __builtin_amdgcn_mfma_f32_32x32x16_bf16(kc2[0], qc[0], s0, 0, 0, 0); s1 = __builtin_amdgcn_mfma_f32_32x32x16_bf16(kc2[1], qc[0], s1, 0, 0, 0); \
          s0 = __builtin_amdgcn_mfma_f32_32x32x16_bf16(kc2[2], qc[1], s0, 0, 0, 0); s1 = __builtin_amdgcn_mfma_f32_32x32x16_bf16(kc2[3], qc[1], s1, 0, 0, 0); __builtin_amdgcn_s_setprio(0); } \
        if (c == 0 && VAR != 5) v_load(vf0, lds + VOFF + vcur + voff, 0); \
        SBAR(); \
        if (VAR != 6) { float mx = max3(s0[0], s1[0], s0[1]); \
        mx = max3(mx, s1[1], s0[2]); mx = max3(mx, s1[2], s0[3]); mx = max3(mx, s1[3], s0[4]); mx = max3(mx, s1[4], s0[5]); \
        mx = max3(mx, s1[5], s0[6]); mx = max3(mx, s1[6], s0[7]); mx = max3(mx, s1[7], s0[8]); mx = max3(mx, s1[8], s0[9]); \
        mx = max3(mx, s1[9], s0[10]); mx = max3(mx, s1[10], s0[11]); mx = max3(mx, s1[11], s0[12]); mx = max3(mx, s1[12], s0[13]); \
        mx = max3(mx, s1[13], s0[14]); mx = max3(mx, s1[14], s0[15]); mx = fmaxf(mx, s1[15]); \
        mx = xhalf_max(mx); \
        if (t == 0) { if (__any(fabsf(mx) > 8.0f)) { mref = mx; gen = true; } } \
        else if (__any(mx > mref + 8.0f)) { const float mnew = fmaxf(mx, mref); const float al = __builtin_amdgcn_exp2f(mref - mnew); \
            _Pragma("unroll") for (int e = 0; e < 4; ++e) _Pragma("unroll") for (int r = 0; r < 16; ++r) o[e][r] *= al; \
            lsum *= al; mref = mnew; gen = true; } \
        float ps0 = 0.f, ps1 = 0.f; \
        if (gen) { _Pragma("unroll") for (int r = 0; r < 16; ++r) { s0[r] = __builtin_amdgcn_exp2f(s0[r] - mref); s1[r] = __builtin_amdgcn_exp2f(s1[r] - mref); ps0 += s0[r]; ps0 += s1[r]; } } \
        else { _Pragma("unroll") for (int r = 0; r < 16; ++r) { s0[r] = __builtin_amdgcn_exp2f(s0[r]); s1[r] = __builtin_amdgcn_exp2f(s1[r]); ps0 += s0[r]; ps0 += s1[r]; } } \
        lsum += ps0 + ps1; } \
        P[0] = (u32x4){cvtpk(s0[0], s0[1]), cvtpk(s0[2], s0[3]), cvtpk(s0[4], s0[5]), cvtpk(s0[6], s0[7])}; \
        P[1] = (u32x4){cvtpk(s0[8], s0[9]), cvtpk(s0[10], s0[11]), cvtpk(s0[12], s0[13]), cvtpk(s0[14], s0[15])}; \
        P[2] = (u32x4){cvtpk(s1[0], s1[1]), cvtpk(s1[2], s1[3]), cvtpk(s1[4], s1[5]), cvtpk(s1[6], s1[7])}; \
        P[3] = (u32x4){cvtpk(s1[8], s1[9]), cvtpk(s1[10], s1[11]), cvtpk(s1[12], s1[13]), cvtpk(s1[14], s1[15])}; \
        if (c == 0 && VAR != 5) pv_tile(o, P, vf0, lds + VOFF + vcur + voff); \
        if (t + 1 < NT && VAR != 4) { LAS unsigned char* kn = lds + ((t + 1) & 1) * KBUF; LAS unsigned char* vn = lds + vnext; \
            _Pragma("unroll") for (int i = 0; i < 2; ++i) { *(LAS u32x4*)(kn + lk[i]) = PKW[i]; *(LAS u32x4*)(vn + lv[i]) = PVW[i]; } } \
        { const int tmp = vprev; vprev = vcur; vcur = vnext; vnext = tmp; } \
        if (VAR != 3) { asm volatile("s_waitcnt lgkmcnt(0)\n\ts_barrier" ::: "memory"); } \
    } while (0)
template <int VAR> __device__ __forceinline__ void unit(LAS unsigned char* lds, const bf16* QK, const bf16* KT, const bf16* VT, bf16* MIX, const float* sgain, float lam, int b, int h, int qb) {
    const int tid = threadIdx.x, lane = tid & 63, r32 = lane & 31, hi = lane >> 5; const int wid = __builtin_amdgcn_readfirstlane(tid >> 6);
    const int qsub = wid & 3, c = wid >> 2;
    const size_t rowbase = (size_t)b * SEQ; const int q0 = qb * 128 + qsub * 32;
    { const bf16* qp = QK + (rowbase + q0 + r32) * 512 + h * 128 + c * 64 + hi * 8;
#pragma unroll
      for (int ds = 0; ds < 4; ++ds) *(LAS bf16x8*)(lds + QOFF + wid * 4096 + ds * 1024 + lane * 16) = *(const bf16x8*)(qp + ds * 16); }
    const bf16* gk[2]; const bf16* gv[2]; int lk[2], lv[2];
#pragma unroll
    for (int i = 0; i < 2; ++i) { const int id = tid + NTHR * i; const int kr = id >> 4, kc = id & 15; const int ve = id >> 3, vc = id & 7;
        gk[i] = KT + (size_t)(b * 4 + h) * 64 * 8192 + id * 8; lk[i] = kr * KP + kc * 16;
        gv[i] = VT + (size_t)(b * 4 + h) * 64 * 8192 + id * 8; lv[i] = VOFF + ve * VP + vc * 16; }
    u32x4 pkA[2], pvA[2], pkB[2], pvB[2];
#pragma unroll
    for (int i = 0; i < 2; ++i) { pkA[i] = *(const u32x4*)gk[i]; pvA[i] = *(const u32x4*)gv[i]; }
#pragma unroll
    for (int i = 0; i < 2; ++i) { pkB[i] = *(const u32x4*)(gk[i] + 8192); pvB[i] = *(const u32x4*)(gv[i] + 8192); }
#pragma unroll
    for (int i = 0; i < 2; ++i) { *(LAS u32x4*)(lds + lk[i]) = pkA[i]; *(LAS u32x4*)(lds + lv[i]) = pvA[i]; }
    __syncthreads();
    f32x16 o[4];
#pragma unroll
    for (int e = 0; e < 4; ++e) o[e] = (f32x16){};
    const f32x16 zero16 = (f32x16){};
    float mref = 0.f, lsum = 0.f; bool gen = false;
    u32x4 P[4];
#pragma unroll
    for (int ks = 0; ks < 4; ++ks) P[ks] = (u32x4){0u, 0u, 0u, 0u};
    int vcur = 0, vprev = 2 * VBUF, vnext = VBUF;
    const int voff = r32 * VP + hi * 16;
    for (int tt = 0; tt < NT; tt += 2) {
        ATT_SLOT(tt, pkB, pvB, pkA, pvA);
        ATT_SLOT(tt + 1, pkA, pvA, pkB, pvB);
    }
    if (c == 1) { bf16x8 vf0[4]; v_load(vf0, lds + VOFF + vprev + voff, 0); pv_tile(o, P, vf0, lds + VOFF + vprev + voff); }
    __syncthreads();
    lsum = xhalf_sum(lsum);
    const float sc = (c == 0) ? (1.0f / lsum) : (lam / lsum);
    LAS float* X = (LAS float*)lds + qsub * (128 * 32);
    if (c == 1) {
#pragma unroll
        for (int e = 0; e < 4; ++e)
#pragma unroll
            for (int r = 0; r < 16; ++r) { const int ee = 32 * e + (r & 3) + 8 * (r >> 2) + 4 * hi; X[ee * 32 + r32] = o[e][r] * sc; } }
    __syncthreads();
    if (c == 0) { float ss = 0.f;
#pragma unroll
        for (int e = 0; e < 4; ++e)
#pragma unroll
            for (int r = 0; r < 16; ++r) { const int ee = 32 * e + (r & 3) + 8 * (r >> 2) + 4 * hi; const float v = o[e][r] * sc - X[ee * 32 + r32]; o[e][r] = v; ss += v * v; }
        ss = xhalf_sum(ss);
        const float rs = (1.0f / sqrtf(ss * (1.0f / 128.0f) + SUBLN_EPS)) * 0.8f;
        bf16* op = MIX + (rowbase + q0 + r32) * 1024 + 512 + h * 128;
#pragma unroll
        for (int e = 0; e < 4; ++e)
#pragma unroll
            for (int q4 = 0; q4 < 4; ++q4) { const int ee = 32 * e + 8 * q4 + 4 * hi; const f32x4 g = *(const f32x4*)(sgain + ee);
                u32x2 w; w.x = cvtpk(o[e][4 * q4] * rs * g.x, o[e][4 * q4 + 1] * rs * g.y); w.y = cvtpk(o[e][4 * q4 + 2] * rs * g.z, o[e][4 * q4 + 3] * rs * g.w);
                *(u32x2*)(op + ee) = w; } }
    __syncthreads();
}
}

namespace hy {
constexpr int UP = 264, UBUF = 32 * UP * 2, HRB = HRLEN * 2;
constexpr int NCH = 17;
__device__ __forceinline__ float ldbf(const bf16* p) { return bf2f(*p); }
struct StageRegs { u32x2 xa, xb, va, vb; unsigned short xm, vm; };
__device__ __forceinline__ void stage_load(StageRegs& R, const bf16* X1, const bf16* V, int j, int tid) {
    const int b = tid >> 6, tt = tid & 63; const int S0 = 256 * j + 4 * tt - 4;
    const bool okA = (S0 >= 0 && S0 < SEQ), okB = (S0 + 4 < SEQ), okM = (S0 >= 1 && S0 <= SEQ);
    const size_t ia = (size_t)b * SEQ + (okA ? S0 : 0), ib = (size_t)b * SEQ + (okB ? S0 + 4 : 0), im = (size_t)b * SEQ + (okM ? S0 - 1 : 0);
    R.xa = *(const u32x2*)(X1 + ia); R.xb = *(const u32x2*)(X1 + ib); R.xm = X1[im];
    R.va = *(const u32x2*)(V + ia); R.vb = *(const u32x2*)(V + ib); R.vm = V[im];
}
__device__ __forceinline__ void stage_write(LAS unsigned char* ub, const StageRegs& R, const float (&w1)[4], const float (&wv)[4], int j, int tid) {
    const int b = tid >> 6, tt = tid & 63; const int S0 = 256 * j + 4 * tt - 4;
    const bool okA = (S0 >= 0 && S0 < SEQ), okB = (S0 + 4 < SEQ), okM = (S0 >= 1 && S0 <= SEQ);
    float xs[9], vs[9];
    xs[0] = okM ? bf2f(R.xm) : 0.f; vs[0] = okM ? bf2f(R.vm) : 0.f;
    xs[1] = okA ? bflo(R.xa.x) : 0.f; xs[2] = okA ? bfhi(R.xa.x) : 0.f; xs[3] = okA ? bflo(R.xa.y) : 0.f; xs[4] = okA ? bfhi(R.xa.y) : 0.f;
    xs[5] = okB ? bflo(R.xb.x) : 0.f; xs[6] = okB ? bfhi(R.xb.x) : 0.f; xs[7] = okB ? bflo(R.xb.y) : 0.f; xs[8] = okB ? bfhi(R.xb.y) : 0.f;
    vs[1] = okA ? bflo(R.va.x) : 0.f; vs[2] = okA ? bfhi(R.va.x) : 0.f; vs[3] = okA ? bflo(R.va.y) : 0.f; vs[4] = okA ? bfhi(R.va.y) : 0.f;
    vs[5] = okB ? bflo(R.vb.x) : 0.f; vs[6] = okB ? bfhi(R.vb.x) : 0.f; vs[7] = okB ? bflo(R.vb.y) : 0.f; vs[8] = okB ? bfhi(R.vb.y) : 0.f;
    float g[7];
#pragma unroll
    for (int i = 0; i < 7; ++i) { const float cx = w1[0] * xs[i] + w1[1] * xs[i + 1] + w1[2] * xs[i + 2] + w1[3]; const float cv = wv[0] * vs[i] + wv[1] * vs[i + 1] + wv[2] * vs[i + 2] + wv[3];
        g[i] = ((i < 4) ? okA : okB) ? cx * cv : 0.f; }
#pragma unroll
    for (int r = 0; r < 4; ++r) { u32x2 w; w.x = pk2(g[r], g[r + 1]); w.y = pk2(g[r + 2], g[r + 3]);
        *(LAS u32x2*)(ub + ((4 * b + r) * UP + 4 * tt) * 2) = w; }
}
__device__ __forceinline__ void channel(LAS unsigned char* lds, const bf16* UVT, const bf16* HR, const float* conv_w, const float* conv_b, bf16* YT, int c) {
    const int tid = threadIdx.x, lane = tid & 63, r32 = lane & 31, hi = lane >> 5; const int wid = __builtin_amdgcn_readfirstlane(tid >> 6);
    const bf16* X0 = UVT + (size_t)c * MTOK; const bf16* X1 = UVT + (size_t)(512 + c) * MTOK; const bf16* V = UVT + (size_t)(1024 + c) * MTOK;
    float w0[4], w1[4], wv[4];
#pragma unroll
    for (int k = 0; k < 3; ++k) { w0[k] = conv_w[k * 1536 + c]; w1[k] = conv_w[k * 1536 + 512 + c]; wv[k] = conv_w[k * 1536 + 1024 + c]; }
    w0[3] = conv_b[c]; w1[3] = conv_b[512 + c]; wv[3] = conv_b[1024 + c];
    for (int i = tid; i < HRB / 16; i += NTHR) { const bf16* src = HR + (size_t)c * HRLEN + 8 * i; ((LAS u32x4*)lds)[i] = *(const u32x4*)src;
        const u32x2 lo = *(const u32x2*)(src + 4); const u32x2 hi2 = (8 * i + 8 < HRLEN) ? *(const u32x2*)(src + 8) : (u32x2){0u, 0u};
        ((LAS u32x4*)(lds + HRB))[i] = (u32x4){lo.x, lo.y, hi2.x, hi2.y}; }
    LAS unsigned char* ub0 = lds + 2 * HRB;
    StageRegs SR;
    stage_load(SR, X1, V, 0, tid); stage_write(ub0, SR, w1, wv, 0, tid);
    __syncthreads();
    f32x16 acc[4];
#pragma unroll
    for (int n = 0; n < 4; ++n) acc[n] = (f32x16){};
    const int idx0 = 4096 - 4 * (128 * wid + r32) - 4 + 8 * hi;
    const int hb0 = (r32 & 1) ? idx0 * 2 : HRB + (idx0 - 4) * 2;
    for (int j = 0; j < NCH; ++j) {
        LAS unsigned char* ucur = ub0 + (j & 1) * UBUF;
        if (j + 1 < NCH) stage_load(SR, X1, V, j + 1, tid);
        const int nks = (j < NCH - 1) ? 16 : 1;
        const LAS unsigned char* ua = ucur + r32 * (UP * 2) + hi * 16;
        const LAS unsigned char* hp = lds + hb0 + j * 512;
        if (nks == 16) {
            bf16x8 a0, b0[4], a1, b1[4];
            a0 = *(const LAS bf16x8*)(ua);
#pragma unroll
            for (int n = 0; n < 4; ++n) b0[n] = *(const LAS bf16x8*)(hp - n * 256);
#pragma unroll
            for (int ks = 0; ks < 16; ks += 2) {
                a1 = *(const LAS bf16x8*)(ua + (ks + 1) * 32);
#pragma unroll
                for (int n = 0; n < 4; ++n) b1[n] = *(const LAS bf16x8*)(hp + (ks + 1) * 32 - n * 256);
                __builtin_amdgcn_sched_barrier(0);
#pragma unroll
                for (int n = 0; n < 4; ++n) acc[n] = __builtin_amdgcn_mfma_f32_32x32x16_bf16(a0, b0[n], acc[n], 0, 0, 0);
                __builtin_amdgcn_sched_barrier(0);
                if (ks + 2 < 16) { a0 = *(const LAS bf16x8*)(ua + (ks + 2) * 32);
#pragma unroll
                    for (int n = 0; n < 4; ++n) b0[n] = *(const LAS bf16x8*)(hp + (ks + 2) * 32 - n * 256); }
                __builtin_amdgcn_sched_barrier(0);
#pragma unroll
                for (int n = 0; n < 4; ++n) acc[n] = __builtin_amdgcn_mfma_f32_32x32x16_bf16(a1, b1[n], acc[n], 0, 0, 0);
                __builtin_amdgcn_sched_barrier(0);
            }
        } else {
            const bf16x8 a = *(const LAS bf16x8*)(ua);
#pragma unroll
            for (int n = 0; n < 4; ++n) { const bf16x8 bb = *(const LAS bf16x8*)(hp - n * 256);
                acc[n] = __builtin_amdgcn_mfma_f32_32x32x16_bf16(a, bb, acc[n], 0, 0, 0); }
        }
        if (j + 1 < NCH) stage_write(ub0 + ((j + 1) & 1) * UBUF, SR, w1, wv, j + 1, tid);
        __syncthreads();
    }
#pragma unroll
    for (int n = 0; n < 4; ++n) { const int t = 4 * (128 * wid + 32 * n + r32);
#pragma unroll
        for (int q = 0; q < 4; ++q) { const int b = 2 * q + hi; const bf16* xp = X0 + (size_t)b * SEQ + t; const u32x2 xa = *(const u32x2*)xp; float xs[6];
            { const float xm = ldbf(xp - ((t > 0) ? 1 : 0)), xq = ldbf(xp + ((t + 4 < SEQ) ? 4 : 0)); xs[0] = (t > 0) ? xm : 0.f; xs[5] = (t + 4 < SEQ) ? xq : 0.f; }
            xs[1] = bflo(xa.x); xs[2] = bfhi(xa.x); xs[3] = bflo(xa.y); xs[4] = bfhi(xa.y);
            float y[4];
#pragma unroll
            for (int i = 0; i < 4; ++i) y[i] = acc[n][4 * q + i] * (w0[0] * xs[i] + w0[1] * xs[i + 1] + w0[2] * xs[i + 2] + w0[3]);
            u32x2 w; w.x = pk2(y[0], y[1]); w.y = pk2(y[2], y[3]);
            *(u32x2*)(YT + (size_t)c * MTOK + (size_t)b * SEQ + t) = w; } }
    __syncthreads();
}
}

#define XB_TMO      128
#define XB_XCNT(j)  (256  + 64 * (j))
#define XB_XSUB(j)  (1280 + 64 * (j))
#define XB_XGEN(j)  (2304 + 64 * (j))
#define XB_TOP      3328
#define XB_TOPGEN   3392
#define XCD_BAR_WORDS 3456
#define XB_SPIN_CAP (1u << 18)

__device__ __forceinline__ unsigned xb_ld(unsigned* p)              { return __hip_atomic_load(p, __ATOMIC_RELAXED, __HIP_MEMORY_SCOPE_AGENT); }
__device__ __forceinline__ unsigned xb_add(unsigned* p, unsigned v) { return __hip_atomic_fetch_add(p, v, __ATOMIC_RELAXED, __HIP_MEMORY_SCOPE_AGENT); }
__device__ __forceinline__ unsigned xb_xcc_id() { return (unsigned)__builtin_amdgcn_s_getreg((3 << 11) | 20) & 0xFu; }
#define XB_SPIN(cond, bar) do { unsigned _sp = 0; while (cond) { __builtin_amdgcn_s_sleep(1); \
    if ((++_sp & 255u) == 0u) { if (xb_ld(&(bar)[XB_TMO])) break; if (_sp > XB_SPIN_CAP) { atomicAdd(&(bar)[XB_TMO], 1u); break; } } } } while (0)

struct XcdBarrier {
    unsigned* bar; unsigned x;
    volatile LAS unsigned* st;
};

__device__ __forceinline__ XcdBarrier xcd_barrier_post(unsigned* bar, volatile LAS unsigned* st) {
    XcdBarrier b; b.bar = bar; b.x = xb_xcc_id(); b.st = st;
    if (threadIdx.x == 0) (void)xb_add(&bar[XB_XCNT(b.x)], 1u);
    return b;
}
__device__ __forceinline__ void xcd_barrier_complete(unsigned* bar, unsigned x, unsigned& nloc, unsigned& nx) {
    const unsigned G = gridDim.x * gridDim.y * gridDim.z;
    unsigned sum, cnt, mine, sp = 0u;
    for (;;) {
        sum = 0u; cnt = 0u; mine = 0u;
#pragma unroll
        for (unsigned j = 0; j < 16; ++j) { const unsigned c = xb_ld(&bar[XB_XCNT(j)]); sum += c; cnt += (c > 0u) ? 1u : 0u; mine = (j == x) ? c : mine; }
        if (sum == G) break;
        __builtin_amdgcn_s_sleep(1);
        if ((++sp & 255u) == 0u) { if (xb_ld(&bar[XB_TMO])) break; if (sp > XB_SPIN_CAP) { atomicAdd(&bar[XB_TMO], 1u); break; } }
    }
    nloc = mine > 0u ? mine : 1u; nx = cnt > 0u ? cnt : 1u;
}

__device__ __forceinline__ void xcd_barrier(const XcdBarrier& b) {
    asm volatile("s_waitcnt vmcnt(0)" ::: "memory");
    __syncthreads();
    if (threadIdx.x == 0) {
        unsigned* bar = b.bar;
        __builtin_amdgcn_s_waitcnt(0);
        unsigned nloc = b.st[0], nx = b.st[1];
        if (nloc == 0u) { xcd_barrier_complete(bar, b.x, nloc, nx); b.st[0] = nloc; b.st[1] = nx; }
        const unsigned old = xb_add(&bar[XB_XSUB(b.x)], 1u);
        const unsigned gen = old / nloc;
        if (old + 1u == (gen + 1u) * nloc) {
            __builtin_amdgcn_fence(__ATOMIC_RELEASE, "agent");
            asm volatile("s_waitcnt vmcnt(0)" ::: "memory");
            const unsigned og = xb_add(&bar[XB_TOP], 1u);
            const unsigned tg = og / nx;
            if (og + 1u == (tg + 1u) * nx) xb_add(&bar[XB_TOPGEN], 1u);
            else XB_SPIN(xb_ld(&bar[XB_TOPGEN]) == tg, bar);
            __builtin_amdgcn_fence(__ATOMIC_ACQUIRE, "agent");
            xb_add(&bar[XB_XGEN(b.x)], 1u);
            asm volatile("s_waitcnt vmcnt(0)" ::: "memory");
        } else {
            XB_SPIN(xb_ld(&bar[XB_XGEN(b.x)]) == gen, bar);
            __builtin_amdgcn_fence(__ATOMIC_ACQUIRE, "agent");
            asm volatile("s_waitcnt vmcnt(0)" ::: "memory");
        }
    }
    __syncthreads();
}

__global__ void __launch_bounds__(NTHR, 2) fwd_kernel(Args a) {
    extern __shared__ __attribute__((aligned(16))) unsigned char lds_raw[];
    LAS unsigned char* lds = (LAS unsigned char*)lds_raw;
    const int tid = threadIdx.x, lane = tid & 63; const int wave = __builtin_amdgcn_readfirstlane(tid >> 6);
    const int G = gridDim.x, bx = blockIdx.x;
    const int gw = bx * NWAVES + wave, NGW = G * NWAVES;
    unsigned char* ws = a.ws;
    bf16* Win_t = (bf16*)(ws + WS_WIN); bf16* Wout_t = (bf16*)(ws + WS_WOUT); bf16* Wup_t = (bf16*)(ws + WS_WUP); bf16* Wdown_t = (bf16*)(ws + WS_WDOWN);
    bf16* HR = (bf16*)(ws + WS_HR); float* ROPE = (float*)(ws + WS_ROPE);
    bf16* XN = (bf16*)(ws + WS_XN); bf16* MO = (bf16*)(ws + WS_MO); bf16* YT = (bf16*)(ws + WS_YT); bf16* UVT = (bf16*)(ws + WS_UVT);
    bf16* QK = (bf16*)(ws + WS_QK); bf16* KT = (bf16*)(ws + WS_KT); bf16* VT = (bf16*)(ws + WS_VT); bf16* MIX = (bf16*)(ws + WS_MIX); bf16* HB = (bf16*)(ws + WS_H);
    const float* x = a.in[0];
    const int lo = a.ph_lo, hi_ph = a.ph_hi;
#if MK_COOP
    cg::grid_group grid = cg::this_grid();
    volatile LAS unsigned* bst = (volatile LAS unsigned*)(lds + 131072 + 64);
    if (tid < 4) bst[tid] = 0u;
    __syncthreads();
    XcdBarrier xbar = xcd_barrier_post((unsigned*)(ws + WS_CTL), bst);
#define SEAM(k) do { if (lo <= (k) && (k) + 1 < hi_ph) { if (hi_ph > 64) grid.sync(); else xcd_barrier(xbar); } } while (0)
#else
#define SEAM(k) do { } while (0)
#endif
#ifndef PHMASK
#define PHMASK 0x1ff
#endif
#define IN(k) (((PHMASK >> (k)) & 1) && lo <= (k) && (k) < hi_ph)

#ifndef DUP_P0
#define DUP_P0 1
#endif
    if (IN(0)) for (int rep0 = 0; rep0 < DUP_P0; ++rep0) {
        LAS float* scr = (LAS float*)(lds + wave * 16384);
        constexpr int I_IN = (DM / 64) * (NIN / 32), I_OUT = (DM / 64) * (DM / 32), I_UP = (DM / 64) * (DFF / 32), I_DN = (DFF / 64) * (DM / 32);
        for (int it = gw; it < I_IN + I_OUT + I_UP + I_DN; it += NGW) { int r = it;
            if (r < I_IN) { p0_transpose_item<true>(a.in[3], DM, NIN, Win_t, scr, r, lane); continue; } r -= I_IN;
            if (r < I_OUT) { p0_transpose_item<false>(a.in[20], DM, DM, Wout_t, scr, r, lane); continue; } r -= I_OUT;
            if (r < I_UP) { p0_transpose_item<false>(a.in[23], DM, DFF, Wup_t, scr, r, lane); continue; } r -= I_UP;
            p0_transpose_item<false>(a.in[24], DFF, DM, Wdown_t, scr, r, lane); }
        for (int m = gw; m < MTOK; m += NGW) rms_row_to_bf16(x + (size_t)m * DM, a.in[1], XN + (size_t)m * DM, lane);
        for (int i = bx * NTHR + tid; i < SEQ * 32; i += G * NTHR) { const int pos = i >> 5, k = i & 31;
            const float inv = exp2f(-(float)(2 * k) * (13.287712379549449f / 64.0f)); const float ang = (float)pos * inv;
            ROPE[2 * i] = cosf(ang); ROPE[2 * i + 1] = sinf(ang); }
        __syncthreads();
        for (int pg = bx; pg < SEQ / 16; pg += G) filter_item(lds, a, HR, pg, tid);
    }
    SEAM(0);
#ifndef DUP_P1
#define DUP_P1 1
#endif
    if (IN(1)) {
        { pg8::Gemm g{Win_t, XN, 2048, MTOK, DM}; pg8::StaticOrder S; S.init(2048, MTOK, G, bx);
          pg8::EpiUV E{UVT, VT};
          pg8::gemm_phase<pg8::EpiUV, pg8::StaticOrder, true, true>(lds, g, S, E); }
        { pg8::Gemm g{XN, Win_t + (size_t)2048 * DM, MTOK, 1024, DM}; pg8::StaticOrder S; S.init(MTOK, 1024, G, bx);
          pg8::EpiRope E{QK, KT, ROPE, QSCALE};
          pg8::gemm_phase<pg8::EpiRope, pg8::StaticOrder, true, true>(lds, g, S, E); }
    }
#if DUP_P1 == 2
    if (IN(1)) {
        { pg8::Gemm g{Win_t, XN, 2048, MTOK, DM}; pg8::StaticOrder S; S.init(2048, MTOK, G, bx);
          pg8::EpiUV E{UVT, VT};
          pg8::gemm_phase<pg8::EpiUV, pg8::StaticOrder, true, true>(lds, g, S, E); }
        { pg8::Gemm g{XN, Win_t + (size_t)2048 * DM, MTOK, 1024, DM}; pg8::StaticOrder S; S.init(MTOK, 1024, G, bx);
          pg8::EpiRope E{QK, KT, ROPE, QSCALE};
          pg8::gemm_phase<pg8::EpiRope, pg8::StaticOrder, true, true>(lds, g, S, E); }
    }
#endif
    SEAM(1);
    if (IN(2)) {
        float lam;
        { const float p1 = a.in[15][lane] * a.in[16][lane], p2 = a.in[17][lane] * a.in[18][lane];
          lam = expf(wave_sum(p1)) - expf(wave_sum(p2)) + 0.2f; }
#ifndef DUP_ATT
#define DUP_ATT 1
#endif
#ifndef DUP_HY
#define DUP_HY 1
#endif
#ifndef ATT_VAR
#define ATT_VAR 0
#endif
        for (int u = bx; u < 1024; u += G) { const int bh = (u & 7) + 8 * (u >> 8), qb = (u >> 3) & 31;
            att::unit<0>(lds, QK, KT, VT, MIX, a.in[19], lam, bh >> 2, bh & 3, qb); }
        if (DUP_ATT > 1)
        for (int u = bx; u < 1024; u += G) { const int bh = (u & 7) + 8 * (u >> 8), qb = (u >> 3) & 31;
            att::unit<ATT_VAR>(lds, QK, KT, VT, MO, a.in[19], lam, bh >> 2, bh & 3, qb); }
        for (int rep = 0; rep < DUP_HY; ++rep)
        for (int c = bx; c < HYW; c += G) hy::channel(lds, UVT, HR, a.in[4], a.in[5], YT, c);
    }
    SEAM(2);
#ifndef DUP_P3
#define DUP_P3 1
#endif
    if (IN(3)) for (int rep3 = 0; rep3 < DUP_P3; ++rep3) {
        LAS unsigned short* scr = (LAS unsigned short*)(lds + wave * 16384);
        for (int it = gw; it < 8 * (MTOK / 64); it += NGW) { const int ct = it & 7, mt = it >> 3; const int c0 = 64 * ct, m0 = 64 * mt;
#pragma unroll
            for (int i = 0; i < 8; ++i) { const int cc = 8 * i + (lane >> 3), mch = lane & 7; const u32x4 v = *(const u32x4*)(YT + (size_t)(c0 + cc) * MTOK + m0 + 8 * mch);
                LAS unsigned* d = (LAS unsigned*)(scr + cc * 66 + 8 * mch); d[0] = v.x; d[1] = v.y; d[2] = v.z; d[3] = v.w; }
            LDS_WAIT(); asm volatile("" ::: "memory");
#pragma unroll
            for (int i = 0; i < 8; ++i) { const int mm = 8 * i + (lane >> 3), cch = lane & 7; const LAS unsigned short* s = scr + (8 * cch) * 66 + mm;
                u32x4 o; o.x = (unsigned)s[0] | ((unsigned)s[66] << 16); o.y = (unsigned)s[2 * 66] | ((unsigned)s[3 * 66] << 16);
                o.z = (unsigned)s[4 * 66] | ((unsigned)s[5 * 66] << 16); o.w = (unsigned)s[6 * 66] | ((unsigned)s[7 * 66] << 16);
                *(u32x4*)(MIX + (size_t)(m0 + mm) * 1024 + c0 + 8 * cch) = o; }
            LDS_WAIT(); asm volatile("" ::: "memory"); }
        __syncthreads();
    }
    SEAM(3);
    if (IN(4)) {
        pg8::Gemm g{MIX, Wout_t, MTOK, DM, DM}; pg8::StaticOrder S; S.init(MTOK, DM, G, bx);
        float* ssb = (float*)(ws + WS_CTL + CTL_SS); unsigned* cntb = (unsigned*)(ws + WS_CTL + CTL_CNT);
        pg8::EpiNormResNorm E{x, MO, XN, a.in[2], a.in[21], ssb, ssb + MTOK, cntb, cntb + 128, NORM_EPS};
        pg8::gemm_phase<pg8::EpiNormResNorm, pg8::StaticOrder, true, true>(lds, g, S, E);
    }
    SEAM(4);
#ifndef DUP_P6
#define DUP_P6 1
#endif
    if (IN(6)) for (int rep6 = 0; rep6 < DUP_P6; ++rep6) {
        pg8::Gemm g{XN, Wup_t, MTOK, DFF, DM}; pg8::StaticOrder S; S.init(MTOK, DFF, G, bx);
        pg8::EpiBf16<1> E{HB, DFF};
        pg8::gemm_phase<pg8::EpiBf16<1>, pg8::StaticOrder, true, true>(lds, g, S, E);
    }
    SEAM(6);
    if (IN(7)) {
        pg8::Gemm g{HB, Wdown_t, MTOK, DM, DFF}; pg8::StaticOrder S; S.init(MTOK, DM, G, bx);
        float* ssb = (float*)(ws + WS_CTL + CTL_SS); unsigned* cntb = (unsigned*)(ws + WS_CTL + CTL_CNT);
        pg8::EpiNormRes E{MO, a.out, a.in[22], ssb + 2 * MTOK, cntb + 256, NORM_EPS};
        pg8::gemm_phase<pg8::EpiNormRes, pg8::StaticOrder, true, true>(lds, g, S, E);
    }
#undef IN
#undef SEAM
}

constexpr int NPHASE = 9;
extern "C" void kernel_launch(void* const* d_in, const int* in_sizes, int n_in, void* d_out, int out_size, void* d_ws, size_t ws_size, hipStream_t stream) {
    static int grid = 0;
    if (grid == 0) {
        if (n_in != 25 || in_sizes[0] != MTOK * DM || out_size != MTOK * DM || ws_size < WS_END) {
            fprintf(stderr, "kernel_launch: unexpected shapes (n_in %d in0 %d out %d ws %zu)\n", n_in, n_in > 0 ? in_sizes[0] : -1, out_size, ws_size); grid = -1; return; }
        int dev = 0, cus = 0, per_cu = 0;
        hipGetDevice(&dev); hipDeviceGetAttribute(&cus, hipDeviceAttributeMultiprocessorCount, dev);
        hipFuncSetAttribute((const void*)fwd_kernel, hipFuncAttributeMaxDynamicSharedMemorySize, LDS_BYTES);
        hipOccupancyMaxActiveBlocksPerMultiprocessor(&per_cu, (const void*)fwd_kernel, NTHR, LDS_BYTES);
        if (per_cu < 1) { fprintf(stderr, "kernel_launch: occupancy query says %d blocks/CU\n", per_cu); per_cu = 1; }
        (void)hipGetLastError();
        grid = cus >= 256 ? 256 : cus;
    }
    if (grid < 0) return;
    Args a{};
    for (int i = 0; i < 25; ++i) a.in[i] = (const float*)d_in[i];
    a.out = (float*)d_out; a.ws = (unsigned char*)d_ws;
#if MK_COOP
    a.ph_lo = 0; a.ph_hi = NPHASE;
    if (hipMemsetAsync((unsigned char*)d_ws + WS_CTL, 0, CTL_BYTES, stream) != hipSuccess) { fprintf(stderr, "kernel_launch: memset of the barrier words failed\n"); return; }
    void* args[] = {&a};
    hipError_t e = hipLaunchCooperativeKernel((const void*)fwd_kernel, dim3(grid), dim3(NTHR), args, LDS_BYTES, stream);
    if (e != hipSuccess) fprintf(stderr, "cooperative launch failed: %s (grid %d)\n", hipGetErrorString(e), grid);
#else
    for (int p = 0; p < NPHASE; ++p) { a.ph_lo = p; a.ph_hi = p + 1; hipLaunchKernelGGL(fwd_kernel, dim3(grid), dim3(NTHR), LDS_BYTES, stream, a); }
#endif
}
```
